# Optimizing an MI355X kernel written in HIP

```python
import jax
import jax.numpy as jnp
from jax import lax
import numpy as np

D_MODEL = 1024
BATCH = 32
SEQ = 256
DEPTH = 2
DEC_BATCH = 4
DEC_SEQ = 2048
PAST_LEN = 256

GRID_W = 64
EPS = 1e-6
ROPE_BASE = 10000.0
Q_BLOCK = 128
MLSTM_CHUNK = 64

M_HEADS = 4
M_DK = 128
M_DV = 128
M_WIDTH = M_HEADS * M_DV
A_HEADS = 8
A_NOPE = 64
A_ROPE = 32
A_QK = A_NOPE + A_ROPE
A_V = 64
A_Q_LORA = 256
A_KV_LORA = 128
A_WIDTH = A_HEADS * A_V
G_HEADS = 8
G_KV_HEADS = 2
G_GROUP = G_HEADS // G_KV_HEADS
G_HD = 64
G_WIDTH = G_HEADS * G_HD
N_BRANCH = 3
BRANCH_WIDTH = 512
D_FF = ((8 * D_MODEL // 3 + 255) // 256) * 256
N_MOD = 6

IN_SIZES = (
    N_BRANCH * D_MODEL,
    M_HEADS * M_DK, M_HEADS * M_DK,
    M_HEADS * M_DV, M_HEADS * M_DV,
    4 * M_HEADS,
    A_Q_LORA, A_KV_LORA, A_ROPE,
    G_HEADS * G_HD, G_KV_HEADS * G_HD, G_KV_HEADS * G_HD,
)
D_IN = sum(IN_SIZES)
IN_SPLITS = tuple(sum(IN_SIZES[:i + 1]) for i in range(len(IN_SIZES) - 1))

kernel_name = 'hybrid_mlstm_mla_gqa_dit_step'


def rms_norm(x, g):
    xf = x.astype(jnp.float32)
    y = xf * lax.rsqrt(jnp.mean(xf * xf, axis=-1, keepdims=True) + EPS)
    return (y * g.astype(jnp.float32)).astype(x.dtype)


def axial_rope(rows, rot_dim):
    n_freq = rot_dim // 4
    freqs = ROPE_BASE ** (-jnp.arange(n_freq, dtype=jnp.float32) / n_freq)
    row = jnp.repeat(jnp.arange(rows, dtype=jnp.float32), GRID_W)
    col = jnp.tile(jnp.arange(GRID_W, dtype=jnp.float32), rows)
    ang = jnp.concatenate([row[:, None] * freqs, col[:, None] * freqs], axis=-1)
    return jnp.cos(ang), jnp.sin(ang)


def apply_rope(x, cos, sin):
    half = x.shape[-1] // 2
    xf = x.astype(jnp.float32)
    x1, x2 = xf[..., :half], xf[..., half:]
    shape = (x.shape[1],) + (1,) * (x.ndim - 3) + (half,)
    c, s = cos.reshape(shape), sin.reshape(shape)
    return jnp.concatenate([x1 * c - x2 * s, x1 * s + x2 * c], axis=-1).astype(x.dtype)


def block_attention(q, k, v):
    b, t, hk, g, d = q.shape
    nblk = t // Q_BLOCK
    scale = d ** -0.5
    qb = jnp.moveaxis(q.reshape(b, nblk, Q_BLOCK, hk, g, d), 1, 0)

    def one_block(qi):
        s = jnp.einsum('bqhgd,bshd->bhgqs', qi, k, preferred_element_type=jnp.float32) * scale
        pr = jax.nn.softmax(s, axis=-1).astype(v.dtype)
        return jnp.einsum('bhgqs,bshe->bqhge', pr, v)

    out = lax.map(one_block, qb)
    return jnp.moveaxis(out, 0, 1).reshape(b, t, hk, g, v.shape[-1])


def mlstm_scan(q, k, v, i_pre, f_pre, state):
    b, nh, t, _ = q.shape
    L = MLSTM_CHUNK
    nc = t // L

    def chunks(a):
        return jnp.moveaxis(a.reshape((b, nh, nc, L) + a.shape[3:]), 2, 0)

    logf = jax.nn.log_sigmoid(f_pre)
    xs = (chunks(q), chunks(k), chunks(v), chunks(i_pre), chunks(logf))
    lower = jnp.tril(jnp.ones((L, L), dtype=bool))

    def step(carry, inp):
        C, n, m = carry
        qc, kc, vc, ic, fc = inp
        bcum = jnp.cumsum(fc, axis=-1)
        d_log = bcum[..., :, None] - bcum[..., None, :] + ic[..., None, :]
        d_log = jnp.where(lower, d_log, -jnp.inf)
        inter = bcum + m[..., None]
        m_t = jnp.maximum(inter, jnp.max(d_log, axis=-1))
        w_inter = jnp.exp(inter - m_t)
        s = jnp.einsum('bhld,bhsd->bhls', qc, kc) * jnp.exp(d_log - m_t[..., None])
        num = jnp.einsum('bhld,bhde->bhle', qc, C) * w_inter[..., None] + jnp.einsum('bhls,bhse->bhle', s, vc)
        den = jnp.einsum('bhld,bhd->bhl', qc, n) * w_inter + jnp.sum(s, axis=-1)
        hc = num / jnp.maximum(jnp.abs(den), jnp.exp(-m_t))[..., None]
        g = bcum[..., -1:] - bcum + ic
        total = bcum[..., -1] + m
        m_new = jnp.maximum(total, jnp.max(g, axis=-1))
        wg = jnp.exp(g - m_new[..., None])
        decay = jnp.exp(total - m_new)
        C_new = C * decay[..., None, None] + jnp.einsum('bhs,bhsd,bhse->bhde', wg, kc, vc)
        n_new = n * decay[..., None] + jnp.einsum('bhs,bhsd->bhd', wg, kc)
        return (C_new, n_new, m_new), hc

    state, hs = lax.scan(step, state, xs)
    return jnp.moveaxis(hs, 0, 2).reshape(b, nh, t, -1), state


def trunk_layer(x, cond, p, ctx, rope_a, rope_g):
    b, t, _ = x.shape
    f32 = jnp.float32
    mod = (jax.nn.silu(cond) @ p['w_mod'] + p['b_mod'])[..., None, :]
    sh1, sc1, gt1, sh2, sc2, gt2 = jnp.split(mod, N_MOD, axis=-1)
    h = rms_norm(x, p['norm1_g']) * (1 + sc1) + sh1
    (gate_pre, mq, mk, mv, mo, mg, aq, akv, akr, gq, gk, gv) = jnp.split(h @ p['w_in'], IN_SPLITS, axis=-1)

    def heads_first(a, nh):
        return a.reshape(b, t, nh, -1).transpose(0, 2, 1, 3).astype(f32)

    qm = heads_first(mq, M_HEADS)
    km = heads_first(mk, M_HEADS) * (M_DK ** -0.5)
    vm = heads_first(mv, M_HEADS)
    gp = (mg + p['b_mgate']).astype(f32).reshape(b, t, 4, M_HEADS).transpose(2, 0, 3, 1)
    if ctx is None:
        zero = (jnp.zeros((b, M_HEADS, M_DK, M_DV), f32), jnp.zeros((b, M_HEADS, M_DK), f32),
                jnp.zeros((b, M_HEADS), f32))
        init_f, init_b = zero, zero
    else:
        init_f = (ctx['mC'][:, 0].astype(f32), ctx['mn'][:, 0].astype(f32), ctx['mm'][:, 0].astype(f32))
        init_b = (ctx['mC'][:, 1].astype(f32), ctx['mn'][:, 1].astype(f32), ctx['mm'][:, 1].astype(f32))
    h_f, st_f = mlstm_scan(qm, km, vm, gp[0], gp[1], init_f)

    def rev(a):
        return jnp.flip(a, axis=2)

    h_b, st_b = mlstm_scan(rev(qm), rev(km), rev(vm), rev(gp[2]), rev(gp[3]), init_b)
    hm = (h_f + rev(h_b)).transpose(0, 2, 1, 3).astype(x.dtype)
    ym = (rms_norm(hm, p['m_norm_g']) * jax.nn.sigmoid(mo.reshape(b, t, M_HEADS, M_DV))).reshape(b, t, M_WIDTH)

    def mla_kv(ckv_, kr_):
        s = ckv_.shape[1]
        kv = (ckv_ @ p['w_ukv']).reshape(b, s, A_HEADS, A_NOPE + A_V)
        k_rope = jnp.broadcast_to(kr_[:, :, None, :], (b, s, A_HEADS, A_ROPE))
        k_ = rms_norm(jnp.concatenate([kv[..., :A_NOPE], k_rope], axis=-1), p['a_knorm_g'])
        return k_, kv[..., A_NOPE:]

    ckv = rms_norm(akv, p['a_kvlora_g'])
    qa = (rms_norm(aq, p['a_qlora_g']) @ p['w_uq']).reshape(b, t, A_HEADS, A_QK)
    qa = rms_norm(qa, p['a_qnorm_g'])
    ka, va = mla_kv(ckv, akr)
    if ctx is not None:
        cos_a, sin_a = rope_a
        qa = jnp.concatenate([qa[..., :A_NOPE], apply_rope(qa[..., A_NOPE:], cos_a, sin_a)], axis=-1)
        ka = jnp.concatenate([ka[..., :A_NOPE], apply_rope(ka[..., A_NOPE:], cos_a, sin_a)], axis=-1)
        kc, vc = mla_kv(ctx['ckv'], ctx['kr'])
        ka = jnp.concatenate([kc, ka], axis=1)
        va = jnp.concatenate([vc, va], axis=1)
    ya = block_attention(qa[:, :, :, None, :], ka, va).reshape(b, t, A_WIDTH)

    qg = rms_norm(gq.reshape(b, t, G_HEADS, G_HD), p['g_qnorm_g'])
    kg = rms_norm(gk.reshape(b, t, G_KV_HEADS, G_HD), p['g_knorm_g'])
    vg = gv.reshape(b, t, G_KV_HEADS, G_HD)
    if ctx is None:
        k_all, v_all = kg, vg
    else:
        cos_g, sin_g = rope_g
        qg = apply_rope(qg, cos_g, sin_g)
        k_all = jnp.concatenate([ctx['gk'], apply_rope(kg, cos_g, sin_g)], axis=1)
        v_all = jnp.concatenate([ctx['gv'], vg], axis=1)
    yg = block_attention(qg.reshape(b, t, G_KV_HEADS, G_GROUP, G_HD), k_all, v_all).reshape(b, t, G_WIDTH)

    ys = jnp.stack([ym, ya, yg], axis=2)
    branches = jnp.einsum('btnw,nwd->btnd', ys, p['w_branch'])
    gates = jax.nn.sigmoid(gate_pre.reshape(b, t, N_BRANCH, D_MODEL))
    mixed = jnp.einsum('btnd,btnd->btd', gates, branches) @ p['w_out']
    x = x + gt1 * mixed

    h2 = rms_norm(x, p['norm2_g']) * (1 + sc2) + sh2
    u_gate, u_val = jnp.split(h2 @ p['w_ffn_in'], 2, axis=-1)
    x = x + gt2 * ((jax.nn.silu(u_gate) * u_val) @ p['w_ffn_out'])

    if ctx is None:
        new_ctx = dict(mC=jnp.stack([st_f[0], st_b[0]], axis=1), mn=jnp.stack([st_f[1], st_b[1]], axis=1),
                       mm=jnp.stack([st_f[2], st_b[2]], axis=1), ckv=ckv, kr=akr, gk=kg, gv=vg)
    else:
        new_ctx = None
    return x, new_ctx


def setup_inputs(seed: int = 0) -> dict:
    key = jax.random.key(seed)
    keys = iter(jax.random.split(key, 40))

    def nrm(shape, scale):
        return jax.random.normal(next(keys), shape, jnp.float32) * scale

    def gain(shape):
        return 1.0 + nrm(shape, 0.02)

    gate_base = jnp.repeat(jnp.array([0.0, 3.0, 0.0, 3.0], jnp.float32), M_HEADS)
    return {
        'x_prompt': nrm((BATCH, SEQ, D_MODEL), 1.0),
        'x_sample': nrm((DEC_BATCH, DEC_SEQ, D_MODEL), 1.0),
        'state_mlstm_C': nrm((DEC_BATCH, DEPTH, 2, M_HEADS, M_DK, M_DV), 0.1),
        'state_mlstm_n': nrm((DEC_BATCH, DEPTH, 2, M_HEADS, M_DK), 0.1),
        'state_mlstm_m': nrm((DEC_BATCH, DEPTH, 2, M_HEADS), 1.0),
        'cache_mla_ckv': nrm((DEC_BATCH, DEPTH, PAST_LEN, A_KV_LORA), 1.0),
        'cache_mla_krope': nrm((DEC_BATCH, DEPTH, PAST_LEN, A_ROPE), 1.0),
        'cache_gqa_k': nrm((DEC_BATCH, DEPTH, PAST_LEN, G_KV_HEADS, G_HD), 1.0),
        'cache_gqa_v': nrm((DEC_BATCH, DEPTH, PAST_LEN, G_KV_HEADS, G_HD), 1.0),
        'c': nrm((DEC_BATCH, D_MODEL), 1.0),
        'c_ctx': nrm((D_MODEL,), 1.0),
        'w_mod': nrm((DEPTH, D_MODEL, N_MOD * D_MODEL), 0.5 * D_MODEL ** -0.5),
        'b_mod': nrm((DEPTH, N_MOD * D_MODEL), 0.02),
        'norm1_g': gain((DEPTH, D_MODEL)),
        'w_in': nrm((DEPTH, D_MODEL, D_IN), D_MODEL ** -0.5),
        'b_mgate': gate_base + nrm((DEPTH, 4 * M_HEADS), 0.1),
        'm_norm_g': gain((DEPTH, M_DV)),
        'a_qlora_g': gain((DEPTH, A_Q_LORA)),
        'a_kvlora_g': gain((DEPTH, A_KV_LORA)),
        'w_uq': nrm((DEPTH, A_Q_LORA, A_HEADS * A_QK), A_Q_LORA ** -0.5),
        'w_ukv': nrm((DEPTH, A_KV_LORA, A_HEADS * (A_NOPE + A_V)), A_KV_LORA ** -0.5),
        'a_qnorm_g': gain((DEPTH, A_QK)),
        'a_knorm_g': gain((DEPTH, A_QK)),
        'g_qnorm_g': gain((DEPTH, G_HD)),
        'g_knorm_g': gain((DEPTH, G_HD)),
        'w_branch': nrm((DEPTH, N_BRANCH, BRANCH_WIDTH, D_MODEL), BRANCH_WIDTH ** -0.5),
        'w_out': nrm((DEPTH, D_MODEL, D_MODEL), D_MODEL ** -0.5),
        'norm2_g': gain((DEPTH, D_MODEL)),
        'w_ffn_in': nrm((DEPTH, D_MODEL, 2 * D_FF), D_MODEL ** -0.5),
        'w_ffn_out': nrm((DEPTH, D_FF, D_MODEL), D_FF ** -0.5),
    }


def reference(x_prompt, x_sample, state_mlstm_C, state_mlstm_n, state_mlstm_m, cache_mla_ckv, cache_mla_krope,
              cache_gqa_k, cache_gqa_v, c, c_ctx, w_mod, b_mod, norm1_g, w_in, b_mgate, m_norm_g, a_qlora_g,
              a_kvlora_g, w_uq, w_ukv, a_qnorm_g, a_knorm_g, g_qnorm_g, g_knorm_g, w_branch, w_out, norm2_g,
              w_ffn_in, w_ffn_out):
    def params(l):
        return dict(w_mod=w_mod[l], b_mod=b_mod[l], norm1_g=norm1_g[l], w_in=w_in[l], b_mgate=b_mgate[l],
                    m_norm_g=m_norm_g[l], a_qlora_g=a_qlora_g[l], a_kvlora_g=a_kvlora_g[l], w_uq=w_uq[l],
                    w_ukv=w_ukv[l], a_qnorm_g=a_qnorm_g[l], a_knorm_g=a_knorm_g[l], g_qnorm_g=g_qnorm_g[l],
                    g_knorm_g=g_knorm_g[l], w_branch=w_branch[l], w_out=w_out[l], norm2_g=norm2_g[l],
                    w_ffn_in=w_ffn_in[l], w_ffn_out=w_ffn_out[l])

    xp = x_prompt
    ctx_layers = []
    for l in range(DEPTH):
        xp, st = trunk_layer(xp, c_ctx, params(l), None, None, None)
        ctx_layers.append(st)

    def stack(name):
        return jnp.stack([s[name] for s in ctx_layers], axis=1).astype(x_prompt.dtype)

    new_mlstm_C = stack('mC')
    new_mlstm_n = stack('mn')
    new_mlstm_m = stack('mm')
    new_mla_ckv = stack('ckv')
    new_mla_krope = stack('kr')
    new_gqa_k = stack('gk')
    new_gqa_v = stack('gv')

    rows = x_sample.shape[1] // GRID_W
    rope_a = axial_rope(rows, A_ROPE)
    rope_g = axial_rope(rows, G_HD)
    xs = x_sample
    for l in range(DEPTH):
        ctx = dict(mC=state_mlstm_C[:, l], mn=state_mlstm_n[:, l], mm=state_mlstm_m[:, l],
                   ckv=cache_mla_ckv[:, l], kr=cache_mla_krope[:, l], gk=cache_gqa_k[:, l], gv=cache_gqa_v[:, l])
        xs, _ = trunk_layer(xs, c, params(l), ctx, rope_a, rope_g)

    return (xp, xs, new_mlstm_C, new_mlstm_n, new_mlstm_m, new_mla_ckv, new_mla_krope, new_gqa_k, new_gqa_v)
```

```cpp
#include <hip/hip_runtime.h>
#include <hip/hip_cooperative_groups.h>
#include <cstdio>
namespace cg = cooperative_groups;

typedef unsigned short bf16_t;
typedef short bf16x8 __attribute__((ext_vector_type(8)));
typedef float f32x16 __attribute__((ext_vector_type(16)));
typedef float f32x4 __attribute__((ext_vector_type(4)));
typedef float f32x2 __attribute__((ext_vector_type(2)));
typedef unsigned u32x4 __attribute__((ext_vector_type(4)));
typedef unsigned u32x2 __attribute__((ext_vector_type(2)));

#ifndef MIXSEL
#define MIXSEL 7
#endif
#ifndef MULTI_LAUNCH
#define MULTI_LAUNCH 1
#endif

constexpr int NTOK = 16384, NCTX = 8192, NKV = 17408;
constexpr int DIN = 6320, DFF = 2816;
constexpr float EPS = 1e-6f;
constexpr int NPHASE = 25;
constexpr size_t DYN_LDS = 131072;

constexpr size_t WB_WIN = 0;
constexpr size_t WB_WUQ = WB_WIN + 6400ull * 1024;
constexpr size_t WB_WUKV = WB_WUQ + 768ull * 256;
constexpr size_t WB_WBR = WB_WUKV + 1024ull * 128;
constexpr size_t WB_WOUT = WB_WBR + 3ull * 1024 * 512;
constexpr size_t WB_WFI = WB_WOUT + 1024ull * 1024;
constexpr size_t WB_WFO = WB_WFI + 5632ull * 1024;
constexpr size_t WB_ELEMS = WB_WFO + 1024ull * 2816;

constexpr size_t OFF_R0 = 0;
constexpr size_t OFF_R1 = OFF_R0 + WB_ELEMS * 2;
constexpr size_t OFF_R2 = OFF_R1 + 16384ull * 2048 * 2;
constexpr size_t OFF_R3 = OFF_R2 + 16384ull * 1216 * 2;
constexpr size_t OFF_R4 = OFF_R3 + 17408ull * 1280 * 2;
constexpr size_t OFF_GQ = OFF_R4 + 2ull * 16384 * 512 * 2;
constexpr size_t OFF_GK = OFF_GQ + 16384ull * 512 * 2;
constexpr size_t OFF_GV = OFF_GK + 17408ull * 128 * 2;
constexpr size_t OFF_QL = OFF_GV + 17408ull * 128 * 2;
constexpr size_t OFF_CKV = OFF_QL + 16384ull * 256 * 2;
constexpr size_t OFF_KR = OFF_CKV + 17408ull * 128 * 2;
constexpr size_t OFF_G = OFF_KR + 17408ull * 32 * 2;
constexpr size_t OFF_MOD = OFF_G + 16384ull * 16 * 4;
constexpr size_t OFF_CNT = OFF_MOD + 2ull * 5 * 6144 * 4;
constexpr size_t WS_END = OFF_CNT + 4096;

constexpr size_t O_Y = 0;
constexpr size_t O_C = 16777216;
constexpr size_t O_N = O_C + 8388608;
constexpr size_t O_M = O_N + 65536;
constexpr size_t O_CKV = O_M + 512;
constexpr size_t O_KR = O_CKV + 2097152;
constexpr size_t O_GK = O_KR + 524288;
constexpr size_t O_GV = O_GK + 2097152;

struct Params {
  const float *x_prompt, *x_sample, *st_C, *st_n, *st_m, *c_ckv, *c_kr, *c_gk, *c_gv, *c, *c_ctx;
  const float *w_mod, *b_mod, *norm1_g, *w_in, *b_mgate, *m_norm_g, *a_qlora_g, *a_kvlora_g, *w_uq, *w_ukv;
  const float *a_qnorm_g, *a_knorm_g, *g_qnorm_g, *g_knorm_g, *w_branch, *w_out, *norm2_g, *w_ffn_in, *w_ffn_out;
  float* out;
  unsigned char* ws;
  int ph_lo, ph_hi;
};

typedef __bf16 bf16x2_t __attribute__((ext_vector_type(2)));
__device__ __forceinline__ unsigned cvt_pk_bf16(float lo, float hi) {
  f32x2 v = {lo, hi};
  bf16x2_t b = __builtin_convertvector(v, bf16x2_t);
  return __builtin_bit_cast(unsigned, b);
}
__device__ __forceinline__ bf16_t f2bf(float f) { return (bf16_t)(cvt_pk_bf16(f, 0.f) & 0xffffu); }
__device__ __forceinline__ float bf2f(bf16_t v) { return __uint_as_float(((unsigned)v) << 16); }
__device__ __forceinline__ float bflo(unsigned u) { return __uint_as_float(u << 16); }
__device__ __forceinline__ float bfhi(unsigned u) { return __uint_as_float(u & 0xffff0000u); }
__device__ __forceinline__ float wave_sum(float v) {
#pragma unroll
  for (int d = 1; d < 64; d <<= 1) v += __shfl_xor(v, d);
  return v;
}
__device__ __forceinline__ float half_sum(float v) {
#pragma unroll
  for (int d = 1; d < 32; d <<= 1) v += __shfl_xor(v, d);
  return v;
}
__device__ __forceinline__ float wave_max(float v) {
#pragma unroll
  for (int d = 1; d < 64; d <<= 1) v = fmaxf(v, __shfl_xor(v, d));
  return v;
}
__device__ __forceinline__ int opaque_tid() {
  int t = threadIdx.x;
  asm volatile("" : "+v"(t));
  return t;
}
__device__ __forceinline__ float sigmoidf_(float x) { return 1.0f / (1.0f + __expf(-x)); }
__device__ __forceinline__ int rowof(int reg, int h2) { return (reg & 3) + 8 * (reg >> 2) + 4 * h2; }
__device__ __forceinline__ int mod_index(int row) { return row < NCTX ? 0 : 1 + ((row - NCTX) >> 11); }

constexpr int LSTR = 72;
constexpr int A_TILE_EL = 256 * LSTR;
constexpr int B_TILE_EL = 128 * LSTR;
constexpr int STAGE_EL = A_TILE_EL + B_TILE_EL;

template <int NI>
__device__ __forceinline__ void gemm_acc(f32x16 (&acc)[2][NI], const bf16_t* __restrict__ A, int lda, int akstride,
                                         const bf16_t* __restrict__ Bt, int ldb, int nk, bf16_t* lds) {
  const int tid = opaque_tid(), lane = tid & 63, wid = tid >> 6, wm = wid >> 1, wn = wid & 1;
  const int lr = tid >> 3, lc = (tid & 7) * 8;
  u32x4 ra[4], rb[NI];
  const bf16_t* ap = A + (size_t)lr * lda + lc;
  const bf16_t* bp = Bt + (size_t)lr * ldb + lc;
#pragma unroll
  for (int i = 0; i < 4; ++i) ra[i] = *(const u32x4*)(ap + (size_t)(64 * i) * lda);
#pragma unroll
  for (int i = 0; i < NI; ++i) rb[i] = *(const u32x4*)(bp + (size_t)(64 * i) * ldb);
  {
    bf16_t* sA = lds;
    bf16_t* sB = lds + A_TILE_EL;
#pragma unroll
    for (int i = 0; i < 4; ++i) *(u32x4*)(sA + (lr + 64 * i) * LSTR + lc) = ra[i];
#pragma unroll
    for (int i = 0; i < NI; ++i) *(u32x4*)(sB + (lr + 64 * i) * LSTR + lc) = rb[i];
  }
  __syncthreads();
  const int arow = wm * 64 + (lane & 31), brow = wn * (32 * NI) + (lane & 31), kof = (lane >> 5) * 8;
  for (int kt = 0; kt < nk; ++kt) {
    const int cur = kt & 1;
    if (kt + 1 < nk) {
      const bf16_t* ap2 = ap + (size_t)(kt + 1) * akstride;
      const bf16_t* bp2 = bp + (size_t)(kt + 1) * 64;
#pragma unroll
      for (int i = 0; i < 4; ++i) ra[i] = *(const u32x4*)(ap2 + (size_t)(64 * i) * lda);
#pragma unroll
      for (int i = 0; i < NI; ++i) rb[i] = *(const u32x4*)(bp2 + (size_t)(64 * i) * ldb);
    }
    const bf16_t* cA = lds + cur * STAGE_EL;
    const bf16_t* cB = cA + A_TILE_EL;
#pragma unroll
    for (int ks = 0; ks < 4; ++ks) {
      bf16x8 af[2], bfr[NI];
#pragma unroll
      for (int mi = 0; mi < 2; ++mi) af[mi] = *(const bf16x8*)(cA + (arow + mi * 32) * LSTR + ks * 16 + kof);
#pragma unroll
      for (int ni = 0; ni < NI; ++ni) bfr[ni] = *(const bf16x8*)(cB + (brow + ni * 32) * LSTR + ks * 16 + kof);
#pragma unroll
      for (int mi = 0; mi < 2; ++mi)
#pragma unroll
        for (int ni = 0; ni < NI; ++ni)
          acc[mi][ni] = __builtin_amdgcn_mfma_f32_32x32x16_bf16(af[mi], bfr[ni], acc[mi][ni], 0, 0, 0);
    }
    if (kt + 1 < nk) {
      bf16_t* sA = lds + (cur ^ 1) * STAGE_EL;
      bf16_t* sB = sA + A_TILE_EL;
#pragma unroll
      for (int i = 0; i < 4; ++i) *(u32x4*)(sA + (lr + 64 * i) * LSTR + lc) = ra[i];
#pragma unroll
      for (int i = 0; i < NI; ++i) *(u32x4*)(sB + (lr + 64 * i) * LSTR + lc) = rb[i];
    }
    __syncthreads();
  }
}

template <int NI>
__device__ __forceinline__ void zero_acc(f32x16 (&acc)[2][NI]) {
#pragma unroll
  for (int mi = 0; mi < 2; ++mi)
#pragma unroll
    for (int ni = 0; ni < NI; ++ni)
#pragma unroll
      for (int r = 0; r < 16; ++r) acc[mi][ni][r] = 0.f;
}

__device__ void cvt_layer(const Params& p, int l, bf16_t* WB, bf16_t* lds) {
  const int tid = opaque_tid();
  for (int tile = blockIdx.x; tile < 4432; tile += gridDim.x) {
    const float* src;
    bf16_t* dst;
    int K, ld, nvalid, mode = 0, tl = tile;
    if (tl < 1600) { src = p.w_in + (size_t)l * 1024 * DIN; dst = WB + WB_WIN; K = 1024; ld = DIN; nvalid = DIN; }
    else if ((tl -= 1600) < 48) { src = p.w_uq + (size_t)l * 256 * 768; dst = WB + WB_WUQ; K = 256; ld = 768; nvalid = 768; }
    else if ((tl -= 48) < 32) { src = p.w_ukv + (size_t)l * 128 * 1024; dst = WB + WB_WUKV; K = 128; ld = 1024; nvalid = 1024; }
    else if ((tl -= 32) < 384) { int n = tl >> 7; tl &= 127; src = p.w_branch + (size_t)(l * 3 + n) * 512 * 1024; dst = WB + WB_WBR + (size_t)n * 1024 * 512; K = 512; ld = 1024; nvalid = 1024; }
    else if ((tl -= 384) < 256) { src = p.w_out + (size_t)l * 1024 * 1024; dst = WB + WB_WOUT; K = 1024; ld = 1024; nvalid = 1024; }
    else if ((tl -= 256) < 1408) { src = p.w_ffn_in + (size_t)l * 1024 * 5632; dst = WB + WB_WFI; K = 1024; ld = 5632; nvalid = 5632; mode = 1; }
    else { tl -= 1408; src = p.w_ffn_out + (size_t)l * DFF * 1024; dst = WB + WB_WFO; K = DFF; ld = 1024; nvalid = 1024; }
    const int nkt = K >> 6, tn = tl / nkt, tk = tl - tn * nkt;
    const int kk = tid >> 4, n4 = (tid & 15) * 4;
    const int np = tn * 64 + n4;
    int nsrc = np;
    if (mode == 1) { const int g = np >> 6, r = np & 63; nsrc = (r < 32 ? 0 : DFF) + 32 * g + (r & 31); }
    const bool valid = np < nvalid;
#pragma unroll
    for (int i = 0; i < 2; ++i) {
      const int k = kk + 32 * i;
      f32x4 v = {0.f, 0.f, 0.f, 0.f};
      if (valid) v = *(const f32x4*)(src + (size_t)(tk * 64 + k) * ld + nsrc);
      lds[(n4 + 0) * LSTR + k] = f2bf(v[0]);
      lds[(n4 + 1) * LSTR + k] = f2bf(v[1]);
      lds[(n4 + 2) * LSTR + k] = f2bf(v[2]);
      lds[(n4 + 3) * LSTR + k] = f2bf(v[3]);
    }
    __syncthreads();
    {
      const int nl = tid >> 3, kc = (tid & 7) * 8;
      const u32x4 w = *(const u32x4*)(lds + nl * LSTR + kc);
      *(u32x4*)(dst + (size_t)(tn * 64 + nl) * K + tk * 64 + kc) = w;
    }
    __syncthreads();
  }
}

__device__ void mod_phase(const Params& p, float* MOD, float* S) {
  const int tid = opaque_tid();
  float* R = S + 5120;
  for (int i = tid; i < 5120; i += 512) {
    const int j = i >> 10, k = i & 1023;
    const float c = (j == 0) ? p.c_ctx[k] : p.c[(j - 1) * 1024 + k];
    S[i] = c / (1.0f + __expf(-c));
  }
  __syncthreads();
  for (int item = blockIdx.x; item < 384; item += gridDim.x) {
    const int l = item / 192, cgp = item - l * 192, c32 = tid & 31, ks = tid >> 5;
    const float* w = p.w_mod + (size_t)l * 1024 * 6144 + cgp * 32 + c32;
    float a0 = 0.f, a1 = 0.f, a2 = 0.f, a3 = 0.f, a4 = 0.f;
    for (int kk2 = 0; kk2 < 64; ++kk2) {
      const int k = ks * 64 + kk2;
      const float wv = w[(size_t)k * 6144];
      a0 += S[k] * wv; a1 += S[1024 + k] * wv; a2 += S[2048 + k] * wv; a3 += S[3072 + k] * wv; a4 += S[4096 + k] * wv;
    }
    R[(ks * 5 + 0) * 32 + c32] = a0; R[(ks * 5 + 1) * 32 + c32] = a1; R[(ks * 5 + 2) * 32 + c32] = a2;
    R[(ks * 5 + 3) * 32 + c32] = a3; R[(ks * 5 + 4) * 32 + c32] = a4;
    __syncthreads();
    if (tid < 160) {
      const int j = tid >> 5, c = tid & 31;
      float s = 0.f;
      for (int q = 0; q < 16; ++q) s += R[(q * 5 + j) * 32 + c];
      MOD[(size_t)(l * 5 + j) * 6144 + cgp * 32 + c] = s + p.b_mod[l * 6144 + cgp * 32 + c];
    }
    __syncthreads();
  }
}

__device__ void normmod_rows(const Params& p, bool from_input, const float* g, const float* MODl, int sh_off, int sc_off, bf16_t* H) {
  const int tid_ = opaque_tid(), lane = tid_ & 63, wid = tid_ >> 6;
  for (int row = blockIdx.x * 8 + wid; row < NTOK; row += gridDim.x * 8) {
    const float* x = from_input ? (row < NCTX ? p.x_prompt + (size_t)row * 1024 : p.x_sample + (size_t)(row - NCTX) * 1024)
                                : p.out + (size_t)row * 1024;
    const float* md = MODl + mod_index(row) * 6144;
    f32x4 v[4];
    float ss = 0.f;
#pragma unroll
    for (int i = 0; i < 4; ++i) {
      v[i] = *(const f32x4*)(x + i * 256 + lane * 4);
      ss += v[i][0] * v[i][0] + v[i][1] * v[i][1] + v[i][2] * v[i][2] + v[i][3] * v[i][3];
    }
    ss = wave_sum(ss);
    const float rstd = rsqrtf(ss * (1.0f / 1024.0f) + EPS);
#pragma unroll
    for (int i = 0; i < 4; ++i) {
      const int c = i * 256 + lane * 4;
      const f32x4 g4 = *(const f32x4*)(g + c), sc = *(const f32x4*)(md + sc_off + c), sh = *(const f32x4*)(md + sh_off + c);
      float y[4];
#pragma unroll
      for (int e = 0; e < 4; ++e) y[e] = v[i][e] * rstd * g4[e] * (1.0f + sc[e]) + sh[e];
      u32x2 w;
      w.x = cvt_pk_bf16(y[0], y[1]);
      w.y = cvt_pk_bf16(y[2], y[3]);
      *(u32x2*)(H + (size_t)row * 1024 + c) = w;
    }
  }
}

__device__ __forceinline__ void rope_cs(int t, int pidx, int nfreq, float& c, float& s) {
  const int fi = pidx < nfreq ? pidx : pidx - nfreq;
  const float pos = pidx < nfreq ? (float)(t >> 6) : (float)(t & 63);
  const float freq = exp2f(-(float)fi / (float)nfreq * 13.287712379549449f);
  const float ang = pos * freq;
  sincosf(ang, &s, &c);
}

__device__ void post_small(const Params& p, int l, const bf16_t* PS, bf16_t* QL, bf16_t* CKV, bf16_t* KR, bf16_t* GQ, bf16_t* GK, bf16_t* GV) {
  const int tid_ = opaque_tid(), lane = tid_ & 63, wid = tid_ >> 6;
  const int pidx = lane & 31, hh = lane >> 5;
  const float gq_scale = 0.125f * 1.4426950408889634f;
  for (int row = blockIdx.x * 8 + wid; row < NKV; row += gridDim.x * 8) {
    if (row < NTOK) {
      const bf16_t* ps = PS + (size_t)row * 1216;
      const bool ctx = row < NCTX;
      const int b = ctx ? (row >> 8) : ((row - NCTX) >> 11);
      const int t = ctx ? (row & 255) : ((row - NCTX) & 2047);
      const size_t obase = (size_t)((b * 2 + l) * 256 + t);
      {
        const u32x2 w = *(const u32x2*)(ps + 16 + lane * 4);
        float v0 = bflo(w.x), v1 = bfhi(w.x), v2 = bflo(w.y), v3 = bfhi(w.y);
        float ss = wave_sum(v0 * v0 + v1 * v1 + v2 * v2 + v3 * v3);
        const float rstd = rsqrtf(ss * (1.0f / 256.0f) + EPS);
        const f32x4 g4 = *(const f32x4*)(p.a_qlora_g + l * 256 + lane * 4);
        u32x2 o;
        o.x = cvt_pk_bf16(v0 * rstd * g4[0], v1 * rstd * g4[1]);
        o.y = cvt_pk_bf16(v2 * rstd * g4[2], v3 * rstd * g4[3]);
        *(u32x2*)(QL + (size_t)row * 256 + lane * 4) = o;
      }
      {
        const unsigned w = *(const unsigned*)(ps + 272 + lane * 2);
        float v0 = bflo(w), v1 = bfhi(w);
        float ss = wave_sum(v0 * v0 + v1 * v1);
        const float rstd = rsqrtf(ss * (1.0f / 128.0f) + EPS);
        const f32x2 g2 = *(const f32x2*)(p.a_kvlora_g + l * 128 + lane * 2);
        v0 = v0 * rstd * g2[0];
        v1 = v1 * rstd * g2[1];
        *(unsigned*)(CKV + (size_t)row * 128 + lane * 2) = cvt_pk_bf16(v0, v1);
        if (ctx) { f32x2 o = {v0, v1}; *(f32x2*)(p.out + O_CKV + obase * 128 + lane * 2) = o; }
      }
      if (lane < 32) {
        const bf16_t w = ps[400 + lane];
        KR[(size_t)row * 32 + lane] = w;
        if (ctx) p.out[O_KR + obase * 32 + lane] = bf2f(w);
      }
#pragma unroll
      for (int i = 0; i < 4; ++i) {
        const int head = 2 * i + hh;
        float x1 = bf2f(ps[432 + head * 64 + pidx]), x2 = bf2f(ps[432 + head * 64 + pidx + 32]);
        const float ss = half_sum(x1 * x1 + x2 * x2);
        const float rstd = rsqrtf(ss * (1.0f / 64.0f) + EPS);
        x1 = x1 * rstd * p.g_qnorm_g[l * 64 + pidx];
        x2 = x2 * rstd * p.g_qnorm_g[l * 64 + pidx + 32];
        if (!ctx) {
          float c, s;
          rope_cs(t, pidx, 16, c, s);
          const float y1 = x1 * c - x2 * s, y2 = x1 * s + x2 * c;
          x1 = y1; x2 = y2;
        }
        GQ[(size_t)row * 512 + head * 64 + pidx] = f2bf(x1 * gq_scale);
        GQ[(size_t)row * 512 + head * 64 + pidx + 32] = f2bf(x2 * gq_scale);
      }
      {
        const int head = hh;
        float x1 = bf2f(ps[944 + head * 64 + pidx]), x2 = bf2f(ps[944 + head * 64 + pidx + 32]);
        const float ss = half_sum(x1 * x1 + x2 * x2);
        const float rstd = rsqrtf(ss * (1.0f / 64.0f) + EPS);
        x1 = x1 * rstd * p.g_knorm_g[l * 64 + pidx];
        x2 = x2 * rstd * p.g_knorm_g[l * 64 + pidx + 32];
        if (ctx) {
          p.out[O_GK + obase * 128 + head * 64 + pidx] = x1;
          p.out[O_GK + obase * 128 + head * 64 + pidx + 32] = x2;
        } else {
          float c, s;
          rope_cs(t, pidx, 16, c, s);
          const float y1 = x1 * c - x2 * s, y2 = x1 * s + x2 * c;
          x1 = y1; x2 = y2;
        }
        GK[(size_t)row * 128 + head * 64 + pidx] = f2bf(x1);
        GK[(size_t)row * 128 + head * 64 + pidx + 32] = f2bf(x2);
      }
      {
        const unsigned w = *(const unsigned*)(ps + 1072 + lane * 2);
        *(unsigned*)(GV + (size_t)row * 128 + lane * 2) = w;
        if (ctx) { f32x2 o = {bflo(w), bfhi(w)}; *(f32x2*)(p.out + O_GV + obase * 128 + lane * 2) = o; }
      }
    } else {
      const int r = row - NTOK, b = r >> 8, s = r & 255;
      const size_t cb = (size_t)((b * 2 + l) * 256 + s);
      {
        const f32x2 v = *(const f32x2*)(p.c_ckv + cb * 128 + lane * 2);
        *(unsigned*)(CKV + (size_t)row * 128 + lane * 2) = cvt_pk_bf16(v[0], v[1]);
      }
      if (lane < 32) KR[(size_t)row * 32 + lane] = f2bf(p.c_kr[cb * 32 + lane]);
      {
        const f32x2 v = *(const f32x2*)(p.c_gk + cb * 128 + lane * 2);
        *(unsigned*)(GK + (size_t)row * 128 + lane * 2) = cvt_pk_bf16(v[0], v[1]);
      }
      {
        const f32x2 v = *(const f32x2*)(p.c_gv + cb * 128 + lane * 2);
        *(unsigned*)(GV + (size_t)row * 128 + lane * 2) = cvt_pk_bf16(v[0], v[1]);
      }
    }
  }
}

__device__ void post_mla(const Params& p, int l, bf16_t* QA, bf16_t* KAV, const bf16_t* KR) {
  const int tid_ = opaque_tid(), lane = tid_ & 63, wid = tid_ >> 6;
  const int pidx = lane & 31, hh = lane >> 5;
  const float q_scale = 0.10206207261596577f * 1.4426950408889634f;
  const float gk0 = p.a_knorm_g[l * 96 + pidx], gk1 = p.a_knorm_g[l * 96 + 32 + pidx], gk2 = p.a_knorm_g[l * 96 + 64 + pidx];
  const float gq0 = p.a_qnorm_g[l * 96 + pidx], gq1 = p.a_qnorm_g[l * 96 + 32 + pidx], gq2 = p.a_qnorm_g[l * 96 + 64 + pidx];
  for (int row = blockIdx.x * 8 + wid; row < NKV; row += gridDim.x * 8) {
    const bool lat = (row >= NCTX) && (row < NTOK);
    const int t = (row - NCTX) & 2047;
    float c = 1.f, s = 0.f;
    if (lat) rope_cs(t, pidx & 15, 8, c, s);
    const float kr = bf2f(KR[(size_t)row * 32 + pidx]);
#pragma unroll
    for (int i = 0; i < 4; ++i) {
      const int head = 2 * i + hh;
      bf16_t* kp = KAV + (size_t)row * 1280 + head * 160;
      float e0 = bf2f(kp[pidx]), e1 = bf2f(kp[32 + pidx]), e2 = kr;
      const float ss = half_sum(e0 * e0 + e1 * e1 + e2 * e2);
      const float rstd = rsqrtf(ss * (1.0f / 96.0f) + EPS);
      e0 *= rstd * gk0; e1 *= rstd * gk1; e2 *= rstd * gk2;
      if (lat) {
        const float other = __shfl_xor(e2, 16);
        e2 = (pidx < 16) ? (e2 * c - other * s) : (other * s + e2 * c);
      }
      kp[pidx] = f2bf(e0); kp[32 + pidx] = f2bf(e1); kp[64 + pidx] = f2bf(e2);
    }
    if (row < NTOK) {
#pragma unroll
      for (int i = 0; i < 4; ++i) {
        const int head = 2 * i + hh;
        bf16_t* qp = QA + (size_t)row * 768 + head * 96;
        float e0 = bf2f(qp[pidx]), e1 = bf2f(qp[32 + pidx]), e2 = bf2f(qp[64 + pidx]);
        const float ss = half_sum(e0 * e0 + e1 * e1 + e2 * e2);
        const float rstd = rsqrtf(ss * (1.0f / 96.0f) + EPS);
        e0 *= rstd * gq0; e1 *= rstd * gq1; e2 *= rstd * gq2;
        if (lat) {
          const float other = __shfl_xor(e2, 16);
          e2 = (pidx < 16) ? (e2 * c - other * s) : (other * s + e2 * c);
        }
        qp[pidx] = f2bf(e0 * q_scale); qp[32 + pidx] = f2bf(e1 * q_scale); qp[64 + pidx] = f2bf(e2 * q_scale);
      }
    }
  }
}

__device__ void post_mlstm(const Params& p, int l, bf16_t* HF, const bf16_t* HB, const bf16_t* PM) {
  const int tid_ = opaque_tid(), lane = tid_ & 63, wid = tid_ >> 6;
  const f32x2 g2 = *(const f32x2*)(p.m_norm_g + l * 128 + lane * 2);
  for (int row = blockIdx.x * 8 + wid; row < NTOK; row += gridDim.x * 8) {
#pragma unroll
    for (int h = 0; h < 4; ++h) {
      const unsigned wf = *(const unsigned*)(HF + (size_t)row * 512 + h * 128 + lane * 2);
      const unsigned wb = *(const unsigned*)(HB + (size_t)row * 512 + h * 128 + lane * 2);
      const unsigned wo = *(const unsigned*)(PM + (size_t)row * 2048 + 1536 + h * 128 + lane * 2);
      float v0 = bflo(wf) + bflo(wb), v1 = bfhi(wf) + bfhi(wb);
      const float ss = wave_sum(v0 * v0 + v1 * v1);
      const float rstd = rsqrtf(ss * (1.0f / 128.0f) + EPS);
      v0 = v0 * rstd * g2[0] * sigmoidf_(bflo(wo));
      v1 = v1 * rstd * g2[1] * sigmoidf_(bfhi(wo));
      *(unsigned*)(HF + (size_t)row * 512 + h * 128 + lane * 2) = cvt_pk_bf16(v0, v1);
    }
  }
}

template <int DQK>
__device__ __forceinline__ void attn_item(const bf16_t* qptr, bf16_t* optr, const bf16_t* Kb, int kstride, const bf16_t* Vb, int vstride,
                                          int seg0_row, int seg0_tiles, int seg1_row, int ntiles, bf16_t* lds) {
  constexpr int KSTR = DQK + 8, KT_EL = 64 * KSTR, VT_EL = 64 * 72, ST_EL = KT_EL + VT_EL, NKK = DQK / 16, KCH = DQK / 8;
  const int tid = opaque_tid(), lane = tid & 63, h2 = lane >> 5, r = lane & 31;
  bf16x8 qf[NKK];
#pragma unroll
  for (int kk = 0; kk < NKK; ++kk) qf[kk] = *(const bf16x8*)(qptr + kk * 16 + h2 * 8);
  f32x16 o0, o1;
#pragma unroll
  for (int i = 0; i < 16; ++i) { o0[i] = 0.f; o1[i] = 0.f; }
  float m_run = -1e30f, l_run = 0.f;
  const int key0 = tid / KCH, c0 = tid - key0 * KCH;
  const int id1 = tid + 512, key1 = id1 / KCH, c1 = id1 - key1 * KCH;
  const bool has1 = (DQK == 96) && (tid < 256);
  const int vkey = tid >> 3, vc = tid & 7;
  const int vpos = (vkey & ~12) | ((vkey & 4) << 1) | ((vkey & 8) >> 1);
  u32x4 kr0, kr1 = {0u, 0u, 0u, 0u}, vr;
  {
    const int row0 = (0 < seg0_tiles) ? seg0_row : seg1_row;
    kr0 = *(const u32x4*)(Kb + (size_t)(row0 + key0) * kstride + c0 * 8);
    if (has1) kr1 = *(const u32x4*)(Kb + (size_t)(row0 + key1) * kstride + c1 * 8);
    vr = *(const u32x4*)(Vb + (size_t)(row0 + vkey) * vstride + vc * 8);
  }
#define ATTN_STORE(buf)                                                                      \
  {                                                                                          \
    bf16_t* sK_ = lds + (buf) * ST_EL;                                                       \
    bf16_t* sV_ = sK_ + KT_EL;                                                               \
    *(u32x4*)(sK_ + key0 * KSTR + c0 * 8) = kr0;                                             \
    if (has1) *(u32x4*)(sK_ + key1 * KSTR + c1 * 8) = kr1;                                   \
    sV_[(vc * 8 + 0) * 72 + vpos] = (bf16_t)(vr.x & 0xffffu);                                \
    sV_[(vc * 8 + 1) * 72 + vpos] = (bf16_t)(vr.x >> 16);                                    \
    sV_[(vc * 8 + 2) * 72 + vpos] = (bf16_t)(vr.y & 0xffffu);                                \
    sV_[(vc * 8 + 3) * 72 + vpos] = (bf16_t)(vr.y >> 16);                                    \
    sV_[(vc * 8 + 4) * 72 + vpos] = (bf16_t)(vr.z & 0xffffu);                                \
    sV_[(vc * 8 + 5) * 72 + vpos] = (bf16_t)(vr.z >> 16);                                    \
    sV_[(vc * 8 + 6) * 72 + vpos] = (bf16_t)(vr.w & 0xffffu);                                \
    sV_[(vc * 8 + 7) * 72 + vpos] = (bf16_t)(vr.w >> 16);                                    \
  }
  ATTN_STORE(0);
  __syncthreads();
  for (int j = 0; j < ntiles; ++j) {
    const int cur = j & 1;
    if (j + 1 < ntiles) {
      const int jn = j + 1;
      const int row0 = (jn < seg0_tiles) ? seg0_row + jn * 64 : seg1_row + (jn - seg0_tiles) * 64;
      kr0 = *(const u32x4*)(Kb + (size_t)(row0 + key0) * kstride + c0 * 8);
      if (has1) kr1 = *(const u32x4*)(Kb + (size_t)(row0 + key1) * kstride + c1 * 8);
      vr = *(const u32x4*)(Vb + (size_t)(row0 + vkey) * vstride + vc * 8);
    }
    const bf16_t* sK = lds + cur * ST_EL;
    const bf16_t* sV = sK + KT_EL;
#pragma unroll
    for (int u = 0; u < 2; ++u) {
      f32x16 s;
#pragma unroll
      for (int i = 0; i < 16; ++i) s[i] = 0.f;
#pragma unroll
      for (int kk = 0; kk < NKK; ++kk) {
        const bf16x8 a = *(const bf16x8*)(sK + (u * 32 + r) * KSTR + kk * 16 + h2 * 8);
        s = __builtin_amdgcn_mfma_f32_32x32x16_bf16(a, qf[kk], s, 0, 0, 0);
      }
      float mx = s[0];
#pragma unroll
      for (int i = 1; i < 16; ++i) mx = fmaxf(mx, s[i]);
      mx = fmaxf(mx, __shfl_xor(mx, 32));
      const float m_new = fmaxf(m_run, mx);
      const float alpha = exp2f(m_run - m_new);
      float ls = 0.f;
#pragma unroll
      for (int i = 0; i < 16; ++i) { s[i] = exp2f(s[i] - m_new); ls += s[i]; }
      l_run = l_run * alpha + ls;
      m_run = m_new;
#pragma unroll
      for (int i = 0; i < 16; ++i) { o0[i] *= alpha; o1[i] *= alpha; }
      u32x4 pa, pb;
      pa.x = cvt_pk_bf16(s[0], s[1]); pa.y = cvt_pk_bf16(s[2], s[3]); pa.z = cvt_pk_bf16(s[4], s[5]); pa.w = cvt_pk_bf16(s[6], s[7]);
      pb.x = cvt_pk_bf16(s[8], s[9]); pb.y = cvt_pk_bf16(s[10], s[11]); pb.z = cvt_pk_bf16(s[12], s[13]); pb.w = cvt_pk_bf16(s[14], s[15]);
      const bf16x8 pf0 = __builtin_bit_cast(bf16x8, pa), pf1 = __builtin_bit_cast(bf16x8, pb);
      {
        const bf16x8 a0 = *(const bf16x8*)(sV + r * 72 + u * 32 + h2 * 8);
        const bf16x8 a1 = *(const bf16x8*)(sV + (32 + r) * 72 + u * 32 + h2 * 8);
        o0 = __builtin_amdgcn_mfma_f32_32x32x16_bf16(a0, pf0, o0, 0, 0, 0);
        o1 = __builtin_amdgcn_mfma_f32_32x32x16_bf16(a1, pf0, o1, 0, 0, 0);
      }
      {
        const bf16x8 a0 = *(const bf16x8*)(sV + r * 72 + u * 32 + 16 + h2 * 8);
        const bf16x8 a1 = *(const bf16x8*)(sV + (32 + r) * 72 + u * 32 + 16 + h2 * 8);
        o0 = __builtin_amdgcn_mfma_f32_32x32x16_bf16(a0, pf1, o0, 0, 0, 0);
        o1 = __builtin_amdgcn_mfma_f32_32x32x16_bf16(a1, pf1, o1, 0, 0, 0);
      }
    }
    if (j + 1 < ntiles) ATTN_STORE(cur ^ 1);
    __syncthreads();
  }
#undef ATTN_STORE
  const float l_tot = l_run + __shfl_xor(l_run, 32);
  const float inv = 1.0f / l_tot;
#pragma unroll
  for (int g = 0; g < 4; ++g) {
    u32x2 w0, w1;
    w0.x = cvt_pk_bf16(o0[4 * g] * inv, o0[4 * g + 1] * inv);
    w0.y = cvt_pk_bf16(o0[4 * g + 2] * inv, o0[4 * g + 3] * inv);
    w1.x = cvt_pk_bf16(o1[4 * g] * inv, o1[4 * g + 1] * inv);
    w1.y = cvt_pk_bf16(o1[4 * g + 2] * inv, o1[4 * g + 3] * inv);
    *(u32x2*)(optr + 8 * g + 4 * h2) = w0;
    *(u32x2*)(optr + 32 + 8 * g + 4 * h2) = w1;
  }
}

__device__ void mlstm_chain(const Params& p, int l, bool lat, int b, int h, int dir, const bf16_t* PM, const float* G, bf16_t* Hout, bf16_t* lds) {
  const int tid = opaque_tid(), lane = tid & 63, wid = tid >> 6, h2 = lane >> 5, r = lane & 31;
  const int T = lat ? 2048 : 256, base_row = lat ? NCTX + b * 2048 : b * 256, nc = T >> 6;
  const float kscale = 0.08838834764831845f;
  bf16_t* Qs = lds;
  bf16_t* Ks = Qs + 64 * 136;
  bf16_t* KwT = Ks + 64 * 136;
  bf16_t* VT = KwT + 128 * 72;
  bf16_t* CT = VT + 128 * 72;
  bf16_t* Ss = CT + 128 * 136;
  float* F = (float*)(Ss + 64 * 72);
  float* icv = F; float* fcv = F + 64; float* e1v = F + 128; float* av = F + 192; float* mtv = F + 256;
  float* winv = F + 320; float* wgkv = F + 384; float* qnv = F + 448; float* hdv = F + 512; float* nvec = F + 576; float* scal = F + 704;
  const int dkt = wid >> 1, dvt0 = (wid & 1) * 2;
  const int lt = wid >> 2, dvt = wid & 3;
  f32x16 accC[2];
  float m_state = 0.f;
  const size_t sidx = (size_t)(((b * 2 + l) * 2 + dir) * 4 + h);
  if (lat) {
#pragma unroll
    for (int i = 0; i < 2; ++i)
#pragma unroll
      for (int rg = 0; rg < 16; ++rg)
        accC[i][rg] = p.st_C[sidx * 16384 + (size_t)(dkt * 32 + rowof(rg, h2)) * 128 + (dvt0 + i) * 32 + r];
    asm volatile("" ::: "memory");
    if (tid < 128) nvec[tid] = p.st_n[sidx * 128 + tid];
    m_state = p.st_m[sidx];
  } else {
#pragma unroll
    for (int i = 0; i < 2; ++i)
#pragma unroll
      for (int rg = 0; rg < 16; ++rg) accC[i][rg] = 0.f;
    if (tid < 128) nvec[tid] = 0.f;
  }
#pragma unroll
  for (int i = 0; i < 2; ++i)
#pragma unroll
    for (int g = 0; g < 4; ++g) {
      u32x2 w;
      w.x = cvt_pk_bf16(accC[i][4 * g], accC[i][4 * g + 1]);
      w.y = cvt_pk_bf16(accC[i][4 * g + 2], accC[i][4 * g + 3]);
      *(u32x2*)(CT + ((dvt0 + i) * 32 + r) * 136 + dkt * 32 + 8 * g + 4 * h2) = w;
    }
  const int j0 = tid >> 4, cc = tid & 15;
  u32x4 rq[2], rk[2], rv[2];
  float gi = 0.f, gf = 0.f;
#define MLSTM_ROW(c, j) (base_row + (dir ? (T - 1 - ((c) * 64 + (j))) : ((c) * 64 + (j))))
#define MLSTM_LOAD(c)                                                                     \
  {                                                                                       \
    _Pragma("unroll") for (int i = 0; i < 2; ++i) {                                       \
      const size_t rr = (size_t)MLSTM_ROW(c, j0 + 32 * i) * 2048 + h * 128 + cc * 8;      \
      rq[i] = *(const u32x4*)(PM + rr);                                                   \
      rk[i] = *(const u32x4*)(PM + rr + 512);                                             \
      rv[i] = *(const u32x4*)(PM + rr + 1024);                                            \
    }                                                                                     \
    if (tid < 64) {                                                                       \
      const size_t gr = (size_t)MLSTM_ROW(c, tid) * 16;                                   \
      gi = G[gr + (2 * dir) * 4 + h];                                                     \
      gf = G[gr + (2 * dir + 1) * 4 + h];                                                 \
    }                                                                                     \
  }
  MLSTM_LOAD(0);
  for (int c = 0; c < nc; ++c) {
#pragma unroll
    for (int i = 0; i < 2; ++i) {
      const int j = j0 + 32 * i;
      *(u32x4*)(Qs + j * 136 + cc * 8) = rq[i];
      *(u32x4*)(Ks + j * 136 + cc * 8) = rk[i];
      VT[(cc * 8 + 0) * 72 + j] = (bf16_t)(rv[i].x & 0xffffu);
      VT[(cc * 8 + 1) * 72 + j] = (bf16_t)(rv[i].x >> 16);
      VT[(cc * 8 + 2) * 72 + j] = (bf16_t)(rv[i].y & 0xffffu);
      VT[(cc * 8 + 3) * 72 + j] = (bf16_t)(rv[i].y >> 16);
      VT[(cc * 8 + 4) * 72 + j] = (bf16_t)(rv[i].z & 0xffffu);
      VT[(cc * 8 + 5) * 72 + j] = (bf16_t)(rv[i].z >> 16);
      VT[(cc * 8 + 6) * 72 + j] = (bf16_t)(rv[i].w & 0xffffu);
      VT[(cc * 8 + 7) * 72 + j] = (bf16_t)(rv[i].w >> 16);
    }
    if (tid < 64) {
      icv[tid] = gi;
      fcv[tid] = fminf(gf, 0.f) - log1pf(__expf(-fabsf(gf)));
    }
    if (c + 1 < nc) MLSTM_LOAD(c + 1);
    __syncthreads();
    if (wid == 0) {
      const float iv = icv[lane];
      float bc = fcv[lane];
#pragma unroll
      for (int d = 1; d < 64; d <<= 1) { const float tt = __shfl_up(bc, d); if (lane >= d) bc += tt; }
      const float a = iv - bc;
      float pm = a;
#pragma unroll
      for (int d = 1; d < 64; d <<= 1) { const float tt = __shfl_up(pm, d); if (lane >= d) pm = fmaxf(pm, tt); }
      const float mt = bc + fmaxf(m_state, pm);
      const float tot = __shfl(bc, 63);
      const float gg = tot + a;
      const float gmax = wave_max(gg);
      const float total = tot + m_state;
      const float m_new = fmaxf(total, gmax);
      e1v[lane] = bc - mt;
      av[lane] = a;
      mtv[lane] = mt;
      winv[lane] = __expf(bc + m_state - mt);
      wgkv[lane] = __expf(gg - m_new) * kscale;
      if (lane == 0) scal[0] = __expf(total - m_new);
      m_state = m_new;
    }
    __syncthreads();
    {
      const int j = tid & 63;
      const float wk = wgkv[j];
#pragma unroll
      for (int i = 0; i < 2; ++i) {
        const int dkb = (tid >> 6) * 8 + 64 * i;
        const u32x4 w = *(const u32x4*)(Ks + j * 136 + dkb);
        KwT[(dkb + 0) * 72 + j] = f2bf(bflo(w.x) * wk);
        KwT[(dkb + 1) * 72 + j] = f2bf(bfhi(w.x) * wk);
        KwT[(dkb + 2) * 72 + j] = f2bf(bflo(w.y) * wk);
        KwT[(dkb + 3) * 72 + j] = f2bf(bfhi(w.y) * wk);
        KwT[(dkb + 4) * 72 + j] = f2bf(bflo(w.z) * wk);
        KwT[(dkb + 5) * 72 + j] = f2bf(bfhi(w.z) * wk);
        KwT[(dkb + 6) * 72 + j] = f2bf(bflo(w.w) * wk);
        KwT[(dkb + 7) * 72 + j] = f2bf(bfhi(w.w) * wk);
      }
    }
    if (wid < 4) {
      const int lt2 = wid >> 1, st = wid & 1;
      f32x16 sacc;
#pragma unroll
      for (int i = 0; i < 16; ++i) sacc[i] = 0.f;
#pragma unroll
      for (int kk = 0; kk < 8; ++kk) {
        const bf16x8 a = *(const bf16x8*)(Qs + (lt2 * 32 + r) * 136 + kk * 16 + h2 * 8);
        const bf16x8 bk = *(const bf16x8*)(Ks + (st * 32 + r) * 136 + kk * 16 + h2 * 8);
        sacc = __builtin_amdgcn_mfma_f32_32x32x16_bf16(a, bk, sacc, 0, 0, 0);
      }
      const int scol = st * 32 + r;
      const float as = av[scol];
#pragma unroll
      for (int rg = 0; rg < 16; ++rg) {
        const int lrow = lt2 * 32 + rowof(rg, h2);
        const float val = (scol <= lrow) ? sacc[rg] * kscale * __expf(e1v[lrow] + as) : 0.f;
        Ss[lrow * 72 + scol] = f2bf(val);
      }
    }
    f32x16 acc;
#pragma unroll
    for (int i = 0; i < 16; ++i) acc[i] = 0.f;
#pragma unroll
    for (int kk = 0; kk < 8; ++kk) {
      const bf16x8 a = *(const bf16x8*)(Qs + (lt * 32 + r) * 136 + kk * 16 + h2 * 8);
      const bf16x8 bq = *(const bf16x8*)(CT + (dvt * 32 + r) * 136 + kk * 16 + h2 * 8);
      acc = __builtin_amdgcn_mfma_f32_32x32x16_bf16(a, bq, acc, 0, 0, 0);
    }
#pragma unroll
    for (int rg = 0; rg < 16; ++rg) acc[rg] *= winv[lt * 32 + rowof(rg, h2)];
    {
      const int lq = tid >> 3, part = tid & 7;
      float sq = 0.f;
#pragma unroll
      for (int e = 0; e < 16; ++e) sq += bf2f(Qs[lq * 136 + part * 16 + e]) * nvec[part * 16 + e];
      sq += __shfl_xor(sq, 1); sq += __shfl_xor(sq, 2); sq += __shfl_xor(sq, 4);
      if (part == 0) qnv[lq] = sq;
    }
    __syncthreads();
#pragma unroll
    for (int ks = 0; ks < 4; ++ks) {
      const bf16x8 a = *(const bf16x8*)(Ss + (lt * 32 + r) * 72 + ks * 16 + h2 * 8);
      const bf16x8 bv = *(const bf16x8*)(VT + (dvt * 32 + r) * 72 + ks * 16 + h2 * 8);
      acc = __builtin_amdgcn_mfma_f32_32x32x16_bf16(a, bv, acc, 0, 0, 0);
    }
    {
      const int lq = tid >> 3, part = tid & 7;
      float rs = 0.f;
#pragma unroll
      for (int e = 0; e < 8; ++e) rs += bf2f(Ss[lq * 72 + part * 8 + e]);
      rs += __shfl_xor(rs, 1); rs += __shfl_xor(rs, 2); rs += __shfl_xor(rs, 4);
      if (part == 0) {
        const float den = qnv[lq] * winv[lq] + rs;
        hdv[lq] = 1.0f / fmaxf(fabsf(den), __expf(-mtv[lq]));
      }
    }
    {
      const float decay = scal[0];
#pragma unroll
      for (int i = 0; i < 2; ++i) {
#pragma unroll
        for (int rg = 0; rg < 16; ++rg) accC[i][rg] *= decay;
#pragma unroll
        for (int ks = 0; ks < 4; ++ks) {
          const bf16x8 a = *(const bf16x8*)(KwT + (dkt * 32 + r) * 72 + ks * 16 + h2 * 8);
          const bf16x8 bv = *(const bf16x8*)(VT + ((dvt0 + i) * 32 + r) * 72 + ks * 16 + h2 * 8);
          accC[i] = __builtin_amdgcn_mfma_f32_32x32x16_bf16(a, bv, accC[i], 0, 0, 0);
        }
#pragma unroll
        for (int g = 0; g < 4; ++g) {
          u32x2 w;
          w.x = cvt_pk_bf16(accC[i][4 * g], accC[i][4 * g + 1]);
          w.y = cvt_pk_bf16(accC[i][4 * g + 2], accC[i][4 * g + 3]);
          *(u32x2*)(CT + ((dvt0 + i) * 32 + r) * 136 + dkt * 32 + 8 * g + 4 * h2) = w;
        }
      }
      if (tid < 128) {
        float sn = 0.f;
        for (int s = 0; s < 64; ++s) sn += wgkv[s] * bf2f(Ks[s * 136 + tid]);
        nvec[tid] = nvec[tid] * decay + sn;
      }
    }
    __syncthreads();
#pragma unroll
    for (int rg = 0; rg < 16; ++rg) {
      const int lrow = lt * 32 + rowof(rg, h2);
      Hout[(size_t)MLSTM_ROW(c, lrow) * 512 + h * 128 + dvt * 32 + r] = f2bf(acc[rg] * hdv[lrow]);
    }
  }
#undef MLSTM_LOAD
#undef MLSTM_ROW
  if (!lat) {
#pragma unroll
    for (int i = 0; i < 2; ++i)
#pragma unroll
      for (int rg = 0; rg < 16; ++rg)
        p.out[O_C + sidx * 16384 + (size_t)(dkt * 32 + rowof(rg, h2)) * 128 + (dvt0 + i) * 32 + r] = accC[i][rg];
    if (tid < 128) p.out[O_N + sidx * 128 + tid] = nvec[tid];
    if (tid == 0) p.out[O_M + sidx] = m_state;
  }
  __syncthreads();
}

__device__ void mixers_phase(const Params& p, int l, unsigned* counter, const bf16_t* PM, const float* G, bf16_t* HF, bf16_t* HB,
                             bf16_t* QA, const bf16_t* KAV, bf16_t* GQ, const bf16_t* GK, const bf16_t* GV, bf16_t* lds) {
  const int tid = opaque_tid(), lane = tid & 63, wid = tid >> 6, r = lane & 31;
  int* slot = (int*)((unsigned char*)lds + 130048);
#ifndef STATIC_SCHED
#define STATIC_SCHED 1
#endif
  for (int it_ = 0;; ++it_) {
#if STATIC_SCHED
    const int item = blockIdx.x + it_ * gridDim.x;
    (void)slot; (void)counter;
#else
    if (tid == 0) *slot = (int)atomicAdd(counter, 1u);
    __syncthreads();
    const int item = *slot;
    __syncthreads();
#endif
    if (item >= 1088) break;
    if (item < 64) {
#if MIXSEL & 1
      const bool lat = item < 32;
      const int nch = lat ? 1 : 8, ch0 = lat ? item : (item - 32) * 8;
      for (int q = 0; q < nch; ++q) {
        const int ch = ch0 + q;
        const int dir = ch & 1, h = (ch >> 1) & 3, b = ch >> 3;
        mlstm_chain(p, l, lat, b, h, dir, PM, G, dir ? HB : HF, lds);
      }
#endif
    } else if (item < 320 || (item >= 576 && item < 832)) {
#if MIXSEL & 2
      const bool lat = item < 320;
      const int i = lat ? item - 64 : item - 576;
      const int b = lat ? (i >> 6) : (i >> 3), h = lat ? ((i >> 3) & 7) : (i & 7), qt = lat ? (i & 7) : 0;
      const int own0 = lat ? NCTX + b * 2048 : b * 256;
      const int qrow = own0 + qt * 256 + wid * 32 + r;
      bf16_t* qp = QA + (size_t)qrow * 768 + h * 96;
      attn_item<96>(qp, qp, KAV + h * 160, 1280, KAV + h * 160 + 96, 1280, NTOK + b * 256, lat ? 4 : 0, own0, lat ? 36 : 4, lds);
#endif
    } else {
#if MIXSEL & 4
      const bool lat = item < 576;
      const int i = lat ? item - 320 : item - 832;
      const int b = lat ? (i >> 6) : (i >> 3), kvh = lat ? ((i >> 5) & 1) : ((i >> 2) & 1), tile = lat ? (i & 31) : (i & 3);
      const int own0 = lat ? NCTX + b * 2048 : b * 256;
      const int head = kvh * 4 + (wid >> 1);
      const int qrow = own0 + tile * 64 + (wid & 1) * 32 + r;
      bf16_t* qp = GQ + (size_t)qrow * 512 + head * 64;
      attn_item<64>(qp, qp, GK + kvh * 64, 128, GV + kvh * 64, 128, NTOK + b * 256, lat ? 4 : 0, own0, lat ? 36 : 4, lds);
#endif
    }
  }
}

__global__ void __launch_bounds__(512) fwd_megakernel(Params p) {
  extern __shared__ __attribute__((aligned(16))) unsigned char smem[];
  bf16_t* lds = (bf16_t*)smem;
  cg::grid_group grid = cg::this_grid();
  unsigned char* ws = p.ws;
  bf16_t* WB = (bf16_t*)(ws + OFF_R0);
  bf16_t* PM = (bf16_t*)(ws + OFF_R1);
  bf16_t* MIX = (bf16_t*)(ws + OFF_R1);
  bf16_t* ACT = (bf16_t*)(ws + OFF_R1);
  bf16_t* PS = (bf16_t*)(ws + OFF_R2);
  bf16_t* QA = (bf16_t*)(ws + OFF_R2);
  bf16_t* KAV = (bf16_t*)(ws + OFF_R3);
  bf16_t* H = (bf16_t*)(ws + OFF_R3);
  bf16_t* HF = (bf16_t*)(ws + OFF_R4);
  bf16_t* HB = HF + (size_t)NTOK * 512;
  bf16_t* GQ = (bf16_t*)(ws + OFF_GQ);
  bf16_t* GK = (bf16_t*)(ws + OFF_GK);
  bf16_t* GV = (bf16_t*)(ws + OFF_GV);
  bf16_t* QL = (bf16_t*)(ws + OFF_QL);
  bf16_t* CKV = (bf16_t*)(ws + OFF_CKV);
  bf16_t* KR = (bf16_t*)(ws + OFF_KR);
  float* G = (float*)(ws + OFF_G);
  float* MOD = (float*)(ws + OFF_MOD);
  unsigned* CNT = (unsigned*)(ws + OFF_CNT);

#ifdef DUMP_OFF
  if (p.ph_lo == 99) {
    const bf16_t* X = (const bf16_t*)(ws + DUMP_OFF);
    for (size_t i = (size_t)blockIdx.x * 512 + threadIdx.x; i < 16777216ull; i += (size_t)gridDim.x * 512) p.out[i] = bf2f(X[i]);
    return;
  }
#endif
  for (int ph = p.ph_lo; ph < p.ph_hi; ++ph) {
    const int tid = opaque_tid(), lane = tid & 63, wid = tid >> 6, wm = wid >> 1, wn = wid & 1, h2 = lane >> 5, r = lane & 31;
    if (ph == 0) {
      if (blockIdx.x == 0 && tid < 64) CNT[tid] = 0u;
      cvt_layer(p, 0, WB, lds);
      mod_phase(p, MOD, (float*)smem);
    } else {
      const int l = (ph - 1) / 12, sp = (ph - 1) % 12;
      const float* MODl = MOD + (size_t)l * 5 * 6144;
      if (sp == 0) {
        if (l == 1) cvt_layer(p, 1, WB, lds);
        normmod_rows(p, l == 0, p.norm1_g + l * 1024, MODl, 0, 1024, H);
      } else if (sp == 1) {
        for (int tile = blockIdx.x; tile < 64 * 26; tile += gridDim.x) {
          const int tm = tile & 63, tn = tile >> 6;
          f32x16 acc[2][2];
          zero_acc<2>(acc);
          gemm_acc<2>(acc, H + (size_t)tm * 256 * 1024, 1024, 64, WB + WB_WIN + (size_t)(3072 + tn * 128) * 1024, 1024, 16, lds);
#pragma unroll
          for (int mi = 0; mi < 2; ++mi)
#pragma unroll
            for (int ni = 0; ni < 2; ++ni) {
              const int col = tn * 128 + wn * 64 + ni * 32 + r;
#pragma unroll
              for (int rg = 0; rg < 16; ++rg) {
                const int row = tm * 256 + wm * 64 + mi * 32 + rowof(rg, h2);
                const float v = acc[mi][ni][rg];
                if (tn < 16) PM[(size_t)row * 2048 + col] = f2bf(v);
                else {
                  const int c2 = col - 2048;
                  if (c2 < 1200) PS[(size_t)row * 1216 + c2] = f2bf(v);
                  if (c2 < 16) G[(size_t)row * 16 + c2] = v + p.b_mgate[l * 16 + c2];
                }
              }
            }
        }
      } else if (sp == 2) {
        post_small(p, l, PS, QL, CKV, KR, GQ, GK, GV);
      } else if (sp == 3) {
        for (int tile = blockIdx.x; tile < 384 + 544; tile += gridDim.x) {
          f32x16 acc[2][2];
          zero_acc<2>(acc);
          if (tile < 384) {
            const int tm = tile & 63, tn = tile >> 6;
            gemm_acc<2>(acc, QL + (size_t)tm * 256 * 256, 256, 64, WB + WB_WUQ + (size_t)tn * 128 * 256, 256, 4, lds);
#pragma unroll
            for (int mi = 0; mi < 2; ++mi)
#pragma unroll
              for (int ni = 0; ni < 2; ++ni) {
                const int col = tn * 128 + wn * 64 + ni * 32 + r;
#pragma unroll
                for (int rg = 0; rg < 16; ++rg) {
                  const int row = tm * 256 + wm * 64 + mi * 32 + rowof(rg, h2);
                  QA[(size_t)row * 768 + col] = f2bf(acc[mi][ni][rg]);
                }
              }
          } else {
            const int t2 = tile - 384, tm = t2 % 68, tn = t2 / 68;
            gemm_acc<2>(acc, CKV + (size_t)tm * 256 * 128, 128, 64, WB + WB_WUKV + (size_t)tn * 128 * 128, 128, 2, lds);
#pragma unroll
            for (int mi = 0; mi < 2; ++mi)
#pragma unroll
              for (int ni = 0; ni < 2; ++ni) {
                const int col = tn * 128 + wn * 64 + ni * 32 + r;
                const int hd = col >> 7, jj = col & 127;
                const int dcol = hd * 160 + (jj < 64 ? jj : jj + 32);
#pragma unroll
                for (int rg = 0; rg < 16; ++rg) {
                  const int row = tm * 256 + wm * 64 + mi * 32 + rowof(rg, h2);
                  KAV[(size_t)row * 1280 + dcol] = f2bf(acc[mi][ni][rg]);
                }
              }
          }
        }
      } else if (sp == 4) {
        post_mla(p, l, QA, KAV, KR);
      } else if (sp == 5) {
        mixers_phase(p, l, CNT + l, PM, G, HF, HB, QA, KAV, GQ, GK, GV, lds);
      } else if (sp == 6) {
        post_mlstm(p, l, HF, HB, PM);
        normmod_rows(p, l == 0, p.norm1_g + l * 1024, MODl, 0, 1024, H);
      } else if (sp == 7) {
        for (int tile = blockIdx.x; tile < 1024; tile += gridDim.x) {
          const int tm = tile & 63, tn = tile >> 6;
          f32x16 mix[2][1];
          zero_acc<1>(mix);
#pragma unroll 1
          for (int n = 0; n < 3; ++n) {
            f32x16 ag[2][1], ab[2][1];
            zero_acc<1>(ag);
            zero_acc<1>(ab);
            gemm_acc<1>(ag, H + (size_t)tm * 256 * 1024, 1024, 64, WB + WB_WIN + (size_t)(n * 1024 + tn * 64) * 1024, 1024, 16, lds);
            const bf16_t* Ab = (n == 0) ? HF + (size_t)tm * 256 * 512 : (n == 1) ? QA + (size_t)tm * 256 * 768 : GQ + (size_t)tm * 256 * 512;
            const int ldab = (n == 1) ? 768 : 512, aks = (n == 1) ? 96 : 64;
            gemm_acc<1>(ab, Ab, ldab, aks, WB + WB_WBR + (size_t)n * 1024 * 512 + (size_t)tn * 64 * 512, 512, 8, lds);
#pragma unroll
            for (int mi = 0; mi < 2; ++mi)
#pragma unroll
              for (int rg = 0; rg < 16; ++rg) mix[mi][0][rg] += sigmoidf_(ag[mi][0][rg]) * ab[mi][0][rg];
          }
#pragma unroll
          for (int mi = 0; mi < 2; ++mi) {
            const int col = tn * 64 + wn * 32 + r;
#pragma unroll
            for (int rg = 0; rg < 16; ++rg) {
              const int row = tm * 256 + wm * 64 + mi * 32 + rowof(rg, h2);
              MIX[(size_t)row * 1024 + col] = f2bf(mix[mi][0][rg]);
            }
          }
        }
      } else if (sp == 8) {
        for (int tile = blockIdx.x; tile < 512; tile += gridDim.x) {
          const int tm = tile & 63, tn = tile >> 6;
          f32x16 acc[2][2];
          zero_acc<2>(acc);
          gemm_acc<2>(acc, MIX + (size_t)tm * 256 * 1024, 1024, 64, WB + WB_WOUT + (size_t)tn * 128 * 1024, 1024, 16, lds);
#pragma unroll
          for (int mi = 0; mi < 2; ++mi)
#pragma unroll
            for (int ni = 0; ni < 2; ++ni) {
              const int col = tn * 128 + wn * 64 + ni * 32 + r;
#pragma unroll
              for (int rg = 0; rg < 16; ++rg) {
                const int row = tm * 256 + wm * 64 + mi * 32 + rowof(rg, h2);
                const float gt = MODl[mod_index(row) * 6144 + 2048 + col];
                const float xin = (l == 0) ? (row < NCTX ? p.x_prompt[(size_t)row * 1024 + col] : p.x_sample[(size_t)(row - NCTX) * 1024 + col])
                                           : p.out[(size_t)row * 1024 + col];
                p.out[(size_t)row * 1024 + col] = xin + gt * acc[mi][ni][rg];
              }
            }
        }
      } else if (sp == 9) {
        normmod_rows(p, false, p.norm2_g + l * 1024, MODl, 3072, 4096, H);
      } else if (sp == 10) {
        for (int tile = blockIdx.x; tile < 64 * 44; tile += gridDim.x) {
          const int tm = tile & 63, tn = tile >> 6;
          f32x16 acc[2][2];
          zero_acc<2>(acc);
          gemm_acc<2>(acc, H + (size_t)tm * 256 * 1024, 1024, 64, WB + WB_WFI + (size_t)tn * 128 * 1024, 1024, 16, lds);
#pragma unroll
          for (int mi = 0; mi < 2; ++mi) {
            const int col = tn * 64 + wn * 32 + r;
#pragma unroll
            for (int rg = 0; rg < 16; ++rg) {
              const int row = tm * 256 + wm * 64 + mi * 32 + rowof(rg, h2);
              const float ug = acc[mi][0][rg], uv = acc[mi][1][rg];
              ACT[(size_t)row * DFF + col] = f2bf(ug * sigmoidf_(ug) * uv);
            }
          }
        }
      } else {
        for (int tile = blockIdx.x; tile < 512; tile += gridDim.x) {
          const int tm = tile & 63, tn = tile >> 6;
          f32x16 acc[2][2];
          zero_acc<2>(acc);
          gemm_acc<2>(acc, ACT + (size_t)tm * 256 * DFF, DFF, 64, WB + WB_WFO + (size_t)tn * 128 * DFF, DFF, 44, lds);
#pragma unroll
          for (int mi = 0; mi < 2; ++mi)
#pragma unroll
            for (int ni = 0; ni < 2; ++ni) {
              const int col = tn * 128 + wn * 64 + ni * 32 + r;
#pragma unroll
              for (int rg = 0; rg < 16; ++rg) {
                const int row = tm * 256 + wm * 64 + mi * 32 + rowof(rg, h2);
                const float gt = MODl[mod_index(row) * 6144 + 5120 + col];
                p.out[(size_t)row * 1024 + col] += gt * acc[mi][ni][rg];
              }
            }
        }
      }
    }
    if (ph + 1 < p.ph_hi) grid.sync();
  }
}

extern "C" void kernel_launch(void* const* d_in, const int* in_sizes, int n_in, void* d_out, int out_size, void* d_ws, size_t ws_size,
                              hipStream_t stream) {
  static int grid_blocks = 0;
  if (!grid_blocks) {
    int dev = 0, cus = 0, per_cu = 0;
    (void)hipGetDevice(&dev);
    (void)hipDeviceGetAttribute(&cus, hipDeviceAttributeMultiprocessorCount, dev);
    (void)hipFuncSetAttribute((const void*)fwd_megakernel, hipFuncAttributeMaxDynamicSharedMemorySize, (int)DYN_LDS);
    (void)hipOccupancyMaxActiveBlocksPerMultiprocessor(&per_cu, fwd_megakernel, 512, DYN_LDS);
    if (per_cu > 1) per_cu = 1;
    if (per_cu < 1) per_cu = 1;
    grid_blocks = cus * per_cu;
  }
  if (ws_size < WS_END) fprintf(stderr, "workspace too small: %zu < %zu\n", ws_size, (size_t)WS_END);
  Params p{};
  const float* const* in = (const float* const*)d_in;
  p.x_prompt = in[0]; p.x_sample = in[1]; p.st_C = in[2]; p.st_n = in[3]; p.st_m = in[4]; p.c_ckv = in[5]; p.c_kr = in[6];
  p.c_gk = in[7]; p.c_gv = in[8]; p.c = in[9]; p.c_ctx = in[10]; p.w_mod = in[11]; p.b_mod = in[12]; p.norm1_g = in[13];
  p.w_in = in[14]; p.b_mgate = in[15]; p.m_norm_g = in[16]; p.a_qlora_g = in[17]; p.a_kvlora_g = in[18]; p.w_uq = in[19];
  p.w_ukv = in[20]; p.a_qnorm_g = in[21]; p.a_knorm_g = in[22]; p.g_qnorm_g = in[23]; p.g_knorm_g = in[24]; p.w_branch = in[25];
  p.w_out = in[26]; p.norm2_g = in[27]; p.w_ffn_in = in[28]; p.w_ffn_out = in[29];
  p.out = (float*)d_out;
  p.ws = (unsigned char*)d_ws;
#if MULTI_LAUNCH
#ifndef RUN_PHASES
#define RUN_PHASES NPHASE
#endif
  for (int ph = 0; ph < RUN_PHASES; ++ph) {
    p.ph_lo = ph; p.ph_hi = ph + 1;
    hipLaunchKernelGGL(fwd_megakernel, dim3(grid_blocks), dim3(512), DYN_LDS, stream, p);
  }
#ifdef DUMP_OFF
  p.ph_lo = 99; p.ph_hi = 100;
  hipLaunchKernelGGL(fwd_megakernel, dim3(grid_blocks), dim3(512), DYN_LDS, stream, p);
#endif
#else
  p.ph_lo = 0; p.ph_hi = NPHASE;
  void* args[] = {&p};
  hipError_t e = hipLaunchCooperativeKernel((void*)fwd_megakernel, dim3(grid_blocks), dim3(512), args, DYN_LDS, stream);
  if (e != hipSuccess) fprintf(stderr, "cooperative launch failed: %s (grid %d)\n", hipGetErrorString(e), grid_blocks);
#endif
}
```

```cpp
#include <hip/hip_runtime.h>
#include <hip/hip_cooperative_groups.h>
#include <cstdio>
namespace cg = cooperative_groups;

typedef unsigned short bf16_t;
typedef short bf16x8 __attribute__((ext_vector_type(8)));
typedef float f32x16 __attribute__((ext_vector_type(16)));
typedef float f32x4 __attribute__((ext_vector_type(4)));
typedef float f32x2 __attribute__((ext_vector_type(2)));
typedef unsigned u32x4 __attribute__((ext_vector_type(4)));
typedef unsigned u32x2 __attribute__((ext_vector_type(2)));

#ifndef MIXSEL
#define MIXSEL 7
#endif
#ifndef MULTI_LAUNCH
#define MULTI_LAUNCH 0
#endif

constexpr int NTOK = 16384, NCTX = 8192, NKV = 17408;
constexpr int DIN = 6320, DFF = 2816;
constexpr float EPS = 1e-6f;
constexpr int NPHASE = 25;
constexpr size_t DYN_LDS = 131072;

constexpr size_t WB_WIN = 0;
constexpr size_t WB_WUQ = WB_WIN + 6400ull * 1024;
constexpr size_t WB_WUKV = WB_WUQ + 768ull * 256;
constexpr size_t WB_WBR = WB_WUKV + 1024ull * 128;
constexpr size_t WB_WOUT = WB_WBR + 3ull * 1024 * 512;
constexpr size_t WB_WFI = WB_WOUT + 1024ull * 1024;
constexpr size_t WB_WFO = WB_WFI + 5632ull * 1024;
constexpr size_t WB_ELEMS = WB_WFO + 1024ull * 2816;

constexpr size_t OFF_R0 = 0;
constexpr size_t OFF_R1 = OFF_R0 + WB_ELEMS * 2;
constexpr size_t OFF_R2 = OFF_R1 + 16384ull * 2048 * 2;
constexpr size_t OFF_R3 = OFF_R2 + 16384ull * 1216 * 2;
constexpr size_t OFF_R4 = OFF_R3 + 17408ull * 1280 * 2;
constexpr size_t OFF_GQ = OFF_R4 + 2ull * 16384 * 512 * 2;
constexpr size_t OFF_GK = OFF_GQ + 16384ull * 512 * 2;
constexpr size_t OFF_GV = OFF_GK + 17408ull * 128 * 2;
constexpr size_t OFF_QL = OFF_GV + 17408ull * 128 * 2;
constexpr size_t OFF_CKV = OFF_QL + 16384ull * 256 * 2;
constexpr size_t OFF_KR = OFF_CKV + 17408ull * 128 * 2;
constexpr size_t OFF_G = OFF_KR + 17408ull * 32 * 2;
constexpr size_t OFF_MOD = OFF_G + 16384ull * 16 * 4;
constexpr size_t OFF_CNT = OFF_MOD + 2ull * 5 * 6144 * 4;
constexpr size_t WS_END = OFF_CNT + 4096;

constexpr size_t O_Y = 0;
constexpr size_t O_C = 16777216;
constexpr size_t O_N = O_C + 8388608;
constexpr size_t O_M = O_N + 65536;
constexpr size_t O_CKV = O_M + 512;
constexpr size_t O_KR = O_CKV + 2097152;
constexpr size_t O_GK = O_KR + 524288;
constexpr size_t O_GV = O_GK + 2097152;

struct Params {
  const float *x_prompt, *x_sample, *st_C, *st_n, *st_m, *c_ckv, *c_kr, *c_gk, *c_gv, *c, *c_ctx;
  const float *w_mod, *b_mod, *norm1_g, *w_in, *b_mgate, *m_norm_g, *a_qlora_g, *a_kvlora_g, *w_uq, *w_ukv;
  const float *a_qnorm_g, *a_knorm_g, *g_qnorm_g, *g_knorm_g, *w_branch, *w_out, *norm2_g, *w_ffn_in, *w_ffn_out;
  float* out;
  unsigned char* ws;
  int ph_lo, ph_hi;
};

typedef __bf16 bf16x2_t __attribute__((ext_vector_type(2)));
__device__ __forceinline__ unsigned cvt_pk_bf16(float lo, float hi) {
  f32x2 v = {lo, hi};
  bf16x2_t b = __builtin_convertvector(v, bf16x2_t);
  return __builtin_bit_cast(unsigned, b);
}
__device__ __forceinline__ bf16_t f2bf(float f) { return (bf16_t)(cvt_pk_bf16(f, 0.f) & 0xffffu); }
__device__ __forceinline__ float bf2f(bf16_t v) { return __uint_as_float(((unsigned)v) << 16); }
__device__ __forceinline__ float bflo(unsigned u) { return __uint_as_float(u << 16); }
__device__ __forceinline__ float bfhi(unsigned u) { return __uint_as_float(u & 0xffff0000u); }
__device__ __forceinline__ float wave_sum(float v) {
#pragma unroll
  for (int d = 1; d < 64; d <<= 1) v += __shfl_xor(v, d);
  return v;
}
__device__ __forceinline__ float half_sum(float v) {
#pragma unroll
  for (int d = 1; d < 32; d <<= 1) v += __shfl_xor(v, d);
  return v;
}
__device__ __forceinline__ float wave_max(float v) {
#pragma unroll
  for (int d = 1; d < 64; d <<= 1) v = fmaxf(v, __shfl_xor(v, d));
  return v;
}
__device__ __forceinline__ int opaque_tid() {
  int t = threadIdx.x;
  asm volatile("" : "+v"(t));
  return t;
}
__device__ __forceinline__ float sigmoidf_(float x) { return 1.0f / (1.0f + __expf(-x)); }
__device__ __forceinline__ int rowof(int reg, int h2) { return (reg & 3) + 8 * (reg >> 2) + 4 * h2; }
__device__ __forceinline__ int mod_index(int row) { return row < NCTX ? 0 : 1 + ((row - NCTX) >> 11); }

constexpr int LSTR = 72;
constexpr int A_TILE_EL = 256 * LSTR;
constexpr int B_TILE_EL = 128 * LSTR;
constexpr int STAGE_EL = A_TILE_EL + B_TILE_EL;

template <int NI>
__device__ __forceinline__ void gemm_acc(f32x16 (&acc)[2][NI], const bf16_t* __restrict__ A, int lda, int akstride,
                                         const bf16_t* __restrict__ Bt, int ldb, int nk, bf16_t* lds) {
  const int tid = opaque_tid(), lane = tid & 63, wid = tid >> 6, wm = wid >> 1, wn = wid & 1;
  const int lr = tid >> 3, lc = (tid & 7) * 8;
  u32x4 ra[4], rb[NI];
  const bf16_t* ap = A + (size_t)lr * lda + lc;
  const bf16_t* bp = Bt + (size_t)lr * ldb + lc;
#pragma unroll
  for (int i = 0; i < 4; ++i) ra[i] = *(const u32x4*)(ap + (size_t)(64 * i) * lda);
#pragma unroll
  for (int i = 0; i < NI; ++i) rb[i] = *(const u32x4*)(bp + (size_t)(64 * i) * ldb);
  {
    bf16_t* sA = lds;
    bf16_t* sB = lds + A_TILE_EL;
#pragma unroll
    for (int i = 0; i < 4; ++i) *(u32x4*)(sA + (lr + 64 * i) * LSTR + lc) = ra[i];
#pragma unroll
    for (int i = 0; i < NI; ++i) *(u32x4*)(sB + (lr + 64 * i) * LSTR + lc) = rb[i];
  }
  __syncthreads();
  const int arow = wm * 64 + (lane & 31), brow = wn * (32 * NI) + (lane & 31), kof = (lane >> 5) * 8;
  for (int kt = 0; kt < nk; ++kt) {
    const int cur = kt & 1;
    if (kt + 1 < nk) {
      const bf16_t* ap2 = ap + (size_t)(kt + 1) * akstride;
      const bf16_t* bp2 = bp + (size_t)(kt + 1) * 64;
#pragma unroll
      for (int i = 0; i < 4; ++i) ra[i] = *(const u32x4*)(ap2 + (size_t)(64 * i) * lda);
#pragma unroll
      for (int i = 0; i < NI; ++i) rb[i] = *(const u32x4*)(bp2 + (size_t)(64 * i) * ldb);
    }
    const bf16_t* cA = lds + cur * STAGE_EL;
    const bf16_t* cB = cA + A_TILE_EL;
#pragma unroll
    for (int ks = 0; ks < 4; ++ks) {
      bf16x8 af[2], bfr[NI];
#pragma unroll
      for (int mi = 0; mi < 2; ++mi) af[mi] = *(const bf16x8*)(cA + (arow + mi * 32) * LSTR + ks * 16 + kof);
#pragma unroll
      for (int ni = 0; ni < NI; ++ni) bfr[ni] = *(const bf16x8*)(cB + (brow + ni * 32) * LSTR + ks * 16 + kof);
#pragma unroll
      for (int mi = 0; mi < 2; ++mi)
#pragma unroll
        for (int ni = 0; ni < NI; ++ni)
          acc[mi][ni] = __builtin_amdgcn_mfma_f32_32x32x16_bf16(af[mi], bfr[ni], acc[mi][ni], 0, 0, 0);
    }
    if (kt + 1 < nk) {
      bf16_t* sA = lds + (cur ^ 1) * STAGE_EL;
      bf16_t* sB = sA + A_TILE_EL;
#pragma unroll
      for (int i = 0; i < 4; ++i) *(u32x4*)(sA + (lr + 64 * i) * LSTR + lc) = ra[i];
#pragma unroll
      for (int i = 0; i < NI; ++i) *(u32x4*)(sB + (lr + 64 * i) * LSTR + lc) = rb[i];
    }
    __syncthreads();
  }
}

template <int NI>
__device__ __forceinline__ void zero_acc(f32x16 (&acc)[2][NI]) {
#pragma unroll
  for (int mi = 0; mi < 2; ++mi)
#pragma unroll
    for (int ni = 0; ni < NI; ++ni)
#pragma unroll
      for (int r = 0; r < 16; ++r) acc[mi][ni][r] = 0.f;
}

__device__ void cvt_layer(const Params& p, int l, bf16_t* WB, bf16_t* lds) {
  const int tid = opaque_tid();
  for (int tile = blockIdx.x; tile < 4432; tile += gridDim.x) {
    const float* src;
    bf16_t* dst;
    int K, ld, nvalid, mode = 0, tl = tile;
    if (tl < 1600) { src = p.w_in + (size_t)l * 1024 * DIN; dst = WB + WB_WIN; K = 1024; ld = DIN; nvalid = DIN; }
    else if ((tl -= 1600) < 48) { src = p.w_uq + (size_t)l * 256 * 768; dst = WB + WB_WUQ; K = 256; ld = 768; nvalid = 768; }
    else if ((tl -= 48) < 32) { src = p.w_ukv + (size_t)l * 128 * 1024; dst = WB + WB_WUKV; K = 128; ld = 1024; nvalid = 1024; }
    else if ((tl -= 32) < 384) { int n = tl >> 7; tl &= 127; src = p.w_branch + (size_t)(l * 3 + n) * 512 * 1024; dst = WB + WB_WBR + (size_t)n * 1024 * 512; K = 512; ld = 1024; nvalid = 1024; }
    else if ((tl -= 384) < 256) { src = p.w_out + (size_t)l * 1024 * 1024; dst = WB + WB_WOUT; K = 1024; ld = 1024; nvalid = 1024; }
    else if ((tl -= 256) < 1408) { src = p.w_ffn_in + (size_t)l * 1024 * 5632; dst = WB + WB_WFI; K = 1024; ld = 5632; nvalid = 5632; mode = 1; }
    else { tl -= 1408; src = p.w_ffn_out + (size_t)l * DFF * 1024; dst = WB + WB_WFO; K = DFF; ld = 1024; nvalid = 1024; }
    const int nkt = K >> 6, tn = tl / nkt, tk = tl - tn * nkt;
    const int kk = tid >> 4, n4 = (tid & 15) * 4;
    const int np = tn * 64 + n4;
    int nsrc = np;
    if (mode == 1) { const int g = np >> 6, r = np & 63; nsrc = (r < 32 ? 0 : DFF) + 32 * g + (r & 31); }
    const bool valid = np < nvalid;
#pragma unroll
    for (int i = 0; i < 2; ++i) {
      const int k = kk + 32 * i;
      f32x4 v = {0.f, 0.f, 0.f, 0.f};
      if (valid) v = *(const f32x4*)(src + (size_t)(tk * 64 + k) * ld + nsrc);
      lds[(n4 + 0) * LSTR + k] = f2bf(v[0]);
      lds[(n4 + 1) * LSTR + k] = f2bf(v[1]);
      lds[(n4 + 2) * LSTR + k] = f2bf(v[2]);
      lds[(n4 + 3) * LSTR + k] = f2bf(v[3]);
    }
    __syncthreads();
    {
      const int nl = tid >> 3, kc = (tid & 7) * 8;
      const u32x4 w = *(const u32x4*)(lds + nl * LSTR + kc);
      *(u32x4*)(dst + (size_t)(tn * 64 + nl) * K + tk * 64 + kc) = w;
    }
    __syncthreads();
  }
}

__device__ void mod_phase(const Params& p, float* MOD, float* S) {
  const int tid = opaque_tid();
  float* R = S + 5120;
  for (int i = tid; i < 5120; i += 512) {
    const int j = i >> 10, k = i & 1023;
    const float c = (j == 0) ? p.c_ctx[k] : p.c[(j - 1) * 1024 + k];
    S[i] = c / (1.0f + __expf(-c));
  }
  __syncthreads();
  for (int item = blockIdx.x; item < 384; item += gridDim.x) {
    const int l = item / 192, cgp = item - l * 192, c32 = tid & 31, ks = tid >> 5;
    const float* w = p.w_mod + (size_t)l * 1024 * 6144 + cgp * 32 + c32;
    float a0 = 0.f, a1 = 0.f, a2 = 0.f, a3 = 0.f, a4 = 0.f;
    for (int kk2 = 0; kk2 < 64; ++kk2) {
      const int k = ks * 64 + kk2;
      const float wv = w[(size_t)k * 6144];
      a0 += S[k] * wv; a1 += S[1024 + k] * wv; a2 += S[2048 + k] * wv; a3 += S[3072 + k] * wv; a4 += S[4096 + k] * wv;
    }
    R[(ks * 5 + 0) * 32 + c32] = a0; R[(ks * 5 + 1) * 32 + c32] = a1; R[(ks * 5 + 2) * 32 + c32] = a2;
    R[(ks * 5 + 3) * 32 + c32] = a3; R[(ks * 5 + 4) * 32 + c32] = a4;
    __syncthreads();
    if (tid < 160) {
      const int j = tid >> 5, c = tid & 31;
      float s = 0.f;
      for (int q = 0; q < 16; ++q) s += R[(q * 5 + j) * 32 + c];
      MOD[(size_t)(l * 5 + j) * 6144 + cgp * 32 + c] = s + p.b_mod[l * 6144 + cgp * 32 + c];
    }
    __syncthreads();
  }
}

__device__ void normmod_rows(const Params& p, bool from_input, const float* g, const float* MODl, int sh_off, int sc_off, bf16_t* H) {
  const int tid_ = opaque_tid(), lane = tid_ & 63, wid = tid_ >> 6;
  for (int row = blockIdx.x * 8 + wid; row < NTOK; row += gridDim.x * 8) {
    const float* x = from_input ? (row < NCTX ? p.x_prompt + (size_t)row * 1024 : p.x_sample + (size_t)(row - NCTX) * 1024)
                                : p.out + (size_t)row * 1024;
    const float* md = MODl + mod_index(row) * 6144;
    f32x4 v[4];
    float ss = 0.f;
#pragma unroll
    for (int i = 0; i < 4; ++i) {
      v[i] = *(const f32x4*)(x + i * 256 + lane * 4);
      ss += v[i][0] * v[i][0] + v[i][1] * v[i][1] + v[i][2] * v[i][2] + v[i][3] * v[i][3];
    }
    ss = wave_sum(ss);
    const float rstd = rsqrtf(ss * (1.0f / 1024.0f) + EPS);
#pragma unroll
    for (int i = 0; i < 4; ++i) {
      const int c = i * 256 + lane * 4;
      const f32x4 g4 = *(const f32x4*)(g + c), sc = *(const f32x4*)(md + sc_off + c), sh = *(const f32x4*)(md + sh_off + c);
      float y[4];
#pragma unroll
      for (int e = 0; e < 4; ++e) y[e] = v[i][e] * rstd * g4[e] * (1.0f + sc[e]) + sh[e];
      u32x2 w;
      w.x = cvt_pk_bf16(y[0], y[1]);
      w.y = cvt_pk_bf16(y[2], y[3]);
      *(u32x2*)(H + (size_t)row * 1024 + c) = w;
    }
  }
}

__device__ __forceinline__ void rope_cs(int t, int pidx, int nfreq, float& c, float& s) {
  const int fi = pidx < nfreq ? pidx : pidx - nfreq;
  const float pos = pidx < nfreq ? (float)(t >> 6) : (float)(t & 63);
  const float freq = exp2f(-(float)fi / (float)nfreq * 13.287712379549449f);
  const float ang = pos * freq;
  sincosf(ang, &s, &c);
}

__device__ void post_small(const Params& p, int l, const bf16_t* PS, bf16_t* QL, bf16_t* CKV, bf16_t* KR, bf16_t* GQ, bf16_t* GK, bf16_t* GV) {
  const int tid_ = opaque_tid(), lane = tid_ & 63, wid = tid_ >> 6;
  const int pidx = lane & 31, hh = lane >> 5;
  const float gq_scale = 0.125f * 1.4426950408889634f;
  for (int row = blockIdx.x * 8 + wid; row < NKV; row += gridDim.x * 8) {
    if (row < NTOK) {
      const bf16_t* ps = PS + (size_t)row * 1216;
      const bool ctx = row < NCTX;
      const int b = ctx ? (row >> 8) : ((row - NCTX) >> 11);
      const int t = ctx ? (row & 255) : ((row - NCTX) & 2047);
      const size_t obase = (size_t)((b * 2 + l) * 256 + t);
      {
        const u32x2 w = *(const u32x2*)(ps + 16 + lane * 4);
        float v0 = bflo(w.x), v1 = bfhi(w.x), v2 = bflo(w.y), v3 = bfhi(w.y);
        float ss = wave_sum(v0 * v0 + v1 * v1 + v2 * v2 + v3 * v3);
        const float rstd = rsqrtf(ss * (1.0f / 256.0f) + EPS);
        const f32x4 g4 = *(const f32x4*)(p.a_qlora_g + l * 256 + lane * 4);
        u32x2 o;
        o.x = cvt_pk_bf16(v0 * rstd * g4[0], v1 * rstd * g4[1]);
        o.y = cvt_pk_bf16(v2 * rstd * g4[2], v3 * rstd * g4[3]);
        *(u32x2*)(QL + (size_t)row * 256 + lane * 4) = o;
      }
      {
        const unsigned w = *(const unsigned*)(ps + 272 + lane * 2);
        float v0 = bflo(w), v1 = bfhi(w);
        float ss = wave_sum(v0 * v0 + v1 * v1);
        const float rstd = rsqrtf(ss * (1.0f / 128.0f) + EPS);
        const f32x2 g2 = *(const f32x2*)(p.a_kvlora_g + l * 128 + lane * 2);
        v0 = v0 * rstd * g2[0];
        v1 = v1 * rstd * g2[1];
        *(unsigned*)(CKV + (size_t)row * 128 + lane * 2) = cvt_pk_bf16(v0, v1);
        if (ctx) { f32x2 o = {v0, v1}; *(f32x2*)(p.out + O_CKV + obase * 128 + lane * 2) = o; }
      }
      if (lane < 32) {
        const bf16_t w = ps[400 + lane];
        KR[(size_t)row * 32 + lane] = w;
        if (ctx) p.out[O_KR + obase * 32 + lane] = bf2f(w);
      }
#pragma unroll
      for (int i = 0; i < 4; ++i) {
        const int head = 2 * i + hh;
        float x1 = bf2f(ps[432 + head * 64 + pidx]), x2 = bf2f(ps[432 + head * 64 + pidx + 32]);
        const float ss = half_sum(x1 * x1 + x2 * x2);
        const float rstd = rsqrtf(ss * (1.0f / 64.0f) + EPS);
        x1 = x1 * rstd * p.g_qnorm_g[l * 64 + pidx];
        x2 = x2 * rstd * p.g_qnorm_g[l * 64 + pidx + 32];
        if (!ctx) {
          float c, s;
          rope_cs(t, pidx, 16, c, s);
          const float y1 = x1 * c - x2 * s, y2 = x1 * s + x2 * c;
          x1 = y1; x2 = y2;
        }
        GQ[(size_t)row * 512 + head * 64 + pidx] = f2bf(x1 * gq_scale);
        GQ[(size_t)row * 512 + head * 64 + pidx + 32] = f2bf(x2 * gq_scale);
      }
      {
        const int head = hh;
        float x1 = bf2f(ps[944 + head * 64 + pidx]), x2 = bf2f(ps[944 + head * 64 + pidx + 32]);
        const float ss = half_sum(x1 * x1 + x2 * x2);
        const float rstd = rsqrtf(ss * (1.0f / 64.0f) + EPS);
        x1 = x1 * rstd * p.g_knorm_g[l * 64 + pidx];
        x2 = x2 * rstd * p.g_knorm_g[l * 64 + pidx + 32];
        if (ctx) {
          p.out[O_GK + obase * 128 + head * 64 + pidx] = x1;
          p.out[O_GK + obase * 128 + head * 64 + pidx + 32] = x2;
        } else {
          float c, s;
          rope_cs(t, pidx, 16, c, s);
          const float y1 = x1 * c - x2 * s, y2 = x1 * s + x2 * c;
          x1 = y1; x2 = y2;
        }
        GK[(size_t)row * 128 + head * 64 + pidx] = f2bf(x1);
        GK[(size_t)row * 128 + head * 64 + pidx + 32] = f2bf(x2);
      }
      {
        const unsigned w = *(const unsigned*)(ps + 1072 + lane * 2);
        *(unsigned*)(GV + (size_t)row * 128 + lane * 2) = w;
        if (ctx) { f32x2 o = {bflo(w), bfhi(w)}; *(f32x2*)(p.out + O_GV + obase * 128 + lane * 2) = o; }
      }
    } else {
      const int r = row - NTOK, b = r >> 8, s = r & 255;
      const size_t cb = (size_t)((b * 2 + l) * 256 + s);
      {
        const f32x2 v = *(const f32x2*)(p.c_ckv + cb * 128 + lane * 2);
        *(unsigned*)(CKV + (size_t)row * 128 + lane * 2) = cvt_pk_bf16(v[0], v[1]);
      }
      if (lane < 32) KR[(size_t)row * 32 + lane] = f2bf(p.c_kr[cb * 32 + lane]);
      {
        const f32x2 v = *(const f32x2*)(p.c_gk + cb * 128 + lane * 2);
        *(unsigned*)(GK + (size_t)row * 128 + lane * 2) = cvt_pk_bf16(v[0], v[1]);
      }
      {
        const f32x2 v = *(const f32x2*)(p.c_gv + cb * 128 + lane * 2);
        *(unsigned*)(GV + (size_t)row * 128 + lane * 2) = cvt_pk_bf16(v[0], v[1]);
      }
    }
  }
}

__device__ void post_mla(const Params& p, int l, bf16_t* QA, bf16_t* KAV, const bf16_t* KR) {
  const int tid_ = opaque_tid(), lane = tid_ & 63, wid = tid_ >> 6;
  const int pidx = lane & 31, hh = lane >> 5;
  const float q_scale = 0.10206207261596577f * 1.4426950408889634f;
  const float gk0 = p.a_knorm_g[l * 96 + pidx], gk1 = p.a_knorm_g[l * 96 + 32 + pidx], gk2 = p.a_knorm_g[l * 96 + 64 + pidx];
  const float gq0 = p.a_qnorm_g[l * 96 + pidx], gq1 = p.a_qnorm_g[l * 96 + 32 + pidx], gq2 = p.a_qnorm_g[l * 96 + 64 + pidx];
  for (int row = blockIdx.x * 8 + wid; row < NKV; row += gridDim.x * 8) {
    const bool lat = (row >= NCTX) && (row < NTOK);
    const int t = (row - NCTX) & 2047;
    float c = 1.f, s = 0.f;
    if (lat) rope_cs(t, pidx & 15, 8, c, s);
    const float kr = bf2f(KR[(size_t)row * 32 + pidx]);
#pragma unroll
    for (int i = 0; i < 4; ++i) {
      const int head = 2 * i + hh;
      bf16_t* kp = KAV + (size_t)row * 1280 + head * 160;
      float e0 = bf2f(kp[pidx]), e1 = bf2f(kp[32 + pidx]), e2 = kr;
      const float ss = half_sum(e0 * e0 + e1 * e1 + e2 * e2);
      const float rstd = rsqrtf(ss * (1.0f / 96.0f) + EPS);
      e0 *= rstd * gk0; e1 *= rstd * gk1; e2 *= rstd * gk2;
      if (lat) {
        const float other = __shfl_xor(e2, 16);
        e2 = (pidx < 16) ? (e2 * c - other * s) : (other * s + e2 * c);
      }
      kp[pidx] = f2bf(e0); kp[32 + pidx] = f2bf(e1); kp[64 + pidx] = f2bf(e2);
    }
    if (row < NTOK) {
#pragma unroll
      for (int i = 0; i < 4; ++i) {
        const int head = 2 * i + hh;
        bf16_t* qp = QA + (size_t)row * 768 + head * 96;
        float e0 = bf2f(qp[pidx]), e1 = bf2f(qp[32 + pidx]), e2 = bf2f(qp[64 + pidx]);
        const float ss = half_sum(e0 * e0 + e1 * e1 + e2 * e2);
        const float rstd = rsqrtf(ss * (1.0f / 96.0f) + EPS);
        e0 *= rstd * gq0; e1 *= rstd * gq1; e2 *= rstd * gq2;
        if (lat) {
          const float other = __shfl_xor(e2, 16);
          e2 = (pidx < 16) ? (e2 * c - other * s) : (other * s + e2 * c);
        }
        qp[pidx] = f2bf(e0 * q_scale); qp[32 + pidx] = f2bf(e1 * q_scale); qp[64 + pidx] = f2bf(e2 * q_scale);
      }
    }
  }
}

__device__ void post_mlstm(const Params& p, int l, bf16_t* HF, const bf16_t* HB, const bf16_t* PM) {
  const int tid_ = opaque_tid(), lane = tid_ & 63, wid = tid_ >> 6;
  const f32x2 g2 = *(const f32x2*)(p.m_norm_g + l * 128 + lane * 2);
  for (int row = blockIdx.x * 8 + wid; row < NTOK; row += gridDim.x * 8) {
#pragma unroll
    for (int h = 0; h < 4; ++h) {
      const unsigned wf = *(const unsigned*)(HF + (size_t)row * 512 + h * 128 + lane * 2);
      const unsigned wb = *(const unsigned*)(HB + (size_t)row * 512 + h * 128 + lane * 2);
      const unsigned wo = *(const unsigned*)(PM + (size_t)row * 2048 + 1536 + h * 128 + lane * 2);
      float v0 = bflo(wf) + bflo(wb), v1 = bfhi(wf) + bfhi(wb);
      const float ss = wave_sum(v0 * v0 + v1 * v1);
      const float rstd = rsqrtf(ss * (1.0f / 128.0f) + EPS);
      v0 = v0 * rstd * g2[0] * sigmoidf_(bflo(wo));
      v1 = v1 * rstd * g2[1] * sigmoidf_(bfhi(wo));
      *(unsigned*)(HF + (size_t)row * 512 + h * 128 + lane * 2) = cvt_pk_bf16(v0, v1);
    }
  }
}

template <int DQK>
__device__ __forceinline__ void attn_item(const bf16_t* qptr, bf16_t* optr, const bf16_t* Kb, int kstride, const bf16_t* Vb, int vstride,
                                          int seg0_row, int seg0_tiles, int seg1_row, int ntiles, bf16_t* lds) {
  constexpr int KSTR = DQK + 8, KT_EL = 64 * KSTR, VT_EL = 64 * 72, ST_EL = KT_EL + VT_EL, NKK = DQK / 16, KCH = DQK / 8;
  const int tid = opaque_tid(), lane = tid & 63, h2 = lane >> 5, r = lane & 31;
  bf16x8 qf[NKK];
#pragma unroll
  for (int kk = 0; kk < NKK; ++kk) qf[kk] = *(const bf16x8*)(qptr + kk * 16 + h2 * 8);
  f32x16 o0, o1;
#pragma unroll
  for (int i = 0; i < 16; ++i) { o0[i] = 0.f; o1[i] = 0.f; }
  float m_run = -1e30f, l_run = 0.f;
  const int key0 = tid / KCH, c0 = tid - key0 * KCH;
  const int id1 = tid + 512, key1 = id1 / KCH, c1 = id1 - key1 * KCH;
  const bool has1 = (DQK == 96) && (tid < 256);
  const int vkey = tid >> 3, vc = tid & 7;
  const int vpos = (vkey & ~12) | ((vkey & 4) << 1) | ((vkey & 8) >> 1);
  u32x4 kr0, kr1 = {0u, 0u, 0u, 0u}, vr;
  {
    const int row0 = (0 < seg0_tiles) ? seg0_row : seg1_row;
    kr0 = *(const u32x4*)(Kb + (size_t)(row0 + key0) * kstride + c0 * 8);
    if (has1) kr1 = *(const u32x4*)(Kb + (size_t)(row0 + key1) * kstride + c1 * 8);
    vr = *(const u32x4*)(Vb + (size_t)(row0 + vkey) * vstride + vc * 8);
  }
#define ATTN_STORE(buf)                                                                      \
  {                                                                                          \
    bf16_t* sK_ = lds + (buf) * ST_EL;                                                       \
    bf16_t* sV_ = sK_ + KT_EL;                                                               \
    *(u32x4*)(sK_ + key0 * KSTR + c0 * 8) = kr0;                                             \
    if (has1) *(u32x4*)(sK_ + key1 * KSTR + c1 * 8) = kr1;                                   \
    sV_[(vc * 8 + 0) * 72 + vpos] = (bf16_t)(vr.x & 0xffffu);                                \
    sV_[(vc * 8 + 1) * 72 + vpos] = (bf16_t)(vr.x >> 16);                                    \
    sV_[(vc * 8 + 2) * 72 + vpos] = (bf16_t)(vr.y & 0xffffu);                                \
    sV_[(vc * 8 + 3) * 72 + vpos] = (bf16_t)(vr.y >> 16);                                    \
    sV_[(vc * 8 + 4) * 72 + vpos] = (bf16_t)(vr.z & 0xffffu);                                \
    sV_[(vc * 8 + 5) * 72 + vpos] = (bf16_t)(vr.z >> 16);                                    \
    sV_[(vc * 8 + 6) * 72 + vpos] = (bf16_t)(vr.w & 0xffffu);                                \
    sV_[(vc * 8 + 7) * 72 + vpos] = (bf16_t)(vr.w >> 16);                                    \
  }
  ATTN_STORE(0);
  __syncthreads();
  for (int j = 0; j < ntiles; ++j) {
    const int cur = j & 1;
    if (j + 1 < ntiles) {
      const int jn = j + 1;
      const int row0 = (jn < seg0_tiles) ? seg0_row + jn * 64 : seg1_row + (jn - seg0_tiles) * 64;
      kr0 = *(const u32x4*)(Kb + (size_t)(row0 + key0) * kstride + c0 * 8);
      if (has1) kr1 = *(const u32x4*)(Kb + (size_t)(row0 + key1) * kstride + c1 * 8);
      vr = *(const u32x4*)(Vb + (size_t)(row0 + vkey) * vstride + vc * 8);
    }
    const bf16_t* sK = lds + cur * ST_EL;
    const bf16_t* sV = sK + KT_EL;
#pragma unroll
    for (int u = 0; u < 2; ++u) {
      f32x16 s;
#pragma unroll
      for (int i = 0; i < 16; ++i) s[i] = 0.f;
#pragma unroll
      for (int kk = 0; kk < NKK; ++kk) {
        const bf16x8 a = *(const bf16x8*)(sK + (u * 32 + r) * KSTR + kk * 16 + h2 * 8);
        s = __builtin_amdgcn_mfma_f32_32x32x16_bf16(a, qf[kk], s, 0, 0, 0);
      }
      float mx = s[0];
#pragma unroll
      for (int i = 1; i < 16; ++i) mx = fmaxf(mx, s[i]);
      mx = fmaxf(mx, __shfl_xor(mx, 32));
      const float m_new = fmaxf(m_run, mx);
      const float alpha = exp2f(m_run - m_new);
      float ls = 0.f;
#pragma unroll
      for (int i = 0; i < 16; ++i) { s[i] = exp2f(s[i] - m_new); ls += s[i]; }
      l_run = l_run * alpha + ls;
      m_run = m_new;
#pragma unroll
      for (int i = 0; i < 16; ++i) { o0[i] *= alpha; o1[i] *= alpha; }
      u32x4 pa, pb;
      pa.x = cvt_pk_bf16(s[0], s[1]); pa.y = cvt_pk_bf16(s[2], s[3]); pa.z = cvt_pk_bf16(s[4], s[5]); pa.w = cvt_pk_bf16(s[6], s[7]);
      pb.x = cvt_pk_bf16(s[8], s[9]); pb.y = cvt_pk_bf16(s[10], s[11]); pb.z = cvt_pk_bf16(s[12], s[13]); pb.w = cvt_pk_bf16(s[14], s[15]);
      const bf16x8 pf0 = __builtin_bit_cast(bf16x8, pa), pf1 = __builtin_bit_cast(bf16x8, pb);
      {
        const bf16x8 a0 = *(const bf16x8*)(sV + r * 72 + u * 32 + h2 * 8);
        const bf16x8 a1 = *(const bf16x8*)(sV + (32 + r) * 72 + u * 32 + h2 * 8);
        o0 = __builtin_amdgcn_mfma_f32_32x32x16_bf16(a0, pf0, o0, 0, 0, 0);
        o1 = __builtin_amdgcn_mfma_f32_32x32x16_bf16(a1, pf0, o1, 0, 0, 0);
      }
      {
        const bf16x8 a0 = *(const bf16x8*)(sV + r * 72 + u * 32 + 16 + h2 * 8);
        const bf16x8 a1 = *(const bf16x8*)(sV + (32 + r) * 72 + u * 32 + 16 + h2 * 8);
        o0 = __builtin_amdgcn_mfma_f32_32x32x16_bf16(a0, pf1, o0, 0, 0, 0);
        o1 = __builtin_amdgcn_mfma_f32_32x32x16_bf16(a1, pf1, o1, 0, 0, 0);
      }
    }
    if (j + 1 < ntiles) ATTN_STORE(cur ^ 1);
    __syncthreads();
  }
#undef ATTN_STORE
  const float l_tot = l_run + __shfl_xor(l_run, 32);
  const float inv = 1.0f / l_tot;
#pragma unroll
  for (int g = 0; g < 4; ++g) {
    u32x2 w0, w1;
    w0.x = cvt_pk_bf16(o0[4 * g] * inv, o0[4 * g + 1] * inv);
    w0.y = cvt_pk_bf16(o0[4 * g + 2] * inv, o0[4 * g + 3] * inv);
    w1.x = cvt_pk_bf16(o1[4 * g] * inv, o1[4 * g + 1] * inv);
    w1.y = cvt_pk_bf16(o1[4 * g + 2] * inv, o1[4 * g + 3] * inv);
    *(u32x2*)(optr + 8 * g + 4 * h2) = w0;
    *(u32x2*)(optr + 32 + 8 * g + 4 * h2) = w1;
  }
}

__device__ void mlstm_chain(const Params& p, int l, bool lat, int b, int h, int dir, const bf16_t* PM, const float* G, bf16_t* Hout, bf16_t* lds) {
  const int tid = opaque_tid(), lane = tid & 63, wid = tid >> 6, h2 = lane >> 5, r = lane & 31;
  const int T = lat ? 2048 : 256, base_row = lat ? NCTX + b * 2048 : b * 256, nc = T >> 6;
  const float kscale = 0.08838834764831845f;
  bf16_t* Qs = lds;
  bf16_t* Ks = Qs + 64 * 136;
  bf16_t* KwT = Ks + 64 * 136;
  bf16_t* VT = KwT + 128 * 72;
  bf16_t* CT = VT + 128 * 72;
  bf16_t* Ss = CT + 128 * 136;
  float* F = (float*)(Ss + 64 * 72);
  float* icv = F; float* fcv = F + 64; float* e1v = F + 128; float* av = F + 192; float* mtv = F + 256;
  float* winv = F + 320; float* wgkv = F + 384; float* qnv = F + 448; float* hdv = F + 512; float* nvec = F + 576; float* scal = F + 704;
  const int dkt = wid >> 1, dvt0 = (wid & 1) * 2;
  const int lt = wid >> 2, dvt = wid & 3;
  f32x16 accC[2];
  float m_state = 0.f;
  const size_t sidx = (size_t)(((b * 2 + l) * 2 + dir) * 4 + h);
  if (lat) {
#pragma unroll
    for (int i = 0; i < 2; ++i)
#pragma unroll
      for (int rg = 0; rg < 16; ++rg)
        accC[i][rg] = p.st_C[sidx * 16384 + (size_t)(dkt * 32 + rowof(rg, h2)) * 128 + (dvt0 + i) * 32 + r];
    asm volatile("" ::: "memory");
    if (tid < 128) nvec[tid] = p.st_n[sidx * 128 + tid];
    m_state = p.st_m[sidx];
  } else {
#pragma unroll
    for (int i = 0; i < 2; ++i)
#pragma unroll
      for (int rg = 0; rg < 16; ++rg) accC[i][rg] = 0.f;
    if (tid < 128) nvec[tid] = 0.f;
  }
#pragma unroll
  for (int i = 0; i < 2; ++i)
#pragma unroll
    for (int g = 0; g < 4; ++g) {
      u32x2 w;
      w.x = cvt_pk_bf16(accC[i][4 * g], accC[i][4 * g + 1]);
      w.y = cvt_pk_bf16(accC[i][4 * g + 2], accC[i][4 * g + 3]);
      *(u32x2*)(CT + ((dvt0 + i) * 32 + r) * 136 + dkt * 32 + 8 * g + 4 * h2) = w;
    }
  const int j0 = tid >> 4, cc = tid & 15;
  u32x4 rq[2], rk[2], rv[2];
  float gi = 0.f, gf = 0.f;
#define MLSTM_ROW(c, j) (base_row + (dir ? (T - 1 - ((c) * 64 + (j))) : ((c) * 64 + (j))))
#define MLSTM_LOAD(c)                                                                     \
  {                                                                                       \
    _Pragma("unroll") for (int i = 0; i < 2; ++i) {                                       \
      const size_t rr = (size_t)MLSTM_ROW(c, j0 + 32 * i) * 2048 + h * 128 + cc * 8;      \
      rq[i] = *(const u32x4*)(PM + rr);                                                   \
      rk[i] = *(const u32x4*)(PM + rr + 512);                                             \
      rv[i] = *(const u32x4*)(PM + rr + 1024);                                            \
    }                                                                                     \
    if (tid < 64) {                                                                       \
      const size_t gr = (size_t)MLSTM_ROW(c, tid) * 16;                                   \
      gi = G[gr + (2 * dir) * 4 + h];                                                     \
      gf = G[gr + (2 * dir + 1) * 4 + h];                                                 \
    }                                                                                     \
  }
  MLSTM_LOAD(0);
  for (int c = 0; c < nc; ++c) {
#pragma unroll
    for (int i = 0; i < 2; ++i) {
      const int j = j0 + 32 * i;
      *(u32x4*)(Qs + j * 136 + cc * 8) = rq[i];
      *(u32x4*)(Ks + j * 136 + cc * 8) = rk[i];
      VT[(cc * 8 + 0) * 72 + j] = (bf16_t)(rv[i].x & 0xffffu);
      VT[(cc * 8 + 1) * 72 + j] = (bf16_t)(rv[i].x >> 16);
      VT[(cc * 8 + 2) * 72 + j] = (bf16_t)(rv[i].y & 0xffffu);
      VT[(cc * 8 + 3) * 72 + j] = (bf16_t)(rv[i].y >> 16);
      VT[(cc * 8 + 4) * 72 + j] = (bf16_t)(rv[i].z & 0xffffu);
      VT[(cc * 8 + 5) * 72 + j] = (bf16_t)(rv[i].z >> 16);
      VT[(cc * 8 + 6) * 72 + j] = (bf16_t)(rv[i].w & 0xffffu);
      VT[(cc * 8 + 7) * 72 + j] = (bf16_t)(rv[i].w >> 16);
    }
    if (tid < 64) {
      icv[tid] = gi;
      fcv[tid] = fminf(gf, 0.f) - log1pf(__expf(-fabsf(gf)));
    }
    if (c + 1 < nc) MLSTM_LOAD(c + 1);
    __syncthreads();
    if (wid == 0) {
      const float iv = icv[lane];
      float bc = fcv[lane];
#pragma unroll
      for (int d = 1; d < 64; d <<= 1) { const float tt = __shfl_up(bc, d); if (lane >= d) bc += tt; }
      const float a = iv - bc;
      float pm = a;
#pragma unroll
      for (int d = 1; d < 64; d <<= 1) { const float tt = __shfl_up(pm, d); if (lane >= d) pm = fmaxf(pm, tt); }
      const float mt = bc + fmaxf(m_state, pm);
      const float tot = __shfl(bc, 63);
      const float gg = tot + a;
      const float gmax = wave_max(gg);
      const float total = tot + m_state;
      const float m_new = fmaxf(total, gmax);
      e1v[lane] = bc - mt;
      av[lane] = a;
      mtv[lane] = mt;
      winv[lane] = __expf(bc + m_state - mt);
      wgkv[lane] = __expf(gg - m_new) * kscale;
      if (lane == 0) scal[0] = __expf(total - m_new);
      m_state = m_new;
    }
    __syncthreads();
    {
      const int j = tid & 63;
      const float wk = wgkv[j];
#pragma unroll
      for (int i = 0; i < 2; ++i) {
        const int dkb = (tid >> 6) * 8 + 64 * i;
        const u32x4 w = *(const u32x4*)(Ks + j * 136 + dkb);
        KwT[(dkb + 0) * 72 + j] = f2bf(bflo(w.x) * wk);
        KwT[(dkb + 1) * 72 + j] = f2bf(bfhi(w.x) * wk);
        KwT[(dkb + 2) * 72 + j] = f2bf(bflo(w.y) * wk);
        KwT[(dkb + 3) * 72 + j] = f2bf(bfhi(w.y) * wk);
        KwT[(dkb + 4) * 72 + j] = f2bf(bflo(w.z) * wk);
        KwT[(dkb + 5) * 72 + j] = f2bf(bfhi(w.z) * wk);
        KwT[(dkb + 6) * 72 + j] = f2bf(bflo(w.w) * wk);
        KwT[(dkb + 7) * 72 + j] = f2bf(bfhi(w.w) * wk);
      }
    }
    if (wid < 4) {
      const int lt2 = wid >> 1, st = wid & 1;
      f32x16 sacc;
#pragma unroll
      for (int i = 0; i < 16; ++i) sacc[i] = 0.f;
#pragma unroll
      for (int kk = 0; kk < 8; ++kk) {
        const bf16x8 a = *(const bf16x8*)(Qs + (lt2 * 32 + r) * 136 + kk * 16 + h2 * 8);
        const bf16x8 bk = *(const bf16x8*)(Ks + (st * 32 + r) * 136 + kk * 16 + h2 * 8);
        sacc = __builtin_amdgcn_mfma_f32_32x32x16_bf16(a, bk, sacc, 0, 0, 0);
      }
      const int scol = st * 32 + r;
      const float as = av[scol];
#pragma unroll
      for (int rg = 0; rg < 16; ++rg) {
        const int lrow = lt2 * 32 + rowof(rg, h2);
        const float val = (scol <= lrow) ? sacc[rg] * kscale * __expf(e1v[lrow] + as) : 0.f;
        Ss[lrow * 72 + scol] = f2bf(val);
      }
    }
    f32x16 acc;
#pragma unroll
    for (int i = 0; i < 16; ++i) acc[i] = 0.f;
#pragma unroll
    for (int kk = 0; kk < 8; ++kk) {
      const bf16x8 a = *(const bf16x8*)(Qs + (lt * 32 + r) * 136 + kk * 16 + h2 * 8);
      const bf16x8 bq = *(const bf16x8*)(CT + (dvt * 32 + r) * 136 + kk * 16 + h2 * 8);
      acc = __builtin_amdgcn_mfma_f32_32x32x16_bf16(a, bq, acc, 0, 0, 0);
    }
#pragma unroll
    for (int rg = 0; rg < 16; ++rg) acc[rg] *= winv[lt * 32 + rowof(rg, h2)];
    {
      const int lq = tid >> 3, part = tid & 7;
      float sq = 0.f;
#pragma unroll
      for (int e = 0; e < 16; ++e) sq += bf2f(Qs[lq * 136 + part * 16 + e]) * nvec[part * 16 + e];
      sq += __shfl_xor(sq, 1); sq += __shfl_xor(sq, 2); sq += __shfl_xor(sq, 4);
      if (part == 0) qnv[lq] = sq;
    }
    __syncthreads();
#pragma unroll
    for (int ks = 0; ks < 4; ++ks) {
      const bf16x8 a = *(const bf16x8*)(Ss + (lt * 32 + r) * 72 + ks * 16 + h2 * 8);
      const bf16x8 bv = *(const bf16x8*)(VT + (dvt * 32 + r) * 72 + ks * 16 + h2 * 8);
      acc = __builtin_amdgcn_mfma_f32_32x32x16_bf16(a, bv, acc, 0, 0, 0);
    }
    {
      const int lq = tid >> 3, part = tid & 7;
      float rs = 0.f;
#pragma unroll
      for (int e = 0; e < 8; ++e) rs += bf2f(Ss[lq * 72 + part * 8 + e]);
      rs += __shfl_xor(rs, 1); rs += __shfl_xor(rs, 2); rs += __shfl_xor(rs, 4);
      if (part == 0) {
        const float den = qnv[lq] * winv[lq] + rs;
        hdv[lq] = 1.0f / fmaxf(fabsf(den), __expf(-mtv[lq]));
      }
    }
    {
      const float decay = scal[0];
#pragma unroll
      for (int i = 0; i < 2; ++i) {
#pragma unroll
        for (int rg = 0; rg < 16; ++rg) accC[i][rg] *= decay;
#pragma unroll
        for (int ks = 0; ks < 4; ++ks) {
          const bf16x8 a = *(const bf16x8*)(KwT + (dkt * 32 + r) * 72 + ks * 16 + h2 * 8);
          const bf16x8 bv = *(const bf16x8*)(VT + ((dvt0 + i) * 32 + r) * 72 + ks * 16 + h2 * 8);
          accC[i] = __builtin_amdgcn_mfma_f32_32x32x16_bf16(a, bv, accC[i], 0, 0, 0);
        }
#pragma unroll
        for (int g = 0; g < 4; ++g) {
          u32x2 w;
          w.x = cvt_pk_bf16(accC[i][4 * g], accC[i][4 * g + 1]);
          w.y = cvt_pk_bf16(accC[i][4 * g + 2], accC[i][4 * g + 3]);
          *(u32x2*)(CT + ((dvt0 + i) * 32 + r) * 136 + dkt * 32 + 8 * g + 4 * h2) = w;
        }
      }
      if (tid < 128) {
        float sn = 0.f;
        for (int s = 0; s < 64; ++s) sn += wgkv[s] * bf2f(Ks[s * 136 + tid]);
        nvec[tid] = nvec[tid] * decay + sn;
      }
    }
    __syncthreads();
#pragma unroll
    for (int rg = 0; rg < 16; ++rg) {
      const int lrow = lt * 32 + rowof(rg, h2);
      Hout[(size_t)MLSTM_ROW(c, lrow) * 512 + h * 128 + dvt * 32 + r] = f2bf(acc[rg] * hdv[lrow]);
    }
  }
#undef MLSTM_LOAD
#undef MLSTM_ROW
  if (!lat) {
#pragma unroll
    for (int i = 0; i < 2; ++i)
#pragma unroll
      for (int rg = 0; rg < 16; ++rg)
        p.out[O_C + sidx * 16384 + (size_t)(dkt * 32 + rowof(rg, h2)) * 128 + (dvt0 + i) * 32 + r] = accC[i][rg];
    if (tid < 128) p.out[O_N + sidx * 128 + tid] = nvec[tid];
    if (tid == 0) p.out[O_M + sidx] = m_state;
  }
  __syncthreads();
}

__device__ void mixers_phase(const Params& p, int l, unsigned* counter, const bf16_t* PM, const float* G, bf16_t* HF, bf16_t* HB,
                             bf16_t* QA, const bf16_t* KAV, bf16_t* GQ, const bf16_t* GK, const bf16_t* GV, bf16_t* lds) {
  const int tid = opaque_tid(), lane = tid & 63, wid = tid >> 6, r = lane & 31;
  int* slot = (int*)((unsigned char*)lds + 130048);
#ifndef STATIC_SCHED
#define STATIC_SCHED 0
#endif
  for (int it_ = 0;; ++it_) {
#if STATIC_SCHED
    const int item = blockIdx.x + it_ * gridDim.x;
    (void)slot; (void)counter;
#else
    if (tid == 0) *slot = (int)atomicAdd(counter, 1u);
    __syncthreads();
    const int item = *slot;
    __syncthreads();
#endif
    if (item >= 1088) break;
    if (item < 64) {
#if MIXSEL & 1
      const bool lat = item < 32;
      const int nch = lat ? 1 : 8, ch0 = lat ? item : (item - 32) * 8;
      for (int q = 0; q < nch; ++q) {
        const int ch = ch0 + q;
        const int dir = ch & 1, h = (ch >> 1) & 3, b = ch >> 3;
        mlstm_chain(p, l, lat, b, h, dir, PM, G, dir ? HB : HF, lds);
      }
#endif
    } else if (item < 320 || (item >= 576 && item < 832)) {
#if MIXSEL & 2
      const bool lat = item < 320;
      const int i = lat ? item - 64 : item - 576;
      const int b = lat ? (i >> 6) : (i >> 3), h = lat ? ((i >> 3) & 7) : (i & 7), qt = lat ? (i & 7) : 0;
      const int own0 = lat ? NCTX + b * 2048 : b * 256;
      const int qrow = own0 + qt * 256 + wid * 32 + r;
      bf16_t* qp = QA + (size_t)qrow * 768 + h * 96;
      attn_item<96>(qp, qp, KAV + h * 160, 1280, KAV + h * 160 + 96, 1280, NTOK + b * 256, lat ? 4 : 0, own0, lat ? 36 : 4, lds);
#endif
    } else {
#if MIXSEL & 4
      const bool lat = item < 576;
      const int i = lat ? item - 320 : item - 832;
      const int b = lat ? (i >> 6) : (i >> 3), kvh = lat ? ((i >> 5) & 1) : ((i >> 2) & 1), tile = lat ? (i & 31) : (i & 3);
      const int own0 = lat ? NCTX + b * 2048 : b * 256;
      const int head = kvh * 4 + (wid >> 1);
      const int qrow = own0 + tile * 64 + (wid & 1) * 32 + r;
      bf16_t* qp = GQ + (size_t)qrow * 512 + head * 64;
      attn_item<64>(qp, qp, GK + kvh * 64, 128, GV + kvh * 64, 128, NTOK + b * 256, lat ? 4 : 0, own0, lat ? 36 : 4, lds);
#endif
    }
  }
}

__global__ void __launch_bounds__(512) fwd_megakernel(Params p) {
  extern __shared__ __attribute__((aligned(16))) unsigned char smem[];
  bf16_t* lds = (bf16_t*)smem;
  cg::grid_group grid = cg::this_grid();
  unsigned char* ws = p.ws;
  bf16_t* WB = (bf16_t*)(ws + OFF_R0);
  bf16_t* PM = (bf16_t*)(ws + OFF_R1);
  bf16_t* MIX = (bf16_t*)(ws + OFF_R1);
  bf16_t* ACT = (bf16_t*)(ws + OFF_R1);
  bf16_t* PS = (bf16_t*)(ws + OFF_R2);
  bf16_t* QA = (bf16_t*)(ws + OFF_R2);
  bf16_t* KAV = (bf16_t*)(ws + OFF_R3);
  bf16_t* H = (bf16_t*)(ws + OFF_R3);
  bf16_t* HF = (bf16_t*)(ws + OFF_R4);
  bf16_t* HB = HF + (size_t)NTOK * 512;
  bf16_t* GQ = (bf16_t*)(ws + OFF_GQ);
  bf16_t* GK = (bf16_t*)(ws + OFF_GK);
  bf16_t* GV = (bf16_t*)(ws + OFF_GV);
  bf16_t* QL = (bf16_t*)(ws + OFF_QL);
  bf16_t* CKV = (bf16_t*)(ws + OFF_CKV);
  bf16_t* KR = (bf16_t*)(ws + OFF_KR);
  float* G = (float*)(ws + OFF_G);
  float* MOD = (float*)(ws + OFF_MOD);
  unsigned* CNT = (unsigned*)(ws + OFF_CNT);

#ifdef DUMP_OFF
  if (p.ph_lo == 99) {
    const bf16_t* X = (const bf16_t*)(ws + DUMP_OFF);
    for (size_t i = (size_t)blockIdx.x * 512 + threadIdx.x; i < 16777216ull; i += (size_t)gridDim.x * 512) p.out[i] = bf2f(X[i]);
    return;
  }
#endif
  for (int ph = p.ph_lo; ph < p.ph_hi; ++ph) {
    const int tid = opaque_tid(), lane = tid & 63, wid = tid >> 6, wm = wid >> 1, wn = wid & 1, h2 = lane >> 5, r = lane & 31;
    if (ph == 0) {
      if (blockIdx.x == 0 && tid < 64) CNT[tid] = 0u;
      cvt_layer(p, 0, WB, lds);
      mod_phase(p, MOD, (float*)smem);
    } else {
      const int l = (ph - 1) / 12, sp = (ph - 1) % 12;
      const float* MODl = MOD + (size_t)l * 5 * 6144;
      if (sp == 0) {
        if (l == 1) cvt_layer(p, 1, WB, lds);
        normmod_rows(p, l == 0, p.norm1_g + l * 1024, MODl, 0, 1024, H);
      } else if (sp == 1) {
        for (int tile = blockIdx.x; tile < 64 * 26; tile += gridDim.x) {
          const int tm = tile & 63, tn = tile >> 6;
          f32x16 acc[2][2];
          zero_acc<2>(acc);
          gemm_acc<2>(acc, H + (size_t)tm * 256 * 1024, 1024, 64, WB + WB_WIN + (size_t)(3072 + tn * 128) * 1024, 1024, 16, lds);
#pragma unroll
          for (int mi = 0; mi < 2; ++mi)
#pragma unroll
            for (int ni = 0; ni < 2; ++ni) {
              const int col = tn * 128 + wn * 64 + ni * 32 + r;
#pragma unroll
              for (int rg = 0; rg < 16; ++rg) {
                const int row = tm * 256 + wm * 64 + mi * 32 + rowof(rg, h2);
                const float v = acc[mi][ni][rg];
                if (tn < 16) PM[(size_t)row * 2048 + col] = f2bf(v);
                else {
                  const int c2 = col - 2048;
                  if (c2 < 1200) PS[(size_t)row * 1216 + c2] = f2bf(v);
                  if (c2 < 16) G[(size_t)row * 16 + c2] = v + p.b_mgate[l * 16 + c2];
                }
              }
            }
        }
      } else if (sp == 2) {
        post_small(p, l, PS, QL, CKV, KR, GQ, GK, GV);
      } else if (sp == 3) {
        for (int tile = blockIdx.x; tile < 384 + 544; tile += gridDim.x) {
          f32x16 acc[2][2];
          zero_acc<2>(acc);
          if (tile < 384) {
            const int tm = tile & 63, tn = tile >> 6;
            gemm_acc<2>(acc, QL + (size_t)tm * 256 * 256, 256, 64, WB + WB_WUQ + (size_t)tn * 128 * 256, 256, 4, lds);
#pragma unroll
            for (int mi = 0; mi < 2; ++mi)
#pragma unroll
              for (int ni = 0; ni < 2; ++ni) {
                const int col = tn * 128 + wn * 64 + ni * 32 + r;
#pragma unroll
                for (int rg = 0; rg < 16; ++rg) {
                  const int row = tm * 256 + wm * 64 + mi * 32 + rowof(rg, h2);
                  QA[(size_t)row * 768 + col] = f2bf(acc[mi][ni][rg]);
                }
              }
          } else {
            const int t2 = tile - 384, tm = t2 % 68, tn = t2 / 68;
            gemm_acc<2>(acc, CKV + (size_t)tm * 256 * 128, 128, 64, WB + WB_WUKV + (size_t)tn * 128 * 128, 128, 2, lds);
#pragma unroll
            for (int mi = 0; mi < 2; ++mi)
#pragma unroll
              for (int ni = 0; ni < 2; ++ni) {
                const int col = tn * 128 + wn * 64 + ni * 32 + r;
                const int hd = col >> 7, jj = col & 127;
                const int dcol = hd * 160 + (jj < 64 ? jj : jj + 32);
#pragma unroll
                for (int rg = 0; rg < 16; ++rg) {
                  const int row = tm * 256 + wm * 64 + mi * 32 + rowof(rg, h2);
                  KAV[(size_t)row * 1280 + dcol] = f2bf(acc[mi][ni][rg]);
                }
              }
          }
        }
      } else if (sp == 4) {
        post_mla(p, l, QA, KAV, KR);
      } else if (sp == 5) {
        mixers_phase(p, l, CNT + l, PM, G, HF, HB, QA, KAV, GQ, GK, GV, lds);
      } else if (sp == 6) {
        post_mlstm(p, l, HF, HB, PM);
        normmod_rows(p, l == 0, p.norm1_g + l * 1024, MODl, 0, 1024, H);
      } else if (sp == 7) {
        for (int tile = blockIdx.x; tile < 1024; tile += gridDim.x) {
          const int tm = tile & 63, tn = tile >> 6;
          f32x16 mix[2][1];
          zero_acc<1>(mix);
#pragma unroll 1
          for (int n = 0; n < 3; ++n) {
            f32x16 ag[2][1], ab[2][1];
            zero_acc<1>(ag);
            zero_acc<1>(ab);
            gemm_acc<1>(ag, H + (size_t)tm * 256 * 1024, 1024, 64, WB + WB_WIN + (size_t)(n * 1024 + tn * 64) * 1024, 1024, 16, lds);
            const bf16_t* Ab = (n == 0) ? HF + (size_t)tm * 256 * 512 : (n == 1) ? QA + (size_t)tm * 256 * 768 : GQ + (size_t)tm * 256 * 512;
            const int ldab = (n == 1) ? 768 : 512, aks = (n == 1) ? 96 : 64;
            gemm_acc<1>(ab, Ab, ldab, aks, WB + WB_WBR + (size_t)n * 1024 * 512 + (size_t)tn * 64 * 512, 512, 8, lds);
#pragma unroll
            for (int mi = 0; mi < 2; ++mi)
#pragma unroll
              for (int rg = 0; rg < 16; ++rg) mix[mi][0][rg] += sigmoidf_(ag[mi][0][rg]) * ab[mi][0][rg];
          }
#pragma unroll
          for (int mi = 0; mi < 2; ++mi) {
            const int col = tn * 64 + wn * 32 + r;
#pragma unroll
            for (int rg = 0; rg < 16; ++rg) {
              const int row = tm * 256 + wm * 64 + mi * 32 + rowof(rg, h2);
              MIX[(size_t)row * 1024 + col] = f2bf(mix[mi][0][rg]);
            }
          }
        }
      } else if (sp == 8) {
        for (int tile = blockIdx.x; tile < 512; tile += gridDim.x) {
          const int tm = tile & 63, tn = tile >> 6;
          f32x16 acc[2][2];
          zero_acc<2>(acc);
          gemm_acc<2>(acc, MIX + (size_t)tm * 256 * 1024, 1024, 64, WB + WB_WOUT + (size_t)tn * 128 * 1024, 1024, 16, lds);
#pragma unroll
          for (int mi = 0; mi < 2; ++mi)
#pragma unroll
            for (int ni = 0; ni < 2; ++ni) {
              const int col = tn * 128 + wn * 64 + ni * 32 + r;
#pragma unroll
              for (int rg = 0; rg < 16; ++rg) {
                const int row = tm * 256 + wm * 64 + mi * 32 + rowof(rg, h2);
                const float gt = MODl[mod_index(row) * 6144 + 2048 + col];
                const float xin = (l == 0) ? (row < NCTX ? p.x_prompt[(size_t)row * 1024 + col] : p.x_sample[(size_t)(row - NCTX) * 1024 + col])
                                           : p.out[(size_t)row * 1024 + col];
                p.out[(size_t)row * 1024 + col] = xin + gt * acc[mi][ni][rg];
              }
            }
        }
      } else if (sp == 9) {
        normmod_rows(p, false, p.norm2_g + l * 1024, MODl, 3072, 4096, H);
      } else if (sp == 10) {
        for (int tile = blockIdx.x; tile < 64 * 44; tile += gridDim.x) {
          const int tm = tile & 63, tn = tile >> 6;
          f32x16 acc[2][2];
          zero_acc<2>(acc);
          gemm_acc<2>(acc, H + (size_t)tm * 256 * 1024, 1024, 64, WB + WB_WFI + (size_t)tn * 128 * 1024, 1024, 16, lds);
#pragma unroll
          for (int mi = 0; mi < 2; ++mi) {
            const int col = tn * 64 + wn * 32 + r;
#pragma unroll
            for (int rg = 0; rg < 16; ++rg) {
              const int row = tm * 256 + wm * 64 + mi * 32 + rowof(rg, h2);
              const float ug = acc[mi][0][rg], uv = acc[mi][1][rg];
              ACT[(size_t)row * DFF + col] = f2bf(ug * sigmoidf_(ug) * uv);
            }
          }
        }
      } else {
        for (int tile = blockIdx.x; tile < 512; tile += gridDim.x) {
          const int tm = tile & 63, tn = tile >> 6;
          f32x16 acc[2][2];
          zero_acc<2>(acc);
          gemm_acc<2>(acc, ACT + (size_t)tm * 256 * DFF, DFF, 64, WB + WB_WFO + (size_t)tn * 128 * DFF, DFF, 44, lds);
#pragma unroll
          for (int mi = 0; mi < 2; ++mi)
#pragma unroll
            for (int ni = 0; ni < 2; ++ni) {
              const int col = tn * 128 + wn * 64 + ni * 32 + r;
#pragma unroll
              for (int rg = 0; rg < 16; ++rg) {
                const int row = tm * 256 + wm * 64 + mi * 32 + rowof(rg, h2);
                const float gt = MODl[mod_index(row) * 6144 + 5120 + col];
                p.out[(size_t)row * 1024 + col] += gt * acc[mi][ni][rg];
              }
            }
        }
      }
    }
    if (ph + 1 < p.ph_hi) grid.sync();
  }
}

extern "C" void kernel_launch(void* const* d_in, const int* in_sizes, int n_in, void* d_out, int out_size, void* d_ws, size_t ws_size,
                              hipStream_t stream) {
  static int grid_blocks = 0;
  if (!grid_blocks) {
    int dev = 0, cus = 0, per_cu = 0;
    (void)hipGetDevice(&dev);
    (void)hipDeviceGetAttribute(&cus, hipDeviceAttributeMultiprocessorCount, dev);
    (void)hipFuncSetAttribute((const void*)fwd_megakernel, hipFuncAttributeMaxDynamicSharedMemorySize, (int)DYN_LDS);
    (void)hipOccupancyMaxActiveBlocksPerMultiprocessor(&per_cu, fwd_megakernel, 512, DYN_LDS);
    if (per_cu > 1) per_cu = 1;
    if (per_cu < 1) per_cu = 1;
    grid_blocks = cus * per_cu;
  }
  if (ws_size < WS_END) fprintf(stderr, "workspace too small: %zu < %zu\n", ws_size, (size_t)WS_END);
  Params p{};
  const float* const* in = (const float* const*)d_in;
  p.x_prompt = in[0]; p.x_sample = in[1]; p.st_C = in[2]; p.st_n = in[3]; p.st_m = in[4]; p.c_ckv = in[5]; p.c_kr = in[6];
  p.c_gk = in[7]; p.c_gv = in[8]; p.c = in[9]; p.c_ctx = in[10]; p.w_mod = in[11]; p.b_mod = in[12]; p.norm1_g = in[13];
  p.w_in = in[14]; p.b_mgate = in[15]; p.m_norm_g = in[16]; p.a_qlora_g = in[17]; p.a_kvlora_g = in[18]; p.w_uq = in[19];
  p.w_ukv = in[20]; p.a_qnorm_g = in[21]; p.a_knorm_g = in[22]; p.g_qnorm_g = in[23]; p.g_knorm_g = in[24]; p.w_branch = in[25];
  p.w_out = in[26]; p.norm2_g = in[27]; p.w_ffn_in = in[28]; p.w_ffn_out = in[29];
  p.out = (float*)d_out;
  p.ws = (unsigned char*)d_ws;
#if MULTI_LAUNCH
#ifndef RUN_PHASES
#define RUN_PHASES NPHASE
#endif
  for (int ph = 0; ph < RUN_PHASES; ++ph) {
    p.ph_lo = ph; p.ph_hi = ph + 1;
    hipLaunchKernelGGL(fwd_megakernel, dim3(grid_blocks), dim3(512), DYN_LDS, stream, p);
  }
#ifdef DUMP_OFF
  p.ph_lo = 99; p.ph_hi = 100;
  hipLaunchKernelGGL(fwd_megakernel, dim3(grid_blocks), dim3(512), DYN_LDS, stream, p);
#endif
#else
  p.ph_lo = 0; p.ph_hi = NPHASE;
  void* args[] = {&p};
  hipError_t e = hipLaunchCooperativeKernel((void*)fwd_megakernel, dim3(grid_blocks), dim3(512), args, DYN_LDS, stream);
  if (e != hipSuccess) fprintf(stderr, "cooperative launch failed: %s (grid %d)\n", hipGetErrorString(e), grid_blocks);
#endif
}
```

```cpp
#include <hip/hip_runtime.h>
#include <hip/hip_cooperative_groups.h>
#include <cstdio>
namespace cg = cooperative_groups;

typedef unsigned short bf16_t;
typedef short bf16x8 __attribute__((ext_vector_type(8)));
typedef float f32x16 __attribute__((ext_vector_type(16)));
typedef float f32x4 __attribute__((ext_vector_type(4)));
typedef float f32x2 __attribute__((ext_vector_type(2)));
typedef unsigned u32x4 __attribute__((ext_vector_type(4)));
typedef unsigned u32x2 __attribute__((ext_vector_type(2)));

#ifndef MIXSEL
#define MIXSEL 7
#endif
#ifndef MULTI_LAUNCH
#define MULTI_LAUNCH 0
#endif

constexpr int NTOK = 16384, NCTX = 8192, NKV = 17408;
constexpr int DIN = 6320, DFF = 2816;
constexpr float EPS = 1e-6f;
constexpr int NPHASE = 27;
constexpr size_t DYN_LDS = 131072 + 64;

constexpr size_t WB_WIN = 0;
constexpr size_t WB_WUQ = WB_WIN + 6400ull * 1024;
constexpr size_t WB_WUKV = WB_WUQ + 768ull * 256;
constexpr size_t WB_WBR = WB_WUKV + 1024ull * 128;
constexpr size_t WB_WOUT = WB_WBR + 3ull * 1024 * 512;
constexpr size_t WB_WFI = WB_WOUT + 1024ull * 1024;
constexpr size_t WB_WFO = WB_WFI + 5632ull * 1024;
constexpr size_t WB_ELEMS = WB_WFO + 1024ull * 2816;

constexpr size_t OFF_R0 = 0;
constexpr size_t OFF_R1 = OFF_R0 + WB_ELEMS * 2;
constexpr size_t OFF_R2 = OFF_R1 + 16384ull * 2048 * 2;
constexpr size_t OFF_R3 = OFF_R2 + 16384ull * 1216 * 2;
constexpr size_t OFF_HF = OFF_R3 + 17408ull * 1280 * 2;
constexpr size_t OFF_YA = OFF_HF + 16384ull * 512 * 2;
constexpr size_t OFF_QL = OFF_YA;
constexpr size_t OFF_CKV = OFF_QL + 16384ull * 256 * 2;
constexpr size_t OFF_KR = OFF_CKV + 17408ull * 128 * 2;
constexpr size_t OFF_GQ = OFF_YA + 16384ull * 512 * 2;
constexpr size_t OFF_HB = OFF_GQ + 16384ull * 512 * 2;
constexpr size_t OFF_GK = OFF_HB + 16384ull * 512 * 2;
constexpr size_t OFF_GV = OFF_GK + 17408ull * 128 * 2;
constexpr size_t OFF_G = OFF_GV + 17408ull * 128 * 2;
constexpr size_t OFF_MOD = OFF_G + 16384ull * 16 * 4;
constexpr size_t OFF_CNT = OFF_MOD + 2ull * 5 * 6144 * 4;
static_assert(OFF_KR + 17408ull * 32 * 2 <= OFF_GQ, "QL/CKV/KR must fit under YA");
constexpr size_t OFF_SG8 = OFF_R1;
constexpr size_t OFF_MIX = OFF_R1 + 16384ull * 3072;
constexpr size_t OFF_PCOPY = OFF_CNT + 2048;
constexpr size_t OFF_BAR = OFF_CNT + 4096;
constexpr size_t OFF_TG = OFF_BAR + 16384;
constexpr size_t OFF_TA = OFF_TG + 2048ull * 32 * 8;
constexpr size_t OFF_SS = OFF_TA + 2048ull * 16 * 8;
constexpr size_t WS_END = OFF_SS + 16384ull * 4 * 4;

constexpr size_t O_Y = 0;
constexpr size_t O_C = 16777216;
constexpr size_t O_N = O_C + 8388608;
constexpr size_t O_M = O_N + 65536;
constexpr size_t O_CKV = O_M + 512;
constexpr size_t O_KR = O_CKV + 2097152;
constexpr size_t O_GK = O_KR + 524288;
constexpr size_t O_GV = O_GK + 2097152;

struct Params {
  const float *x_prompt, *x_sample, *st_C, *st_n, *st_m, *c_ckv, *c_kr, *c_gk, *c_gv, *c, *c_ctx;
  const float *w_mod, *b_mod, *norm1_g, *w_in, *b_mgate, *m_norm_g, *a_qlora_g, *a_kvlora_g, *w_uq, *w_ukv;
  const float *a_qnorm_g, *a_knorm_g, *g_qnorm_g, *g_knorm_g, *w_branch, *w_out, *norm2_g, *w_ffn_in, *w_ffn_out;
  float* out;
  unsigned char* ws;
  int ph_lo, ph_hi;
};

typedef __attribute__((address_space(1))) const float* gcfp_t;
struct ParamsG {
  gcfp_t f[30];
  __attribute__((address_space(1))) float* out;
  __attribute__((address_space(1))) unsigned char* ws;
  int ph_lo, ph_hi;
};
static_assert(sizeof(ParamsG) == sizeof(Params), "ParamsG must mirror Params");

typedef __bf16 bf16x2_t __attribute__((ext_vector_type(2)));
__device__ __forceinline__ unsigned cvt_pk_bf16(float lo, float hi) {
  f32x2 v = {lo, hi};
  bf16x2_t b = __builtin_convertvector(v, bf16x2_t);
  return __builtin_bit_cast(unsigned, b);
}
__device__ __forceinline__ bf16_t f2bf(float f) { return (bf16_t)(cvt_pk_bf16(f, 0.f) & 0xffffu); }
__device__ __forceinline__ float bf2f(bf16_t v) { return __uint_as_float(((unsigned)v) << 16); }
__device__ __forceinline__ float bflo(unsigned u) { return __uint_as_float(u << 16); }
__device__ __forceinline__ float bfhi(unsigned u) { return __uint_as_float(u & 0xffff0000u); }
__device__ __forceinline__ float wave_sum(float v) {
#pragma unroll
  for (int d = 1; d < 64; d <<= 1) v += __shfl_xor(v, d);
  return v;
}
__device__ __forceinline__ float half_sum(float v) {
#pragma unroll
  for (int d = 1; d < 32; d <<= 1) v += __shfl_xor(v, d);
  return v;
}
__device__ __forceinline__ float wave_max(float v) {
#pragma unroll
  for (int d = 1; d < 64; d <<= 1) v = fmaxf(v, __shfl_xor(v, d));
  return v;
}
__device__ __forceinline__ int opaque_tid() {
  int t = threadIdx.x;
  asm volatile("" : "+v"(t));
  return t;
}
__device__ __forceinline__ int opaque_bid() {
  int b = blockIdx.x;
  asm volatile("" : "+s"(b));
  return b;
}
__device__ __forceinline__ int opaque_gdim() {
  int g = gridDim.x;
  asm volatile("" : "+s"(g));
  return g;
}
__device__ __forceinline__ float cross_half_max(float x) {
  const unsigned u = __float_as_uint(x);
  const u32x2 rr = __builtin_amdgcn_permlane32_swap(u, u, false, false);
  return fmaxf(__uint_as_float(rr[0]), __uint_as_float(rr[1]));
}
__device__ __forceinline__ void lds_barrier() {
  asm volatile("s_waitcnt lgkmcnt(0)" ::: "memory");
  __builtin_amdgcn_s_barrier();
  asm volatile("" ::: "memory");
}
__device__ __forceinline__ float sigmoidf_(float x) { return __builtin_amdgcn_rcpf(1.0f + __builtin_amdgcn_exp2f(x * -1.4426950408889634f)); }
__device__ __forceinline__ int rowof(int reg, int h2) { return (reg & 3) + 8 * (reg >> 2) + 4 * h2; }
__device__ __forceinline__ int mod_index(int row) { return row < NCTX ? 0 : 1 + ((row - NCTX) >> 11); }

namespace pg8 {
#define PG8_LAS __attribute__((address_space(3)))
typedef unsigned short bf16_t;
typedef short bf16x8 __attribute__((ext_vector_type(8)));
typedef float f32x4 __attribute__((ext_vector_type(4)));
typedef unsigned u32x4 __attribute__((ext_vector_type(4)));
constexpr int BM = 256, BK = 64, HALF = 128, HTB = HALF * BK * 2  , STAGE_BYTES = 8 * HTB, NXCD = 8, WGM = 4;

__host__ __device__ __forceinline__ int lds_byte(int r, int c) { const int st = (r >> 4) * 2 + (c >> 5), rr = r & 15, cc = c & 31, ob = rr * 64 + cc * 2; return st * 1024 + (ob ^ (((ob >> 9) & 1) << 5)); }
__host__ __device__ __forceinline__ void stage_rc(int b, int& R, int& C) { const int st = b / 1024, sb = b % 1024, swz = sb ^ (((sb >> 9) & 1) << 5); R = (st >> 1) * 16 + swz / 64; C = (st & 1) * 32 + (swz % 64) / 2; }
__host__ __device__ __forceinline__ int perm32(int rho) { const int n = rho >> 4, i = rho & 15; return 8 * (i >> 2) + 4 * n + (i & 3); }

struct Unit { int pm, pn; };
struct Gemm { const bf16_t* A; const bf16_t* Bt; int M, N, K; };

struct StaticOrder {
    int nM, nN, nwg, G, c;
    __host__ __device__ void init(int M, int N, int G_, int c_) { nM = M / BM; nN = N / BM; nwg = nM * nN; G = G_; c = c_; }
    __host__ __device__ bool next(int i, Unit& u) const {
        const long L = (long)i * G + c; if (L >= nwg) return false;
        int wgid = (int)L; { const int q = nwg / NXCD, r = nwg % NXCD, xcd = wgid % NXCD, off = wgid / NXCD; wgid = (xcd < r ? xcd * (q + 1) : r * (q + 1) + (xcd - r) * q) + off; }
        const int nig = WGM * nN, gid = wgid / nig, fm = gid * WGM, gsz = (nM - fm) < WGM ? (nM - fm) : WGM;
        u.pm = fm + ((wgid % nig) % gsz); u.pn = (wgid % nig) / gsz; return true;
    }
    __device__ __forceinline__ void a_ready(const Unit&) const {}
    __device__ __forceinline__ void done(const Unit&) const {}
};
template <class Epi, class Sched, bool STAMP = false>
__device__ __forceinline__ void gemm_phase(PG8_LAS unsigned char* lds, const Gemm g, const Sched& S, const Epi& E, unsigned long long* stamps) {
    const int tid = opaque_tid(), wid = __builtin_amdgcn_readfirstlane(tid >> 6), lane = tid & 63, wr = wid >> 2, wc = wid & 3, fr = lane & 15, fq = lane >> 4;
    const int K = g.K, nt = K / BK;
    int ts_lo = 0, ts_hi = 0, nts = 0; const unsigned long long rt_entry = STAMP ? (unsigned long long)wall_clock64() : 0ull;
#define PG8_STAMP() do { if (STAMP && wid == 0 && nts < 64) { const unsigned long long _c = (unsigned long long)clock64(); \
        ts_lo = (lane == nts) ? (int)(unsigned)_c : ts_lo; ts_hi = (lane == nts) ? (int)(unsigned)(_c >> 32) : ts_hi; ++nts; } } while (0)
    PG8_STAMP();
    unsigned voffA[2], voffB[2];
#pragma unroll
    for (int i = 0; i < 2; ++i) { int R, C; stage_rc(tid * 16 + i * 8192, R, C); const int Rb = Epi::PERM ? ((R & ~31) + perm32(R & 31)) : R;
        voffA[i] = (unsigned)(R * K + C) * 2u; voffB[i] = (unsigned)(Rb * K + C) * 2u; }
    const size_t kstep = (size_t)(BK * 2);
    const size_t hstep = (size_t)HALF * K * 2;
    const size_t tstep = 2 * hstep;
    const unsigned ldsw = (unsigned)wid * 1024u;
    const int aoff = lds_byte(wr * 64 + fr, fq * 8), boff = lds_byte(wc * 32 + fr, fq * 8);
#define PG8_SA(b, h) (((b) * 2 + (h)) * HTB)
#define PG8_SB(b, h) ((4 + (b) * 2 + (h)) * HTB)
#define PG8_STAGE(bufoff, gbase, voff) do { _Pragma("unroll") for (int _i = 0; _i < 2; ++_i) \
        __builtin_amdgcn_global_load_lds((const unsigned*)((const char*)(gbase) + (voff)[_i]), (PG8_LAS unsigned*)(lds + (bufoff) + ldsw + _i * 8192), 16, 0, 0); } while (0)
#define PG8_LDA(dst, b, h) do { _Pragma("unroll") for (int m = 0; m < 4; ++m) _Pragma("unroll") for (int k = 0; k < 2; ++k) dst[m][k] = *(const PG8_LAS bf16x8*)(lds + PG8_SA(b, h) + aoff + m * 2048 + k * 1024); } while (0)
#define PG8_LDB(dst, b, h) do { _Pragma("unroll") for (int n = 0; n < 2; ++n) _Pragma("unroll") for (int k = 0; k < 2; ++k) dst[n][k] = *(const PG8_LAS bf16x8*)(lds + PG8_SB(b, h) + boff + n * 2048 + k * 1024); } while (0)
#define PG8_MMA(ai, bj, At, Bt) do { __builtin_amdgcn_s_setprio(1); _Pragma("unroll") for (int m = 0; m < 4; ++m) _Pragma("unroll") for (int n = 0; n < 2; ++n) _Pragma("unroll") for (int k = 0; k < 2; ++k) \
        acc[ai][bj][m][n] = __builtin_amdgcn_mfma_f32_16x16x32_bf16(Bt[n][k], At[m][k], acc[ai][bj][m][n], 0, 0, 0); __builtin_amdgcn_s_setprio(0); } while (0)
#define PG8_WAIT_V(n) asm volatile("s_waitcnt vmcnt(" #n ")" ::: "memory")
#define PG8_WAIT_L(n) asm volatile("s_waitcnt lgkmcnt(" #n ")" ::: "memory")
#define PG8_BAR __builtin_amdgcn_s_barrier()
#define PG8_SCHED __builtin_amdgcn_sched_barrier(0)
    Unit cur, nxt; int ui = 0;
    if (!S.next(0, cur)) return;
    f32x4 acc[2][2][4][2];
#pragma unroll
    for (int a = 0; a < 2; ++a)
#pragma unroll
        for (int b = 0; b < 2; ++b)
#pragma unroll
            for (int m = 0; m < 4; ++m)
#pragma unroll
                for (int n = 0; n < 2; ++n) acc[a][b][m][n] = (f32x4){0.f, 0.f, 0.f, 0.f};
    bf16x8 At[4][2], B0[2][2], B1[2][2];
    const char* cA = (const char*)g.A + (size_t)cur.pm * tstep; const char* cB = (const char*)g.Bt + (size_t)cur.pn * tstep;
    S.a_ready(cur);
    PG8_STAGE(PG8_SB(0, 0), cB, voffB); PG8_STAGE(PG8_SA(0, 0), cA, voffA); PG8_STAGE(PG8_SB(0, 1), cB + hstep, voffB); PG8_STAGE(PG8_SA(0, 1), cA + hstep, voffA);
    if (wr == 1) PG8_BAR;
    PG8_WAIT_V(4); PG8_BAR;
    PG8_STAGE(PG8_SB(1, 0), cB + kstep, voffB); PG8_STAGE(PG8_SA(1, 0), cA + kstep, voffA); PG8_STAGE(PG8_SB(1, 1), cB + hstep + kstep, voffB);
    PG8_WAIT_V(6); PG8_BAR;
    PG8_STAMP();
    for (;;) {
        const bool has_next = S.next(ui + 1, nxt);
        const char* nA = has_next ? (const char*)g.A + (size_t)nxt.pm * tstep : cA; const char* nB = has_next ? (const char*)g.Bt + (size_t)nxt.pn * tstep : cB;
        for (int t = 0; t < nt; t += 2) {
            const bool last = (t == nt - 2);
            const char* a1 = cA + (size_t)(t + 1) * kstep;
            const char* a2 = last ? nA : cA + (size_t)(t + 2) * kstep; const char* b2 = last ? nB : cB + (size_t)(t + 2) * kstep;
            const char* a3 = a2 + kstep; const char* b3 = b2 + kstep;
            if (last && has_next) S.a_ready(nxt);
            PG8_LDB(B0, 0, 0); PG8_SCHED; PG8_LDA(At, 0, 0); PG8_STAGE(PG8_SA(1, 1), a1 + hstep, voffA);
            PG8_WAIT_L(8); PG8_BAR; PG8_WAIT_L(0); PG8_MMA(0, 0, At, B0); PG8_BAR; PG8_SCHED;
            PG8_LDB(B1, 0, 1); PG8_STAGE(PG8_SB(0, 0), b2, voffB);
            PG8_BAR; PG8_WAIT_L(0); PG8_MMA(0, 1, At, B1); PG8_BAR;
            PG8_LDA(At, 0, 1); PG8_STAGE(PG8_SA(0, 0), a2, voffA);
            PG8_BAR; PG8_WAIT_L(0); PG8_MMA(1, 0, At, B0); PG8_BAR; PG8_SCHED;
            PG8_STAGE(PG8_SB(0, 1), b2 + hstep, voffB);
            PG8_WAIT_V(6); PG8_BAR; PG8_MMA(1, 1, At, B1); PG8_BAR;
            PG8_LDB(B0, 1, 0); PG8_SCHED; PG8_LDA(At, 1, 0); PG8_STAGE(PG8_SA(0, 1), a2 + hstep, voffA);
            PG8_WAIT_L(8); PG8_BAR; PG8_WAIT_L(0); PG8_MMA(0, 0, At, B0); PG8_BAR; PG8_SCHED;
            PG8_LDB(B1, 1, 1); PG8_STAGE(PG8_SB(1, 0), b3, voffB);
            PG8_BAR; PG8_WAIT_L(0); PG8_MMA(0, 1, At, B1); PG8_BAR;
            PG8_LDA(At, 1, 1); PG8_STAGE(PG8_SA(1, 0), a3, voffA);
            PG8_BAR; PG8_WAIT_L(0); PG8_MMA(1, 0, At, B0); PG8_BAR; PG8_SCHED;
            PG8_STAGE(PG8_SB(1, 1), b3 + hstep, voffB);
            PG8_WAIT_V(6); PG8_BAR; PG8_MMA(1, 1, At, B1); PG8_BAR;
        }
        PG8_STAMP();
        if constexpr (!Epi::AFTER_DRAIN) { E(acc, cur, wr, wc, fr, fq); S.done(cur); }
        PG8_STAMP();
        if (!has_next) break;
#pragma unroll
        for (int a = 0; a < 2; ++a)
#pragma unroll
            for (int b = 0; b < 2; ++b)
#pragma unroll
                for (int m = 0; m < 4; ++m)
#pragma unroll
                    for (int n = 0; n < 2; ++n) acc[a][b][m][n] = (f32x4){0.f, 0.f, 0.f, 0.f};
        cur = nxt; cA = nA; cB = nB; ++ui;
    }
    PG8_WAIT_V(0);
    if (wr == 0) PG8_BAR;
    PG8_BAR;
    if constexpr (Epi::AFTER_DRAIN) { E.fused(acc, cur, wr, wc, fr, fq, lds, wid, lane); S.done(cur); }
    PG8_STAMP();
    if (STAMP && wid == 0) { stamps[lane] = lane < nts ? (((unsigned long long)(unsigned)ts_hi << 32) | (unsigned)ts_lo) : 0ull;
        if (lane == 62) stamps[62] = rt_entry; if (lane == 63) stamps[63] = (unsigned long long)wall_clock64(); }
#undef PG8_STAMP
#undef PG8_SA
#undef PG8_SB
#undef PG8_STAGE
#undef PG8_LDA
#undef PG8_LDB
#undef PG8_MMA
#undef PG8_WAIT_V
#undef PG8_WAIT_L
#undef PG8_BAR
#undef PG8_SCHED
}
}

struct EpiP2 {
  static constexpr bool PERM = true, AFTER_DRAIN = false;
  bf16_t* PM; bf16_t* PS; float* G; const float* bias;
  __device__ __forceinline__ void operator()(const f32x4 (&acc)[2][2][4][2], const pg8::Unit& u, int wr, int wc, int fr, int fq) const {
    const int row0 = u.pm * 256 + wr * 64 + fr, colt = u.pn * 256 + wc * 32 + 8 * fq;
#pragma unroll
    for (int ai = 0; ai < 2; ++ai)
#pragma unroll
      for (int m = 0; m < 4; ++m) {
        const int row = row0 + ai * 128 + m * 16;
#pragma unroll
        for (int bj = 0; bj < 2; ++bj) {
          const int col = colt + bj * 128;
          const f32x4 v0 = acc[ai][bj][m][0], v1 = acc[ai][bj][m][1];
          u32x4 w;
          w.x = cvt_pk_bf16(v0[0], v0[1]); w.y = cvt_pk_bf16(v0[2], v0[3]);
          w.z = cvt_pk_bf16(v1[0], v1[1]); w.w = cvt_pk_bf16(v1[2], v1[3]);
          if (u.pn < 8) *(u32x4*)(PM + (size_t)row * 2048 + col) = w;
          else {
            const int c2 = col - 2048;
            if (c2 < 1200) *(u32x4*)(PS + (size_t)row * 1216 + c2) = w;
            if (c2 < 16) {
              *(f32x4*)(G + (size_t)row * 16 + c2) = v0 + *(const f32x4*)(bias + c2);
              *(f32x4*)(G + (size_t)row * 16 + c2 + 4) = v1 + *(const f32x4*)(bias + c2 + 4);
            }
          }
        }
      }
  }
};
struct EpiRes {
  static constexpr bool PERM = false, AFTER_DRAIN = true;
  const float* xp; const float* xs; float* out; const float* MODl; int gt_off; int from_input;
  int do_norm; const float* ng; const float* MODn; int sh_off, sc_off; bf16_t* H; unsigned* SS; unsigned* cnt;
  __device__ __forceinline__ void fused(f32x4 (&acc)[2][2][4][2], const pg8::Unit& u, int wr, int wc, int fr, int fq, PG8_LAS unsigned char* lds, int wid, int lane) const {
    const int row0 = u.pm * 256 + wr * 64 + fr, colt = u.pn * 256 + wc * 32 + 4 * fq;
#pragma unroll
    for (int ai = 0; ai < 2; ++ai)
#pragma unroll
      for (int m = 0; m < 4; ++m) {
        const int row = row0 + ai * 128 + m * 16;
        const float* md = MODl + mod_index(row) * 6144 + gt_off;
        const float* xin = from_input ? (row < NCTX ? xp + (size_t)row * 1024 : xs + (size_t)(row - NCTX) * 1024) : out + (size_t)row * 1024;
        float* xo = out + (size_t)row * 1024;
#pragma unroll
        for (int bj = 0; bj < 2; ++bj)
#pragma unroll
          for (int n = 0; n < 2; ++n) {
            const int col = colt + bj * 128 + n * 16;
            const f32x4 gt = *(const f32x4*)(md + col), xi = *(const f32x4*)(xin + col);
            const f32x4 v = xi + gt * acc[ai][bj][m][n];
            acc[ai][bj][m][n] = v;
            *(f32x4*)(xo + col) = v;
          }
      }
    if (!do_norm) return;
    PG8_LAS float* P = (PG8_LAS float*)lds;
    PG8_LAS float* Rr = (PG8_LAS float*)(lds + 4096);
    const int t = wid * 64 + lane;
#pragma unroll
    for (int ai = 0; ai < 2; ++ai)
#pragma unroll
      for (int m = 0; m < 4; ++m) {
        float ss = 0.f;
#pragma unroll
        for (int bj = 0; bj < 2; ++bj)
#pragma unroll
          for (int n = 0; n < 2; ++n) { const f32x4 v = acc[ai][bj][m][n]; ss += (v[0] * v[0] + v[1] * v[1]) + (v[2] * v[2] + v[3] * v[3]); }
        ss += __shfl_xor(ss, 16);
        ss += __shfl_xor(ss, 32);
        if (fq == 0) P[(ai * 128 + wr * 64 + m * 16 + fr) * 4 + wc] = ss;
      }
    lds_barrier();
    if (t < 256) {
      const float s = (P[t * 4 + 0] + P[t * 4 + 1]) + (P[t * 4 + 2] + P[t * 4 + 3]);
      __hip_atomic_store(SS + (size_t)(u.pm * 256 + t) * 4 + u.pn, __float_as_uint(s), __ATOMIC_RELAXED, __HIP_MEMORY_SCOPE_AGENT);
    }
    asm volatile("s_waitcnt vmcnt(0)" ::: "memory");
    lds_barrier();
    if (t == 0) __hip_atomic_fetch_add(cnt + u.pm, 1u, __ATOMIC_RELAXED, __HIP_MEMORY_SCOPE_AGENT);
    if (wid == 0) {
      unsigned sp_ = 0;
      while ((unsigned)__builtin_amdgcn_readfirstlane(__hip_atomic_load(cnt + u.pm, __ATOMIC_RELAXED, __HIP_MEMORY_SCOPE_AGENT)) < 4u) {
        __builtin_amdgcn_s_sleep(2);
        if (++sp_ > (1u << 20)) break;
      }
      __builtin_amdgcn_fence(__ATOMIC_ACQUIRE, "agent");
      asm volatile("s_waitcnt vmcnt(0)" ::: "memory");
    }
    lds_barrier();
    if (t < 256) {
      const unsigned* sl = SS + (size_t)(u.pm * 256 + t) * 4;
      float tot = 0.f;
#pragma unroll
      for (int q = 0; q < 4; ++q) tot += __uint_as_float(__hip_atomic_load(sl + q, __ATOMIC_RELAXED, __HIP_MEMORY_SCOPE_AGENT));
      Rr[t] = rsqrtf(tot * (1.0f / 1024.0f) + EPS);
    }
    lds_barrier();
    const float* mn = MODn + mod_index(u.pm * 256) * 6144;
#pragma unroll
    for (int bj = 0; bj < 2; ++bj)
#pragma unroll
      for (int n = 0; n < 2; ++n) {
        const int col = colt + bj * 128 + n * 16;
        const f32x4 g4 = *(const f32x4*)(ng + col), sc = *(const f32x4*)(mn + sc_off + col), sh = *(const f32x4*)(mn + sh_off + col);
#pragma unroll
        for (int ai = 0; ai < 2; ++ai)
#pragma unroll
          for (int m = 0; m < 4; ++m) {
            const int rl = ai * 128 + wr * 64 + m * 16 + fr;
            const float rstd = Rr[rl];
            const f32x4 v = acc[ai][bj][m][n];
            float y[4];
#pragma unroll
            for (int e = 0; e < 4; ++e) y[e] = v[e] * rstd * g4[e] * (1.0f + sc[e]) + sh[e];
            u32x2 w;
            w.x = cvt_pk_bf16(y[0], y[1]);
            w.y = cvt_pk_bf16(y[2], y[3]);
            *(u32x2*)(H + (size_t)(u.pm * 256 + rl) * 1024 + col) = w;
          }
      }
  }
};
struct EpiSwiGLU {
  static constexpr bool PERM = true, AFTER_DRAIN = false;
  bf16_t* ACT;
  __device__ __forceinline__ void operator()(const f32x4 (&acc)[2][2][4][2], const pg8::Unit& u, int wr, int wc, int fr, int fq) const {
    const int row0 = u.pm * 256 + wr * 64 + fr, colt = u.pn * 128 + wc * 32 + 8 * fq;
#pragma unroll
    for (int ai = 0; ai < 2; ++ai)
#pragma unroll
      for (int m = 0; m < 4; ++m) {
        const int row = row0 + ai * 128 + m * 16;
        float y[8];
#pragma unroll
        for (int n = 0; n < 2; ++n) {
          const f32x4 g = acc[ai][0][m][n], v = acc[ai][1][m][n];
#pragma unroll
          for (int e = 0; e < 4; ++e) y[4 * n + e] = g[e] * sigmoidf_(g[e]) * v[e];
        }
        u32x4 w;
        w.x = cvt_pk_bf16(y[0], y[1]); w.y = cvt_pk_bf16(y[2], y[3]); w.z = cvt_pk_bf16(y[4], y[5]); w.w = cvt_pk_bf16(y[6], y[7]);
        *(u32x4*)(ACT + (size_t)row * DFF + colt) = w;
      }
  }
};
struct EpiGate8 {
  static constexpr bool PERM = true, AFTER_DRAIN = false;
  unsigned char* SG;
  __device__ __forceinline__ void operator()(const f32x4 (&acc)[2][2][4][2], const pg8::Unit& u, int wr, int wc, int fr, int fq) const {
    const int row0 = u.pm * 256 + wr * 64 + fr, colt = u.pn * 256 + wc * 32 + 8 * fq;
#pragma unroll
    for (int ai = 0; ai < 2; ++ai)
#pragma unroll
      for (int m = 0; m < 4; ++m) {
        const int row = row0 + ai * 128 + m * 16;
#pragma unroll
        for (int bj = 0; bj < 2; ++bj) {
          u32x2 w = {0u, 0u};
#pragma unroll
          for (int e = 0; e < 4; ++e) {
            w.x |= ((unsigned)(sigmoidf_(acc[ai][bj][m][0][e]) * 255.0f + 0.5f)) << (8 * e);
            w.y |= ((unsigned)(sigmoidf_(acc[ai][bj][m][1][e]) * 255.0f + 0.5f)) << (8 * e);
          }
          *(u32x2*)(SG + (size_t)row * 3072 + colt + bj * 128) = w;
        }
      }
  }
};
struct EpiU {
  static constexpr bool PERM = true, AFTER_DRAIN = false;
  int mode;
  EpiP2 e0; EpiGate8 e1; EpiSwiGLU e2;
  __device__ __forceinline__ void operator()(const f32x4 (&acc)[2][2][4][2], const pg8::Unit& u, int wr, int wc, int fr, int fq) const {
    if (mode == 0) e0(acc, u, wr, wc, fr, fq);
    else if (mode == 1) e1(acc, u, wr, wc, fr, fq);
    else e2(acc, u, wr, wc, fr, fq);
  }
};
struct BranchOrder {
  int G, c;
  __device__ bool next(int i, pg8::Unit& u) const {
    const int n = i % 3, t = c + (i / 3) * G;
    if (t >= 256) return false;
    u.pm = n * 64 + 8 * (t & 7) + ((t >> 3) & 7); u.pn = n * 4 + (t >> 6);
    return true;
  }
  __device__ __forceinline__ void a_ready(const pg8::Unit&) const {}
  __device__ __forceinline__ void done(const pg8::Unit&) const {}
};
struct EpiMixAcc {
  static constexpr bool PERM = true, AFTER_DRAIN = false;
  const unsigned char* SG; bf16_t* MIX;
  __device__ __forceinline__ void operator()(const f32x4 (&acc)[2][2][4][2], const pg8::Unit& u, int wr, int wc, int fr, int fq) const {
    const int nb = u.pn >> 2, pn = u.pn & 3, pm = u.pm - nb * 64;
    const int row0 = pm * 256 + wr * 64 + fr, colt = pn * 256 + wc * 32 + 8 * fq;
#pragma unroll
    for (int ai = 0; ai < 2; ++ai)
#pragma unroll
      for (int m = 0; m < 4; ++m) {
        const int row = row0 + ai * 128 + m * 16;
#pragma unroll
        for (int bj = 0; bj < 2; ++bj) {
          const int col = colt + bj * 128;
          const u32x2 g = *(const u32x2*)(SG + (size_t)row * 3072 + nb * 1024 + col);
          const f32x4 a0 = acc[ai][bj][m][0], a1 = acc[ai][bj][m][1];
          float y[8];
#pragma unroll
          for (int e = 0; e < 4; ++e) {
            y[e] = (float)((g.x >> (8 * e)) & 255u) * (1.0f / 255.0f) * a0[e];
            y[4 + e] = (float)((g.y >> (8 * e)) & 255u) * (1.0f / 255.0f) * a1[e];
          }
          bf16_t* mp = MIX + (size_t)row * 1024 + col;
          if (nb > 0) {
            const u32x4 o = *(const u32x4*)mp;
            y[0] += bflo(o.x); y[1] += bfhi(o.x); y[2] += bflo(o.y); y[3] += bfhi(o.y);
            y[4] += bflo(o.z); y[5] += bfhi(o.z); y[6] += bflo(o.w); y[7] += bfhi(o.w);
          }
          u32x4 w;
          w.x = cvt_pk_bf16(y[0], y[1]); w.y = cvt_pk_bf16(y[2], y[3]); w.z = cvt_pk_bf16(y[4], y[5]); w.w = cvt_pk_bf16(y[6], y[7]);
          *(u32x4*)mp = w;
        }
      }
  }
};

constexpr int LSTR = 72;
constexpr int A_TILE_EL = 256 * LSTR;
constexpr int B_TILE_EL = 128 * LSTR;
constexpr int STAGE_EL = A_TILE_EL + B_TILE_EL;

template <int NI>
__device__ __forceinline__ void gemm_acc(f32x16 (&acc)[2][NI], const bf16_t* __restrict__ A, int lda, int akstride,
                                         const bf16_t* __restrict__ Bt, int ldb, int nk, bf16_t* lds) {
  const int tid = opaque_tid(), lane = tid & 63, wid = tid >> 6, wm = wid >> 1, wn = wid & 1;
  const int lr = tid >> 3, lc = (tid & 7) * 8;
  u32x4 ra[4], rb[NI];
  const bf16_t* ap = A + (size_t)lr * lda + lc;
  const bf16_t* bp = Bt + (size_t)lr * ldb + lc;
#pragma unroll
  for (int i = 0; i < 4; ++i) ra[i] = *(const u32x4*)(ap + (size_t)(64 * i) * lda);
#pragma unroll
  for (int i = 0; i < NI; ++i) rb[i] = *(const u32x4*)(bp + (size_t)(64 * i) * ldb);
  {
    bf16_t* sA = lds;
    bf16_t* sB = lds + A_TILE_EL;
#pragma unroll
    for (int i = 0; i < 4; ++i) *(u32x4*)(sA + (lr + 64 * i) * LSTR + lc) = ra[i];
#pragma unroll
    for (int i = 0; i < NI; ++i) *(u32x4*)(sB + (lr + 64 * i) * LSTR + lc) = rb[i];
  }
  __syncthreads();
  const int arow = wm * 64 + (lane & 31), brow = wn * (32 * NI) + (lane & 31), kof = (lane >> 5) * 8;
  for (int kt = 0; kt < nk; ++kt) {
    const int cur = kt & 1;
    if (kt + 1 < nk) {
      const bf16_t* ap2 = ap + (size_t)(kt + 1) * akstride;
      const bf16_t* bp2 = bp + (size_t)(kt + 1) * 64;
#pragma unroll
      for (int i = 0; i < 4; ++i) ra[i] = *(const u32x4*)(ap2 + (size_t)(64 * i) * lda);
#pragma unroll
      for (int i = 0; i < NI; ++i) rb[i] = *(const u32x4*)(bp2 + (size_t)(64 * i) * ldb);
    }
    const bf16_t* cA = lds + cur * STAGE_EL;
    const bf16_t* cB = cA + A_TILE_EL;
#pragma unroll
    for (int ks = 0; ks < 4; ++ks) {
      bf16x8 af[2], bfr[NI];
#pragma unroll
      for (int mi = 0; mi < 2; ++mi) af[mi] = *(const bf16x8*)(cA + (arow + mi * 32) * LSTR + ks * 16 + kof);
#pragma unroll
      for (int ni = 0; ni < NI; ++ni) bfr[ni] = *(const bf16x8*)(cB + (brow + ni * 32) * LSTR + ks * 16 + kof);
#pragma unroll
      for (int mi = 0; mi < 2; ++mi)
#pragma unroll
        for (int ni = 0; ni < NI; ++ni)
          acc[mi][ni] = __builtin_amdgcn_mfma_f32_32x32x16_bf16(af[mi], bfr[ni], acc[mi][ni], 0, 0, 0);
    }
    if (kt + 1 < nk) {
      bf16_t* sA = lds + (cur ^ 1) * STAGE_EL;
      bf16_t* sB = sA + A_TILE_EL;
#pragma unroll
      for (int i = 0; i < 4; ++i) *(u32x4*)(sA + (lr + 64 * i) * LSTR + lc) = ra[i];
#pragma unroll
      for (int i = 0; i < NI; ++i) *(u32x4*)(sB + (lr + 64 * i) * LSTR + lc) = rb[i];
    }
    __syncthreads();
  }
}

template <int NI>
__device__ __forceinline__ void zero_acc(f32x16 (&acc)[2][NI]) {
#pragma unroll
  for (int mi = 0; mi < 2; ++mi)
#pragma unroll
    for (int ni = 0; ni < NI; ++ni)
#pragma unroll
      for (int r = 0; r < 16; ++r) acc[mi][ni][r] = 0.f;
}

struct CvtJob { const float* src; bf16_t* dst; int K, ld, nvalid, mode, tn, tk; };
constexpr int CVT_TILES = 2216;
__device__ __forceinline__ CvtJob cvt_decode(const Params& p, int l, bf16_t* WB, int tile) {
  CvtJob j;
  j.mode = 0;
  int tl = tile;
  if (tl < 800) { j.src = p.w_in + (size_t)l * 1024 * DIN; j.dst = WB + WB_WIN; j.K = 1024; j.ld = DIN; j.nvalid = DIN; }
  else if ((tl -= 800) < 24) { j.src = p.w_uq + (size_t)l * 256 * 768; j.dst = WB + WB_WUQ; j.K = 256; j.ld = 768; j.nvalid = 768; }
  else if ((tl -= 24) < 16) { j.src = p.w_ukv + (size_t)l * 128 * 1024; j.dst = WB + WB_WUKV; j.K = 128; j.ld = 1024; j.nvalid = 1024; }
  else if ((tl -= 16) < 192) { const int n = tl >> 6; tl &= 63; j.src = p.w_branch + (size_t)(l * 3 + n) * 512 * 1024; j.dst = WB + WB_WBR + (size_t)n * 1024 * 512; j.K = 512; j.ld = 1024; j.nvalid = 1024; }
  else if ((tl -= 192) < 128) { j.src = p.w_out + (size_t)l * 1024 * 1024; j.dst = WB + WB_WOUT; j.K = 1024; j.ld = 1024; j.nvalid = 1024; }
  else if ((tl -= 128) < 704) { j.src = p.w_ffn_in + (size_t)l * 1024 * 5632; j.dst = WB + WB_WFI; j.K = 1024; j.ld = 5632; j.nvalid = 5632; j.mode = 1; }
  else { tl -= 704; j.src = p.w_ffn_out + (size_t)l * DFF * 1024; j.dst = WB + WB_WFO; j.K = DFF; j.ld = 1024; j.nvalid = 1024; }
  const int nkt = j.K >> 7;
  j.tn = tl / nkt; j.tk = tl - j.tn * nkt;
  return j;
}
__device__ __forceinline__ void cvt_load(const CvtJob& j, int tid, f32x4 (&v)[4]) {
  const int kk = tid >> 4, n4 = (tid & 15) * 4, np = j.tn * 64 + n4;
  int nsrc = np;
  if (j.mode == 1) { const int g = np >> 8, r = np & 255; nsrc = (r < 128 ? 0 : DFF) + 128 * g + (r & 127); }
#pragma unroll
  for (int i = 0; i < 4; ++i) v[i] = (f32x4){0.f, 0.f, 0.f, 0.f};
  if (np < j.nvalid) {
#pragma unroll
    for (int i = 0; i < 4; ++i) v[i] = *(const f32x4*)(j.src + (size_t)(j.tk * 128 + kk + 32 * i) * j.ld + nsrc);
  }
}
__device__ void cvt_layer(const Params& p, int l, bf16_t* WB, bf16_t* lds) {
  const int tid = opaque_tid();
  const int kk = tid >> 4, n4 = (tid & 15) * 4, nl = tid >> 3, kc = (tid & 7) * 8;
  float* Tbase = (float*)lds;
  int tile = opaque_bid(), buf = 0;
  f32x4 v[4];
  if (tile < CVT_TILES) { const CvtJob j = cvt_decode(p, l, WB, tile); cvt_load(j, tid, v); }
  while (tile < CVT_TILES) {
    float* T = Tbase + buf * (128 * 65);
#pragma unroll
    for (int i = 0; i < 4; ++i) {
      float* tp = T + (kk + 32 * i) * 65 + n4;
      tp[0] = v[i][0]; tp[1] = v[i][1]; tp[2] = v[i][2]; tp[3] = v[i][3];
    }
    const CvtJob jc = cvt_decode(p, l, WB, tile);
    const int next = tile + opaque_gdim();
    if (next < CVT_TILES) { const CvtJob jn = cvt_decode(p, l, WB, next); cvt_load(jn, tid, v); }
    lds_barrier();
#pragma unroll
    for (int hlf = 0; hlf < 2; ++hlf) {
      const int k0 = hlf * 64 + kc;
      u32x4 w;
      w.x = cvt_pk_bf16(T[(k0 + 0) * 65 + nl], T[(k0 + 1) * 65 + nl]);
      w.y = cvt_pk_bf16(T[(k0 + 2) * 65 + nl], T[(k0 + 3) * 65 + nl]);
      w.z = cvt_pk_bf16(T[(k0 + 4) * 65 + nl], T[(k0 + 5) * 65 + nl]);
      w.w = cvt_pk_bf16(T[(k0 + 6) * 65 + nl], T[(k0 + 7) * 65 + nl]);
      *(u32x4*)(jc.dst + (size_t)(jc.tn * 64 + nl) * jc.K + jc.tk * 128 + k0) = w;
    }
    buf ^= 1;
    tile = next;
  }
  __syncthreads();
}

__device__ void mod_phase(const Params& p, float* MOD, float* S) {
  const int tid = opaque_tid();
  float* R = S + 5120;
  for (int i = tid; i < 5120; i += 512) {
    const int j = i >> 10, k = i & 1023;
    const float c = (j == 0) ? p.c_ctx[k] : p.c[(j - 1) * 1024 + k];
    S[i] = c / (1.0f + __expf(-c));
  }
  __syncthreads();
  for (int item = opaque_bid(); item < 768; item += opaque_gdim()) {
    const int l = item / 384, cgp = item - l * 384, c16 = tid & 15, ks = tid >> 4;
    const float* w = p.w_mod + (size_t)l * 1024 * 6144 + cgp * 16 + c16;
    float a0 = 0.f, a1 = 0.f, a2 = 0.f, a3 = 0.f, a4 = 0.f;
#pragma unroll 8
    for (int kk2 = 0; kk2 < 32; ++kk2) {
      const int k = ks * 32 + kk2;
      const float wv = w[(size_t)k * 6144];
      a0 += S[k] * wv; a1 += S[1024 + k] * wv; a2 += S[2048 + k] * wv; a3 += S[3072 + k] * wv; a4 += S[4096 + k] * wv;
    }
    R[(ks * 5 + 0) * 16 + c16] = a0; R[(ks * 5 + 1) * 16 + c16] = a1; R[(ks * 5 + 2) * 16 + c16] = a2;
    R[(ks * 5 + 3) * 16 + c16] = a3; R[(ks * 5 + 4) * 16 + c16] = a4;
    __syncthreads();
    if (tid < 80) {
      const int j = tid >> 4, c = tid & 15;
      float s = 0.f;
      for (int q = 0; q < 32; ++q) s += R[(q * 5 + j) * 16 + c];
      MOD[(size_t)(l * 5 + j) * 6144 + cgp * 16 + c] = s + p.b_mod[l * 6144 + cgp * 16 + c];
    }
    __syncthreads();
  }
}

__device__ void normmod_rows(const Params& p, bool from_input, const float* g, const float* MODl, int sh_off, int sc_off, bf16_t* H) {
  const int tid_ = opaque_tid(), lane = tid_ & 63, wid = tid_ >> 6;
  const int stride = opaque_gdim() * 8;
  for (int row0 = opaque_bid() * 8 + wid; row0 < NTOK; row0 += stride * 4) {
    f32x4 v[4][4];
    float ss[4];
#pragma unroll
    for (int k = 0; k < 4; ++k) {
      const int row = row0 + k * stride;
      ss[k] = 0.f;
      if (row < NTOK) {
        const float* x = from_input ? (row < NCTX ? p.x_prompt + (size_t)row * 1024 : p.x_sample + (size_t)(row - NCTX) * 1024)
                                    : p.out + (size_t)row * 1024;
#pragma unroll
        for (int i = 0; i < 4; ++i) {
          v[k][i] = *(const f32x4*)(x + i * 256 + lane * 4);
          ss[k] += v[k][i][0] * v[k][i][0] + v[k][i][1] * v[k][i][1] + v[k][i][2] * v[k][i][2] + v[k][i][3] * v[k][i][3];
        }
      }
    }
#pragma unroll
    for (int d = 1; d < 64; d <<= 1) {
#pragma unroll
      for (int k = 0; k < 4; ++k) ss[k] += __shfl_xor(ss[k], d);
    }
#pragma unroll
    for (int k = 0; k < 4; ++k) {
      const int row = row0 + k * stride;
      if (row < NTOK) {
        const float* md = MODl + mod_index(row) * 6144;
        const float rstd = rsqrtf(ss[k] * (1.0f / 1024.0f) + EPS);
#pragma unroll
        for (int i = 0; i < 4; ++i) {
          const int c = i * 256 + lane * 4;
          const f32x4 g4 = *(const f32x4*)(g + c), sc = *(const f32x4*)(md + sc_off + c), sh = *(const f32x4*)(md + sh_off + c);
          float y[4];
#pragma unroll
          for (int e = 0; e < 4; ++e) y[e] = v[k][i][e] * rstd * g4[e] * (1.0f + sc[e]) + sh[e];
          u32x2 w;
          w.x = cvt_pk_bf16(y[0], y[1]);
          w.y = cvt_pk_bf16(y[2], y[3]);
          *(u32x2*)(H + (size_t)row * 1024 + c) = w;
        }
      }
    }
  }
}

__device__ __forceinline__ void rope_cs(int t, int pidx, int nfreq, float& c, float& s) {
  const int fi = pidx < nfreq ? pidx : pidx - nfreq;
  const float pos = pidx < nfreq ? (float)(t >> 6) : (float)(t & 63);
  const float freq = exp2f(-(float)fi / (float)nfreq * 13.287712379549449f);
  const float ang = pos * freq;
  sincosf(ang, &s, &c);
}

__device__ void rope_tables(f32x2* TG, f32x2* TA) {
  for (int i = opaque_bid() * 512 + opaque_tid(); i < 2048 * 48; i += opaque_gdim() * 512) {
    const int t = i / 48, j = i - t * 48;
    float c, s;
    if (j < 32) { rope_cs(t, j, 16, c, s); TG[t * 32 + j] = (f32x2){c, s}; }
    else { rope_cs(t, j - 32, 8, c, s); TA[t * 16 + (j - 32)] = (f32x2){c, s}; }
  }
}
__device__ __forceinline__ float sum8(float v) { v += __shfl_xor(v, 1); v += __shfl_xor(v, 2); v += __shfl_xor(v, 4); return v; }

__device__ void post_small(const Params& p, int l, const bf16_t* PS, bf16_t* QL, bf16_t* CKV, bf16_t* KR, bf16_t* GQ, bf16_t* GK, bf16_t* GV, const f32x2* TG) {
  const int tid_ = opaque_tid(), lane = tid_ & 63, wid = tid_ >> 6;
  const int head = lane >> 3, j8 = lane & 7;
  const float gq_scale = 0.125f * 1.4426950408889634f;
  const f32x4 gqa = *(const f32x4*)(p.g_qnorm_g + l * 64 + 4 * j8), gqb = *(const f32x4*)(p.g_qnorm_g + l * 64 + 32 + 4 * j8);
  const f32x4 gka = *(const f32x4*)(p.g_knorm_g + l * 64 + 4 * j8), gkb = *(const f32x4*)(p.g_knorm_g + l * 64 + 32 + 4 * j8);
  const f32x4 gql = *(const f32x4*)(p.a_qlora_g + l * 256 + lane * 4);
  const f32x2 gkv = *(const f32x2*)(p.a_kvlora_g + l * 128 + lane * 2);
  for (int row = opaque_bid() * 8 + wid; row < NKV; row += opaque_gdim() * 8) {
    if (row < NTOK) {
      const bf16_t* ps = PS + (size_t)row * 1216;
      const bool ctx = row < NCTX;
      const int b = ctx ? (row >> 8) : ((row - NCTX) >> 11);
      const int t = ctx ? (row & 255) : ((row - NCTX) & 2047);
      const size_t obase = (size_t)((b * 2 + l) * 256 + t);
      const u32x2 wq = *(const u32x2*)(ps + 16 + lane * 4);
      const unsigned wkv = *(const unsigned*)(ps + 272 + lane * 2);
      const u32x2 g1 = *(const u32x2*)(ps + 432 + head * 64 + 4 * j8), g2 = *(const u32x2*)(ps + 432 + head * 64 + 32 + 4 * j8);
      const int khead = (lane >> 3) & 1;
      const u32x2 k1 = *(const u32x2*)(ps + 944 + khead * 64 + 4 * j8), k2 = *(const u32x2*)(ps + 944 + khead * 64 + 32 + 4 * j8);
      f32x4 c4 = {1.f, 1.f, 1.f, 1.f}, s4 = {0.f, 0.f, 0.f, 0.f}, c4b = c4, s4b = s4;
      if (!ctx) {
        const f32x4 r0 = *(const f32x4*)(TG + t * 32 + 4 * j8), r1 = *(const f32x4*)(TG + t * 32 + 4 * j8 + 2);
        c4 = (f32x4){r0[0], r0[2], r1[0], r1[2]}; s4 = (f32x4){r0[1], r0[3], r1[1], r1[3]};
      }
      (void)c4b; (void)s4b;
      float q0 = bflo(wq.x), q1 = bfhi(wq.x), q2 = bflo(wq.y), q3 = bfhi(wq.y);
      float v0 = bflo(wkv), v1 = bfhi(wkv);
      float ssq = q0 * q0 + q1 * q1 + q2 * q2 + q3 * q3, sskv = v0 * v0 + v1 * v1;
#pragma unroll
      for (int d = 1; d < 64; d <<= 1) { ssq += __shfl_xor(ssq, d); sskv += __shfl_xor(sskv, d); }
      {
        const float rstd = rsqrtf(ssq * (1.0f / 256.0f) + EPS);
        u32x2 o;
        o.x = cvt_pk_bf16(q0 * rstd * gql[0], q1 * rstd * gql[1]);
        o.y = cvt_pk_bf16(q2 * rstd * gql[2], q3 * rstd * gql[3]);
        *(u32x2*)(QL + (size_t)row * 256 + lane * 4) = o;
      }
      {
        const float rstd = rsqrtf(sskv * (1.0f / 128.0f) + EPS);
        v0 = v0 * rstd * gkv[0]; v1 = v1 * rstd * gkv[1];
        *(unsigned*)(CKV + (size_t)row * 128 + lane * 2) = cvt_pk_bf16(v0, v1);
        if (ctx) { f32x2 o = {v0, v1}; *(f32x2*)(p.out + O_CKV + obase * 128 + lane * 2) = o; }
      }
      {
        float x1[4] = {bflo(g1.x), bfhi(g1.x), bflo(g1.y), bfhi(g1.y)}, x2[4] = {bflo(g2.x), bfhi(g2.x), bflo(g2.y), bfhi(g2.y)};
        float ss = 0.f;
#pragma unroll
        for (int e = 0; e < 4; ++e) ss += x1[e] * x1[e] + x2[e] * x2[e];
        ss = sum8(ss);
        const float rstd = rsqrtf(ss * (1.0f / 64.0f) + EPS) ;
        float y1[4], y2[4];
#pragma unroll
        for (int e = 0; e < 4; ++e) {
          const float a1 = x1[e] * rstd * gqa[e], a2 = x2[e] * rstd * gqb[e];
          y1[e] = (a1 * c4[e] - a2 * s4[e]) * gq_scale;
          y2[e] = (a1 * s4[e] + a2 * c4[e]) * gq_scale;
        }
        u32x2 o1, o2;
        o1.x = cvt_pk_bf16(y1[0], y1[1]); o1.y = cvt_pk_bf16(y1[2], y1[3]);
        o2.x = cvt_pk_bf16(y2[0], y2[1]); o2.y = cvt_pk_bf16(y2[2], y2[3]);
        *(u32x2*)(GQ + (size_t)row * 512 + head * 64 + 4 * j8) = o1;
        *(u32x2*)(GQ + (size_t)row * 512 + head * 64 + 32 + 4 * j8) = o2;
      }
      {
        float x1[4] = {bflo(k1.x), bfhi(k1.x), bflo(k1.y), bfhi(k1.y)}, x2[4] = {bflo(k2.x), bfhi(k2.x), bflo(k2.y), bfhi(k2.y)};
        float ss = 0.f;
#pragma unroll
        for (int e = 0; e < 4; ++e) ss += x1[e] * x1[e] + x2[e] * x2[e];
        ss = sum8(ss);
        const float rstd = rsqrtf(ss * (1.0f / 64.0f) + EPS);
        float y1[4], y2[4];
#pragma unroll
        for (int e = 0; e < 4; ++e) {
          const float a1 = x1[e] * rstd * gka[e], a2 = x2[e] * rstd * gkb[e];
          y1[e] = a1 * c4[e] - a2 * s4[e];
          y2[e] = a1 * s4[e] + a2 * c4[e];
        }
        if (lane < 16) {
          if (ctx) {
            *(f32x4*)(p.out + O_GK + obase * 128 + khead * 64 + 4 * j8) = (f32x4){y1[0], y1[1], y1[2], y1[3]};
            *(f32x4*)(p.out + O_GK + obase * 128 + khead * 64 + 32 + 4 * j8) = (f32x4){y2[0], y2[1], y2[2], y2[3]};
          }
          u32x2 o1, o2;
          o1.x = cvt_pk_bf16(y1[0], y1[1]); o1.y = cvt_pk_bf16(y1[2], y1[3]);
          o2.x = cvt_pk_bf16(y2[0], y2[1]); o2.y = cvt_pk_bf16(y2[2], y2[3]);
          *(u32x2*)(GK + (size_t)row * 128 + khead * 64 + 4 * j8) = o1;
          *(u32x2*)(GK + (size_t)row * 128 + khead * 64 + 32 + 4 * j8) = o2;
        }
      }
      if (lane >= 32) {
        const int e0 = (lane - 32) * 4;
        const u32x2 w = *(const u32x2*)(ps + 1072 + e0);
        *(u32x2*)(GV + (size_t)row * 128 + e0) = w;
        if (ctx) *(f32x4*)(p.out + O_GV + obase * 128 + e0) = (f32x4){bflo(w.x), bfhi(w.x), bflo(w.y), bfhi(w.y)};
      } else if (lane >= 16 && lane < 24) {
        const int e0 = (lane - 16) * 4;
        const u32x2 w = *(const u32x2*)(ps + 400 + e0);
        *(u32x2*)(KR + (size_t)row * 32 + e0) = w;
        if (ctx) *(f32x4*)(p.out + O_KR + obase * 32 + e0) = (f32x4){bflo(w.x), bfhi(w.x), bflo(w.y), bfhi(w.y)};
      }
    } else {
      const int r = row - NTOK, b = r >> 8, s = r & 255;
      const size_t cb = (size_t)((b * 2 + l) * 256 + s);
      {
        const f32x2 v = *(const f32x2*)(p.c_ckv + cb * 128 + lane * 2);
        *(unsigned*)(CKV + (size_t)row * 128 + lane * 2) = cvt_pk_bf16(v[0], v[1]);
      }
      if (lane < 32) KR[(size_t)row * 32 + lane] = f2bf(p.c_kr[cb * 32 + lane]);
      {
        const f32x2 v = *(const f32x2*)(p.c_gk + cb * 128 + lane * 2);
        *(unsigned*)(GK + (size_t)row * 128 + lane * 2) = cvt_pk_bf16(v[0], v[1]);
      }
      {
        const f32x2 v = *(const f32x2*)(p.c_gv + cb * 128 + lane * 2);
        *(unsigned*)(GV + (size_t)row * 128 + lane * 2) = cvt_pk_bf16(v[0], v[1]);
      }
    }
  }
}

__device__ __forceinline__ void mla_head_vec(bf16_t* np, bf16_t* rp_out, const u32x2 rw, const f32x4 ga, const f32x4 gb, const f32x4 gr,
                                             bool lat, int j8, const f32x4 c4, const f32x4 s4, float oscale) {
  const u32x4 nw = *(const u32x4*)np;
  float x[8] = {bflo(nw.x), bfhi(nw.x), bflo(nw.y), bfhi(nw.y), bflo(nw.z), bfhi(nw.z), bflo(nw.w), bfhi(nw.w)};
  float rr[4] = {bflo(rw.x), bfhi(rw.x), bflo(rw.y), bfhi(rw.y)};
  float ss = 0.f;
#pragma unroll
  for (int e = 0; e < 8; ++e) ss += x[e] * x[e];
#pragma unroll
  for (int e = 0; e < 4; ++e) ss += rr[e] * rr[e];
  ss = sum8(ss);
  const float rstd = rsqrtf(ss * (1.0f / 96.0f) + EPS);
#pragma unroll
  for (int e = 0; e < 4; ++e) { x[e] *= rstd * ga[e] * oscale; x[4 + e] *= rstd * gb[e] * oscale; rr[e] *= rstd * gr[e]; }
  float ro[4];
#pragma unroll
  for (int e = 0; e < 4; ++e) {
    const float other = __shfl_xor(rr[e], 4);
    ro[e] = rr[e];
    if (lat) ro[e] = (j8 < 4) ? (rr[e] * c4[e] - other * s4[e]) : (other * s4[e] + rr[e] * c4[e]);
    ro[e] *= oscale;
  }
  u32x4 ow;
  ow.x = cvt_pk_bf16(x[0], x[1]); ow.y = cvt_pk_bf16(x[2], x[3]); ow.z = cvt_pk_bf16(x[4], x[5]); ow.w = cvt_pk_bf16(x[6], x[7]);
  *(u32x4*)np = ow;
  u32x2 orw;
  orw.x = cvt_pk_bf16(ro[0], ro[1]); orw.y = cvt_pk_bf16(ro[2], ro[3]);
  *(u32x2*)rp_out = orw;
}
__device__ void post_mla(const Params& p, int l, bf16_t* QA, bf16_t* KAV, const bf16_t* KR, const f32x2* TA) {
  const int tid_ = opaque_tid(), lane = tid_ & 63, wid = tid_ >> 6;
  const int head = lane >> 3, j8 = lane & 7;
  const float q_scale = 0.10206207261596577f * 1.4426950408889634f;
  const f32x4 gka = *(const f32x4*)(p.a_knorm_g + l * 96 + 8 * j8), gkb = *(const f32x4*)(p.a_knorm_g + l * 96 + 8 * j8 + 4), gkr = *(const f32x4*)(p.a_knorm_g + l * 96 + 64 + 4 * j8);
  const f32x4 gqa = *(const f32x4*)(p.a_qnorm_g + l * 96 + 8 * j8), gqb = *(const f32x4*)(p.a_qnorm_g + l * 96 + 8 * j8 + 4), gqr = *(const f32x4*)(p.a_qnorm_g + l * 96 + 64 + 4 * j8);
  for (int row = opaque_bid() * 8 + wid; row < NKV; row += opaque_gdim() * 8) {
    const bool lat = (row >= NCTX) && (row < NTOK);
    const int t = (row - NCTX) & 2047;
    f32x4 c4 = {1.f, 1.f, 1.f, 1.f}, s4 = {0.f, 0.f, 0.f, 0.f};
    if (lat) {
      const f32x4 r0 = *(const f32x4*)(TA + t * 16 + 4 * (j8 & 3)), r1 = *(const f32x4*)(TA + t * 16 + 4 * (j8 & 3) + 2);
      c4 = (f32x4){r0[0], r0[2], r1[0], r1[2]}; s4 = (f32x4){r0[1], r0[3], r1[1], r1[3]};
    }
    {
      bf16_t* kp = KAV + (size_t)row * 1280 + head * 160;
      const u32x2 rw = *(const u32x2*)(KR + (size_t)row * 32 + 4 * j8);
      mla_head_vec(kp + 8 * j8, kp + 64 + 4 * j8, rw, gka, gkb, gkr, lat, j8, c4, s4, 1.0f);
    }
    if (row < NTOK) {
      bf16_t* qp = QA + (size_t)row * 768 + head * 96;
      const u32x2 rw = *(const u32x2*)(qp + 64 + 4 * j8);
      mla_head_vec(qp + 8 * j8, qp + 64 + 4 * j8, rw, gqa, gqb, gqr, lat, j8, c4, s4, q_scale);
    }
  }
}

__device__ void post_mlstm(const Params& p, int l, bf16_t* HF, const bf16_t* HB, const bf16_t* PM) {
  const int tid_ = opaque_tid(), lane = tid_ & 63, wid = tid_ >> 6;
  const int head = lane >> 4, j16 = lane & 15;
  const f32x4 ga = *(const f32x4*)(p.m_norm_g + l * 128 + 8 * j16), gb = *(const f32x4*)(p.m_norm_g + l * 128 + 8 * j16 + 4);
  for (int row = opaque_bid() * 8 + wid; row < NTOK; row += opaque_gdim() * 8) {
    const u32x4 wf = *(const u32x4*)(HF + (size_t)row * 512 + head * 128 + 8 * j16);
    const u32x4 wb = *(const u32x4*)(HB + (size_t)row * 512 + head * 128 + 8 * j16);
    const u32x4 wo = *(const u32x4*)(PM + (size_t)row * 2048 + 1536 + head * 128 + 8 * j16);
    float v[8] = {bflo(wf.x) + bflo(wb.x), bfhi(wf.x) + bfhi(wb.x), bflo(wf.y) + bflo(wb.y), bfhi(wf.y) + bfhi(wb.y),
                  bflo(wf.z) + bflo(wb.z), bfhi(wf.z) + bfhi(wb.z), bflo(wf.w) + bflo(wb.w), bfhi(wf.w) + bfhi(wb.w)};
    const float mo[8] = {bflo(wo.x), bfhi(wo.x), bflo(wo.y), bfhi(wo.y), bflo(wo.z), bfhi(wo.z), bflo(wo.w), bfhi(wo.w)};
    float ss = 0.f;
#pragma unroll
    for (int e = 0; e < 8; ++e) ss += v[e] * v[e];
    ss = sum8(ss);
    ss += __shfl_xor(ss, 8);
    const float rstd = rsqrtf(ss * (1.0f / 128.0f) + EPS);
#pragma unroll
    for (int e = 0; e < 4; ++e) { v[e] = v[e] * rstd * ga[e] * sigmoidf_(mo[e]); v[4 + e] = v[4 + e] * rstd * gb[e] * sigmoidf_(mo[4 + e]); }
    u32x4 o;
    o.x = cvt_pk_bf16(v[0], v[1]); o.y = cvt_pk_bf16(v[2], v[3]); o.z = cvt_pk_bf16(v[4], v[5]); o.w = cvt_pk_bf16(v[6], v[7]);
    *(u32x4*)(HF + (size_t)row * 512 + head * 128 + 8 * j16) = o;
  }
}

template <int DQK>
__device__ __forceinline__ void attn_item(const bf16_t* qptr, bf16_t* optr, const bf16_t* Kb, int kstride, const bf16_t* Vb, int vstride,
                                          int seg0_row, int seg0_tiles, int seg1_row, int ntiles, bf16_t* lds, bool nostore = false) {
  constexpr int KSTR = DQK + 8, KT_EL = 64 * KSTR, VT_EL = 64 * 72, NKK = DQK / 16, KCH = DQK / 8;
  const int tid = opaque_tid(), lane = tid & 63, h2 = lane >> 5, r = lane & 31;
  bf16_t* const sKb = lds;
  bf16_t* const sVb = lds + 2 * KT_EL;
  bf16x8 qf[NKK];
#pragma unroll
  for (int kk = 0; kk < NKK; ++kk) qf[kk] = *(const bf16x8*)(qptr + kk * 16 + h2 * 8);
  f32x16 o0, o1;
#pragma unroll
  for (int i = 0; i < 16; ++i) { o0[i] = 0.f; o1[i] = 0.f; }
  float m_run = -1e30f, l_run = 0.f;
  const int key0 = tid / KCH, c0 = tid - key0 * KCH;
  const int id1 = tid + 512, key1 = id1 / KCH, c1 = id1 - key1 * KCH;
  const bool has1 = (DQK == 96) && (tid < 256);
  const int vkey = tid & 63, vc = tid >> 6;
  const int vpos = (vkey & ~12) | ((vkey & 4) << 1) | ((vkey & 8) >> 1);
  u32x4 kr0, kr1 = {0u, 0u, 0u, 0u}, vr;
#define ATTN_ROW0(j) (((j) < seg0_tiles) ? seg0_row + (j) * 64 : seg1_row + ((j) - seg0_tiles) * 64)
#define ATTN_LOADK(j)                                                                        \
  {                                                                                          \
    const int row0_ = ATTN_ROW0(j);                                                          \
    kr0 = *(const u32x4*)(Kb + (size_t)(row0_ + key0) * kstride + c0 * 8);                   \
    if (has1) kr1 = *(const u32x4*)(Kb + (size_t)(row0_ + key1) * kstride + c1 * 8);        \
  }
#define ATTN_LOADV(j) { const int row0_ = ATTN_ROW0(j); vr = *(const u32x4*)(Vb + (size_t)(row0_ + vkey) * vstride + vc * 8); }
#define ATTN_STOREK(buf)                                                                     \
  {                                                                                          \
    bf16_t* sK_ = sKb + (buf) * KT_EL;                                                       \
    *(u32x4*)(sK_ + key0 * KSTR + c0 * 8) = kr0;                                             \
    if (has1) *(u32x4*)(sK_ + key1 * KSTR + c1 * 8) = kr1;                                   \
  }
#define ATTN_STOREV(buf)                                                                     \
  {                                                                                          \
    bf16_t* sV_ = sVb + (buf) * VT_EL;                                                       \
    sV_[(vc * 8 + 0) * 72 + vpos] = (bf16_t)(vr.x & 0xffffu);                                \
    sV_[(vc * 8 + 1) * 72 + vpos] = (bf16_t)(vr.x >> 16);                                    \
    sV_[(vc * 8 + 2) * 72 + vpos] = (bf16_t)(vr.y & 0xffffu);                                \
    sV_[(vc * 8 + 3) * 72 + vpos] = (bf16_t)(vr.y >> 16);                                    \
    sV_[(vc * 8 + 4) * 72 + vpos] = (bf16_t)(vr.z & 0xffffu);                                \
    sV_[(vc * 8 + 5) * 72 + vpos] = (bf16_t)(vr.z >> 16);                                    \
    sV_[(vc * 8 + 6) * 72 + vpos] = (bf16_t)(vr.w & 0xffffu);                                \
    sV_[(vc * 8 + 7) * 72 + vpos] = (bf16_t)(vr.w >> 16);                                    \
  }
#define ATTN_QK(dst0, dst1, buf)                                                             \
  {                                                                                          \
    const bf16_t* sK_ = sKb + (buf) * KT_EL;                                                 \
    _Pragma("unroll") for (int i = 0; i < 16; ++i) { dst0[i] = 0.f; dst1[i] = 0.f; }         \
    __builtin_amdgcn_s_setprio(1);                                                           \
    bf16x8 ka0_[NKK], ka1_[NKK];     \
    _Pragma("unroll") for (int kk = 0; kk < NKK; ++kk) {                                     \
      ka0_[kk] = *(const bf16x8*)(sK_ + r * KSTR + kk * 16 + h2 * 8);                        \
      ka1_[kk] = *(const bf16x8*)(sK_ + (32 + r) * KSTR + kk * 16 + h2 * 8);                 \
    }                                                                                        \
    __builtin_amdgcn_sched_barrier(0);         \
    _Pragma("unroll") for (int kk = 0; kk < NKK; ++kk) {                                     \
      dst0 = __builtin_amdgcn_mfma_f32_32x32x16_bf16(ka0_[kk], qf[kk], dst0, 0, 0, 0);       \
      dst1 = __builtin_amdgcn_mfma_f32_32x32x16_bf16(ka1_[kk], qf[kk], dst1, 0, 0, 0);       \
    }                                                                                        \
    __builtin_amdgcn_s_setprio(0);                                                           \
  }
  ATTN_LOADK(0); ATTN_LOADV(0);
  ATTN_STOREK(0); ATTN_STOREV(0);
  ATTN_LOADK(1);
  ATTN_STOREK(1);
  lds_barrier();
  f32x16 s0, s1;
  ATTN_QK(s0, s1, 0);
  lds_barrier();
  for (int j = 0; j < ntiles; ++j) {
    const int cur = j & 1;
    if (j + 1 < ntiles) ATTN_LOADV(j + 1);
    if (j + 2 < ntiles) ATTN_LOADK(j + 2);
    f32x16 n0, n1;
    if (j + 1 < ntiles) { ATTN_QK(n0, n1, cur ^ 1); }
    else {
#pragma unroll
      for (int i = 0; i < 16; ++i) { n0[i] = 0.f; n1[i] = 0.f; }
    }
    const bf16_t* sV = sVb + cur * VT_EL;
    {
      float mx = fmaxf(s0[0], s1[0]);
#pragma unroll
      for (int i = 1; i < 16; ++i) mx = fmaxf(mx, fmaxf(s0[i], s1[i]));
      mx = cross_half_max(mx);
      if (__any(mx > m_run + 11.5f)) {
        const float m_new = fmaxf(m_run, mx);
        const float alpha = __builtin_amdgcn_exp2f(m_run - m_new);
        l_run *= alpha;
#pragma unroll
        for (int i = 0; i < 16; ++i) { o0[i] *= alpha; o1[i] *= alpha; }
        m_run = m_new;
      }
      float ls = 0.f;
#pragma unroll
      for (int i = 0; i < 16; ++i) {
        s0[i] = __builtin_amdgcn_exp2f(s0[i] - m_run);
        s1[i] = __builtin_amdgcn_exp2f(s1[i] - m_run);
        ls += s0[i] + s1[i];
      }
      l_run += ls;
      u32x4 pa, pb, pc, pd;
      pa.x = cvt_pk_bf16(s0[0], s0[1]); pa.y = cvt_pk_bf16(s0[2], s0[3]); pa.z = cvt_pk_bf16(s0[4], s0[5]); pa.w = cvt_pk_bf16(s0[6], s0[7]);
      pb.x = cvt_pk_bf16(s0[8], s0[9]); pb.y = cvt_pk_bf16(s0[10], s0[11]); pb.z = cvt_pk_bf16(s0[12], s0[13]); pb.w = cvt_pk_bf16(s0[14], s0[15]);
      pc.x = cvt_pk_bf16(s1[0], s1[1]); pc.y = cvt_pk_bf16(s1[2], s1[3]); pc.z = cvt_pk_bf16(s1[4], s1[5]); pc.w = cvt_pk_bf16(s1[6], s1[7]);
      pd.x = cvt_pk_bf16(s1[8], s1[9]); pd.y = cvt_pk_bf16(s1[10], s1[11]); pd.z = cvt_pk_bf16(s1[12], s1[13]); pd.w = cvt_pk_bf16(s1[14], s1[15]);
      const bf16x8 pf[4] = {__builtin_bit_cast(bf16x8, pa), __builtin_bit_cast(bf16x8, pb), __builtin_bit_cast(bf16x8, pc), __builtin_bit_cast(bf16x8, pd)};
      bf16x8 vf0[4], vf1[4];
#pragma unroll
      for (int q = 0; q < 4; ++q) {
        vf0[q] = *(const bf16x8*)(sV + r * 72 + q * 16 + h2 * 8);
        vf1[q] = *(const bf16x8*)(sV + (32 + r) * 72 + q * 16 + h2 * 8);
      }
      __builtin_amdgcn_sched_barrier(0);
#pragma unroll
      for (int q = 0; q < 4; ++q) {
        o0 = __builtin_amdgcn_mfma_f32_32x32x16_bf16(vf0[q], pf[q], o0, 0, 0, 0);
        o1 = __builtin_amdgcn_mfma_f32_32x32x16_bf16(vf1[q], pf[q], o1, 0, 0, 0);
      }
    }
    if (j + 1 < ntiles) ATTN_STOREV(cur ^ 1);
    if (j + 2 < ntiles) ATTN_STOREK(cur);
    lds_barrier();
    s0 = n0; s1 = n1;
  }
#undef ATTN_ROW0
#undef ATTN_LOADK
#undef ATTN_LOADV
#undef ATTN_STOREK
#undef ATTN_STOREV
#undef ATTN_QK
  const float l_tot = l_run + __shfl_xor(l_run, 32);
  const float inv = 1.0f / l_tot;
  if (nostore && inv != 12345.f) return;
#pragma unroll
  for (int g = 0; g < 4; ++g) {
    u32x2 w0, w1;
    w0.x = cvt_pk_bf16(o0[4 * g] * inv, o0[4 * g + 1] * inv);
    w0.y = cvt_pk_bf16(o0[4 * g + 2] * inv, o0[4 * g + 3] * inv);
    w1.x = cvt_pk_bf16(o1[4 * g] * inv, o1[4 * g + 1] * inv);
    w1.y = cvt_pk_bf16(o1[4 * g + 2] * inv, o1[4 * g + 3] * inv);
    *(u32x2*)(optr + 8 * g + 4 * h2) = w0;
    *(u32x2*)(optr + 32 + 8 * g + 4 * h2) = w1;
  }
}

__device__ void mlstm_chain(const Params& p, int l, bool lat, int b, int h, int dir, const bf16_t* PM, const float* G, bf16_t* Hout, bf16_t* lds) {
  const int tid = opaque_tid(), lane = tid & 63, wid = tid >> 6, h2 = lane >> 5, r = lane & 31;
  const int T = lat ? 2048 : 256, base_row = lat ? NCTX + b * 2048 : b * 256, nc = T >> 6;
  const float kscale = 0.08838834764831845f;
  bf16_t* Qs = lds;
  bf16_t* Ks = Qs + 64 * 136;
  bf16_t* KwT = Ks + 64 * 136;
  bf16_t* VT = KwT + 128 * 72;
  bf16_t* CT = VT + 128 * 72;
  bf16_t* Ss = CT + 128 * 136;
  float* F = (float*)(Ss + 64 * 72);
  float* qnv = F + 768; float* hdv = F + 832; float* nvec = F + 896;
  const int dkt = wid >> 1, dvt0 = (wid & 1) * 2;
  const int lt = wid >> 2, dvt = wid & 3;
  f32x16 accC[2];
  float m_state = 0.f;
  const size_t sidx = (size_t)(((b * 2 + l) * 2 + dir) * 4 + h);
  if (lat) {
#pragma unroll
    for (int i = 0; i < 2; ++i)
#pragma unroll
      for (int rg = 0; rg < 16; ++rg)
        accC[i][rg] = p.st_C[sidx * 16384 + (size_t)(dkt * 32 + rowof(rg, h2)) * 128 + (dvt0 + i) * 32 + r];
    asm volatile("" ::: "memory");
    if (tid < 128) nvec[tid] = p.st_n[sidx * 128 + tid];
    m_state = p.st_m[sidx];
  } else {
#pragma unroll
    for (int i = 0; i < 2; ++i)
#pragma unroll
      for (int rg = 0; rg < 16; ++rg) accC[i][rg] = 0.f;
    if (tid < 128) nvec[tid] = 0.f;
  }
#pragma unroll
  for (int i = 0; i < 2; ++i)
#pragma unroll
    for (int g = 0; g < 4; ++g) {
      u32x2 w;
      w.x = cvt_pk_bf16(accC[i][4 * g], accC[i][4 * g + 1]);
      w.y = cvt_pk_bf16(accC[i][4 * g + 2], accC[i][4 * g + 3]);
      *(u32x2*)(CT + ((dvt0 + i) * 32 + r) * 136 + dkt * 32 + 8 * g + 4 * h2) = w;
    }
  const int j0 = tid >> 4, cc = tid & 15;
  const int vj = tid & 63, vc8 = tid >> 6;
  u32x4 rq[2], rk[2], rv[2];
  float gi = 0.f, gf = 0.f;
#define MLSTM_ROW(c, j) (base_row + (dir ? (T - 1 - ((c) * 64 + (j))) : ((c) * 64 + (j))))
  const int rstep = dir ? -64 : 64;
  const bf16_t* pq0 = PM + (size_t)MLSTM_ROW(0, j0) * 2048 + h * 128 + cc * 8;
  const bf16_t* pq1 = PM + (size_t)MLSTM_ROW(0, j0 + 32) * 2048 + h * 128 + cc * 8;
  const bf16_t* pv0 = PM + (size_t)MLSTM_ROW(0, vj) * 2048 + 1024 + h * 128 + vc8 * 8;
  const float* pgt = G + (size_t)MLSTM_ROW(0, lane) * 16 + (2 * dir) * 4 + h;
  const long cstride = (long)rstep * 2048;
  const int sgn = dir ? -1 : 1;
  bf16_t* const ph0 = Hout + (size_t)MLSTM_ROW(0, lt * 32 + 4 * h2) * 512 + h * 128 + dvt * 32 + r;
#define MLSTM_LOAD(c)                                                                     \
  {                                                                                       \
    const long co_ = (long)(c) * cstride;                                                 \
    rq[0] = *(const u32x4*)(pq0 + co_); rk[0] = *(const u32x4*)(pq0 + co_ + 512);         \
    rq[1] = *(const u32x4*)(pq1 + co_); rk[1] = *(const u32x4*)(pq1 + co_ + 512);         \
    rv[0] = *(const u32x4*)(pv0 + co_); rv[1] = *(const u32x4*)(pv0 + co_ + 64);          \
  }
#define MLSTM_GATES(c)                                                                    \
  if (wid == 7) {                                                                         \
    const float* gp_ = pgt + (long)(c) * (rstep * 16);                                    \
    gi = gp_[0];                                                                          \
    gf = gp_[4];                                                                          \
  }
#define MLSTM_SCAL(par)                                                                   \
  if (wid == 7) {                                                                         \
    float* Fp = F + (par) * 384;                                                          \
    const float iv = gi;                                                                  \
    float bc = fminf(gf, 0.f) - log1pf(__expf(-fabsf(gf)));                               \
    _Pragma("unroll") for (int d = 1; d < 64; d <<= 1) { const float tt = __shfl_up(bc, d); if (lane >= d) bc += tt; } \
    const float a = iv - bc;                                                              \
    float pm = a;                                                                         \
    _Pragma("unroll") for (int d = 1; d < 64; d <<= 1) { const float tt = __shfl_up(pm, d); if (lane >= d) pm = fmaxf(pm, tt); } \
    const float mt = bc + fmaxf(m_state, pm);                                             \
    const float tot = __shfl(bc, 63);                                                     \
    const float gg = tot + a;                                                             \
    const float gmax = wave_max(gg);                                                      \
    const float total = tot + m_state;                                                    \
    const float m_new = fmaxf(total, gmax);                                               \
    Fp[lane] = bc - mt;                                                           \
    Fp[64 + lane] = a;                                                             \
    Fp[128 + lane] = mt;                                                          \
    Fp[192 + lane] = __expf(bc + m_state - mt);                                  \
    Fp[256 + lane] = __expf(gg - m_new) * kscale;                                \
    if (lane == 0) Fp[320] = __expf(total - m_new);                             \
    m_state = m_new;                                                                      \
  }
  MLSTM_LOAD(0);
  MLSTM_GATES(0);
  MLSTM_SCAL(0);
  if (nc > 1) MLSTM_GATES(1);
  for (int c = 0; c < nc; ++c) {
#pragma unroll
    for (int i = 0; i < 2; ++i) {
      const int j = j0 + 32 * i;
      *(u32x4*)(Qs + j * 136 + cc * 8) = rq[i];
      *(u32x4*)(Ks + j * 136 + cc * 8) = rk[i];
      const int vr0 = (vc8 + 8 * i) * 8;
      VT[(vr0 + 0) * 72 + vj] = (bf16_t)(rv[i].x & 0xffffu);
      VT[(vr0 + 1) * 72 + vj] = (bf16_t)(rv[i].x >> 16);
      VT[(vr0 + 2) * 72 + vj] = (bf16_t)(rv[i].y & 0xffffu);
      VT[(vr0 + 3) * 72 + vj] = (bf16_t)(rv[i].y >> 16);
      VT[(vr0 + 4) * 72 + vj] = (bf16_t)(rv[i].z & 0xffffu);
      VT[(vr0 + 5) * 72 + vj] = (bf16_t)(rv[i].z >> 16);
      VT[(vr0 + 6) * 72 + vj] = (bf16_t)(rv[i].w & 0xffffu);
      VT[(vr0 + 7) * 72 + vj] = (bf16_t)(rv[i].w >> 16);
    }
    lds_barrier();
    const float* e1v = F + (c & 1) * 384; const float* av = e1v + 64; const float* mtv = e1v + 128;
    const float* winv = e1v + 192; const float* wgkv = e1v + 256; const float* scal = e1v + 320;
    if (c + 1 < nc) MLSTM_LOAD(c + 1);
    if (c + 1 < nc) { MLSTM_SCAL((c + 1) & 1); if (c + 2 < nc) MLSTM_GATES(c + 2); }
    {
      const int j = tid & 63;
      const float wk = wgkv[j];
#pragma unroll
      for (int i = 0; i < 2; ++i) {
        const int dkb = (tid >> 6) * 8 + 64 * i;
        const u32x4 w = *(const u32x4*)(Ks + j * 136 + dkb);
        KwT[(dkb + 0) * 72 + j] = f2bf(bflo(w.x) * wk);
        KwT[(dkb + 1) * 72 + j] = f2bf(bfhi(w.x) * wk);
        KwT[(dkb + 2) * 72 + j] = f2bf(bflo(w.y) * wk);
        KwT[(dkb + 3) * 72 + j] = f2bf(bfhi(w.y) * wk);
        KwT[(dkb + 4) * 72 + j] = f2bf(bflo(w.z) * wk);
        KwT[(dkb + 5) * 72 + j] = f2bf(bfhi(w.z) * wk);
        KwT[(dkb + 6) * 72 + j] = f2bf(bflo(w.w) * wk);
        KwT[(dkb + 7) * 72 + j] = f2bf(bfhi(w.w) * wk);
      }
    }
    f32x16 acc;
#pragma unroll
    for (int i = 0; i < 16; ++i) acc[i] = 0.f;
    const bf16_t* qcA = Qs + (lt * 32 + r) * 136 + h2 * 8;
    const bf16_t* qcB = CT + (dvt * 32 + r) * 136 + h2 * 8;
    if (wid < 4) {
      const int lt2 = wid >> 1, st = wid & 1;
      const bf16_t* sA = Qs + (lt2 * 32 + r) * 136 + h2 * 8;
      const bf16_t* sB = Ks + (st * 32 + r) * 136 + h2 * 8;
      f32x16 sacc;
#pragma unroll
      for (int i = 0; i < 16; ++i) sacc[i] = 0.f;
#pragma unroll
      for (int kb = 0; kb < 4; ++kb) {
        bf16x8 fa[2], fb[2], ga[2], gb[2];
#pragma unroll
        for (int u = 0; u < 2; ++u) {
          fa[u] = *(const bf16x8*)(sA + (2 * kb + u) * 16); fb[u] = *(const bf16x8*)(sB + (2 * kb + u) * 16);
          ga[u] = *(const bf16x8*)(qcA + (2 * kb + u) * 16); gb[u] = *(const bf16x8*)(qcB + (2 * kb + u) * 16);
        }
        __builtin_amdgcn_sched_barrier(0);
#pragma unroll
        for (int u = 0; u < 2; ++u) {
          sacc = __builtin_amdgcn_mfma_f32_32x32x16_bf16(fa[u], fb[u], sacc, 0, 0, 0);
          acc = __builtin_amdgcn_mfma_f32_32x32x16_bf16(ga[u], gb[u], acc, 0, 0, 0);
        }
      }
      const int scol = st * 32 + r;
      const float as = av[scol];
      float ev[16];
#pragma unroll
      for (int rg = 0; rg < 16; ++rg) ev[rg] = e1v[lt2 * 32 + rowof(rg, h2)];
#pragma unroll
      for (int rg = 0; rg < 16; ++rg) {
        const int lrow = lt2 * 32 + rowof(rg, h2);
        const float ex = (scol <= lrow) ? (ev[rg] + as) * 1.4426950408889634f : -__builtin_inff();
        const float val = sacc[rg] * kscale * __builtin_amdgcn_exp2f(ex);
        Ss[lrow * 72 + scol] = f2bf(val);
      }
    } else {
#pragma unroll
      for (int kb = 0; kb < 2; ++kb) {
        bf16x8 ga[4], gb[4];
#pragma unroll
        for (int u = 0; u < 4; ++u) { ga[u] = *(const bf16x8*)(qcA + (4 * kb + u) * 16); gb[u] = *(const bf16x8*)(qcB + (4 * kb + u) * 16); }
        __builtin_amdgcn_sched_barrier(0);
#pragma unroll
        for (int u = 0; u < 4; ++u) acc = __builtin_amdgcn_mfma_f32_32x32x16_bf16(ga[u], gb[u], acc, 0, 0, 0);
      }
    }
#pragma unroll
    for (int rg = 0; rg < 16; ++rg) acc[rg] *= winv[lt * 32 + rowof(rg, h2)];
    {
      const int lq = tid >> 3, part = tid & 7;
      float sq = 0.f;
#pragma unroll
      for (int e4 = 0; e4 < 2; ++e4) {
        const u32x4 qw = *(const u32x4*)(Qs + lq * 136 + part * 16 + e4 * 8);
        const f32x4 n0 = *(const f32x4*)(nvec + part * 16 + e4 * 8), n1 = *(const f32x4*)(nvec + part * 16 + e4 * 8 + 4);
        sq += bflo(qw.x) * n0[0] + bfhi(qw.x) * n0[1] + bflo(qw.y) * n0[2] + bfhi(qw.y) * n0[3];
        sq += bflo(qw.z) * n1[0] + bfhi(qw.z) * n1[1] + bflo(qw.w) * n1[2] + bfhi(qw.w) * n1[3];
      }
      sq += __shfl_xor(sq, 1); sq += __shfl_xor(sq, 2); sq += __shfl_xor(sq, 4);
      if (part == 0) qnv[lq] = sq;
    }
    lds_barrier();
    {
      bf16x8 sa[4], sb[4];
#pragma unroll
      for (int ks = 0; ks < 4; ++ks) {
        sa[ks] = *(const bf16x8*)(Ss + (lt * 32 + r) * 72 + ks * 16 + h2 * 8);
        sb[ks] = *(const bf16x8*)(VT + (dvt * 32 + r) * 72 + ks * 16 + h2 * 8);
      }
      __builtin_amdgcn_sched_barrier(0);
#pragma unroll
      for (int ks = 0; ks < 4; ++ks) acc = __builtin_amdgcn_mfma_f32_32x32x16_bf16(sa[ks], sb[ks], acc, 0, 0, 0);
    }
    {
      const int lq = tid >> 3, part = tid & 7;
      const u32x4 sw = *(const u32x4*)(Ss + lq * 72 + part * 8);
      float rs = (bflo(sw.x) + bfhi(sw.x)) + (bflo(sw.y) + bfhi(sw.y)) + (bflo(sw.z) + bfhi(sw.z)) + (bflo(sw.w) + bfhi(sw.w));
      rs += __shfl_xor(rs, 1); rs += __shfl_xor(rs, 2); rs += __shfl_xor(rs, 4);
      if (part == 0) {
        const float den = qnv[lq] * winv[lq] + rs;
        hdv[lq] = 1.0f / fmaxf(fabsf(den), __expf(-mtv[lq]));
      }
    }
    {
      const float decay = scal[0];
      bf16x8 ka[4], kv0[4], kv1[4];
#pragma unroll
      for (int ks = 0; ks < 4; ++ks) {
        ka[ks] = *(const bf16x8*)(KwT + (dkt * 32 + r) * 72 + ks * 16 + h2 * 8);
        kv0[ks] = *(const bf16x8*)(VT + (dvt0 * 32 + r) * 72 + ks * 16 + h2 * 8);
        kv1[ks] = *(const bf16x8*)(VT + ((dvt0 + 1) * 32 + r) * 72 + ks * 16 + h2 * 8);
      }
      __builtin_amdgcn_sched_barrier(0);
#pragma unroll
      for (int rg = 0; rg < 16; ++rg) { accC[0][rg] *= decay; accC[1][rg] *= decay; }
#pragma unroll
      for (int ks = 0; ks < 4; ++ks) {
        accC[0] = __builtin_amdgcn_mfma_f32_32x32x16_bf16(ka[ks], kv0[ks], accC[0], 0, 0, 0);
        accC[1] = __builtin_amdgcn_mfma_f32_32x32x16_bf16(ka[ks], kv1[ks], accC[1], 0, 0, 0);
      }
#pragma unroll
      for (int i = 0; i < 2; ++i) {
#pragma unroll
        for (int g = 0; g < 4; ++g) {
          u32x2 w;
          w.x = cvt_pk_bf16(accC[i][4 * g], accC[i][4 * g + 1]);
          w.y = cvt_pk_bf16(accC[i][4 * g + 2], accC[i][4 * g + 3]);
          *(u32x2*)(CT + ((dvt0 + i) * 32 + r) * 136 + dkt * 32 + 8 * g + 4 * h2) = w;
        }
      }
      {
        const int ndk = tid >> 2, npart = tid & 3;
        const u32x4 k0 = *(const u32x4*)(KwT + ndk * 72 + npart * 16), k1 = *(const u32x4*)(KwT + ndk * 72 + npart * 16 + 8);
        float sn = (bflo(k0.x) + bfhi(k0.x)) + (bflo(k0.y) + bfhi(k0.y)) + (bflo(k0.z) + bfhi(k0.z)) + (bflo(k0.w) + bfhi(k0.w));
        sn += (bflo(k1.x) + bfhi(k1.x)) + (bflo(k1.y) + bfhi(k1.y)) + (bflo(k1.z) + bfhi(k1.z)) + (bflo(k1.w) + bfhi(k1.w));
        sn += __shfl_xor(sn, 1); sn += __shfl_xor(sn, 2);
        if (npart == 0) nvec[ndk] = nvec[ndk] * decay + sn;
      }
    }
    lds_barrier();
    {
      bf16_t* const phc = ph0 + (long)c * (rstep * 512);
#pragma unroll
      for (int rg = 0; rg < 16; ++rg) {
        const int lrow = lt * 32 + rowof(rg, h2);
        phc[sgn * (((rg & 3) + 8 * (rg >> 2)) * 512)] = f2bf(acc[rg] * hdv[lrow]);
      }
    }
  }
#undef MLSTM_LOAD
#undef MLSTM_GATES
#undef MLSTM_SCAL
#undef MLSTM_ROW
  if (!lat) {
#pragma unroll
    for (int i = 0; i < 2; ++i)
#pragma unroll
      for (int rg = 0; rg < 16; ++rg)
        p.out[O_C + sidx * 16384 + (size_t)(dkt * 32 + rowof(rg, h2)) * 128 + (dvt0 + i) * 32 + r] = accC[i][rg];
    if (tid < 128) p.out[O_N + sidx * 128 + tid] = nvec[tid];
    if (tid == 448) p.out[O_M + sidx] = m_state;
  }
  __syncthreads();
}

__device__ void mixers_phase(const Params& p, int l, unsigned* counter, const bf16_t* PM, const float* G, bf16_t* HF, bf16_t* HB,
                             bf16_t* QA, bf16_t* YA, const bf16_t* KAV, bf16_t* GQ, const bf16_t* GK, const bf16_t* GV, bf16_t* lds, int item_limit, int item_first = 0, bool nostore = false) {
  const int tid = opaque_tid(), lane = tid & 63, wid = tid >> 6, r = lane & 31;
  int* slot = (int*)((unsigned char*)lds + 130048);
#ifndef STATIC_SCHED
#define STATIC_SCHED 0
#endif
  for (int it_ = 0;; ++it_) {
#if STATIC_SCHED
    const int item = opaque_bid() + it_ * opaque_gdim();
    (void)slot; (void)counter;
#else
    if (tid == 0) *slot = (int)atomicAdd(counter, 1u);
    __syncthreads();
    int item = *slot;
    __syncthreads();
#endif
    item += item_first;
    if (item >= item_limit) break;
    if (item < 64) {
#if MIXSEL & 1
      const bool lat = item < 32;
      const int nch = lat ? 1 : 8, ch0 = lat ? item : (item - 32) * 8;
      for (int q = 0; q < nch; ++q) {
        const int ch = ch0 + q;
        const int dir = ch & 1, h = (ch >> 1) & 3, b = ch >> 3;
        mlstm_chain(p, l, lat, b, h, dir, PM, G, dir ? HB : HF, lds);
      }
#endif
    } else if (item < 320 || (item >= 576 && item < 832)) {
#if MIXSEL & 2
      const bool lat = item < 320;
      const int i = lat ? item - 64 : item - 576;
      const int b = lat ? (i >> 6) : (i >> 3), h = lat ? ((i >> 3) & 7) : (i & 7), qt = lat ? (i & 7) : 0;
      const int own0 = lat ? NCTX + b * 2048 : b * 256;
      const int qrow = own0 + qt * 256 + wid * 32 + r;
      bf16_t* qp = QA + (size_t)qrow * 768 + h * 96;
      attn_item<96>(qp, YA + (size_t)qrow * 512 + h * 64, KAV + h * 160, 1280, KAV + h * 160 + 96, 1280, NTOK + b * 256, lat ? 4 : 0, own0, lat ? 36 : 4, lds, nostore);
#endif
    } else {
#if MIXSEL & 4
      const bool lat = item < 576;
      const int i = lat ? item - 320 : item - 832;
      const int b = lat ? (i >> 6) : (i >> 3), kvh = lat ? ((i >> 5) & 1) : ((i >> 2) & 1), tile = lat ? (i & 31) : (i & 3);
      const int own0 = lat ? NCTX + b * 2048 : b * 256;
      const int head = kvh * 4 + (wid >> 1);
      const int qrow = own0 + tile * 64 + (wid & 1) * 32 + r;
      bf16_t* qp = GQ + (size_t)qrow * 512 + head * 64;
      attn_item<64>(qp, qp, GK + kvh * 64, 128, GV + kvh * 64, 128, NTOK + b * 256, lat ? 4 : 0, own0, lat ? 36 : 4, lds, nostore);
#endif
    }
  }
}

#define XB_TMO      128
#define XB_XCNT(j)  (256  + 64 * (j))
#define XB_XSUB(j)  (1280 + 64 * (j))
#define XB_XGEN(j)  (2304 + 64 * (j))
#define XB_TOP      3328
#define XB_TOPGEN   3392
#define XCD_BAR_WORDS 3456
#define XB_SPIN_CAP (1u << 18)
#define XLAS __attribute__((address_space(3)))

__device__ __forceinline__ unsigned xb_ld(unsigned* p)              { return __hip_atomic_load(p, __ATOMIC_RELAXED, __HIP_MEMORY_SCOPE_AGENT); }
__device__ __forceinline__ unsigned xb_add(unsigned* p, unsigned v) { return __hip_atomic_fetch_add(p, v, __ATOMIC_RELAXED, __HIP_MEMORY_SCOPE_AGENT); }
__device__ __forceinline__ unsigned xb_xcc_id() { return (unsigned)__builtin_amdgcn_s_getreg((3 << 11) | 20) & 0xFu; }
#define XB_SPIN(cond, bar) do { unsigned _sp = 0; while (cond) { __builtin_amdgcn_s_sleep(1); \
    if ((++_sp & 255u) == 0u) { if (xb_ld(&(bar)[XB_TMO])) break; if (_sp > XB_SPIN_CAP) { atomicAdd(&(bar)[XB_TMO], 1u); break; } } } } while (0)

struct XcdBarrier {
    unsigned* bar; unsigned x;
    volatile XLAS unsigned* st;
};

__device__ __forceinline__ XcdBarrier xcd_barrier_post(unsigned* bar, volatile XLAS unsigned* st) {
    XcdBarrier b; b.bar = bar; b.x = xb_xcc_id(); b.st = st;
    if (threadIdx.x == 0) (void)xb_add(&bar[XB_XCNT(b.x)], 1u);
    return b;
}
__device__ __forceinline__ void xcd_barrier_complete(unsigned* bar, unsigned x, unsigned& nloc, unsigned& nx) {
    const unsigned G = gridDim.x * gridDim.y * gridDim.z;
    unsigned sum, cnt, mine, sp = 0u;
    for (;;) {
        sum = 0u; cnt = 0u; mine = 0u;
#pragma unroll
        for (unsigned j = 0; j < 16; ++j) { const unsigned c = xb_ld(&bar[XB_XCNT(j)]); sum += c; cnt += (c > 0u) ? 1u : 0u; mine = (j == x) ? c : mine; }
        if (sum == G) break;
        __builtin_amdgcn_s_sleep(1);
        if ((++sp & 255u) == 0u) { if (xb_ld(&bar[XB_TMO])) break; if (sp > XB_SPIN_CAP) { atomicAdd(&bar[XB_TMO], 1u); break; } }
    }
    nloc = mine > 0u ? mine : 1u; nx = cnt > 0u ? cnt : 1u;
}

__device__ __forceinline__ void xcd_barrier(const XcdBarrier& b) {
    asm volatile("s_waitcnt vmcnt(0)" ::: "memory");
    __syncthreads();
    if (threadIdx.x == 0) {
        unsigned* bar = b.bar;
        __builtin_amdgcn_s_waitcnt(0);
        unsigned nloc = b.st[0], nx = b.st[1];
        if (nloc == 0u) { xcd_barrier_complete(bar, b.x, nloc, nx); b.st[0] = nloc; b.st[1] = nx; }
        const unsigned old = xb_add(&bar[XB_XSUB(b.x)], 1u);
        const unsigned gen = old / nloc;
        if (old + 1u == (gen + 1u) * nloc) {
            __builtin_amdgcn_fence(__ATOMIC_RELEASE, "agent");
            asm volatile("s_waitcnt vmcnt(0)" ::: "memory");
            const unsigned og = xb_add(&bar[XB_TOP], 1u);
            const unsigned tg = og / nx;
            if (og + 1u == (tg + 1u) * nx) xb_add(&bar[XB_TOPGEN], 1u);
            else XB_SPIN(xb_ld(&bar[XB_TOPGEN]) == tg, bar);
            __builtin_amdgcn_fence(__ATOMIC_ACQUIRE, "agent");
            xb_add(&bar[XB_XGEN(b.x)], 1u);
            asm volatile("s_waitcnt vmcnt(0)" ::: "memory");
        } else {
            XB_SPIN(xb_ld(&bar[XB_XGEN(b.x)]) == gen, bar);
            __builtin_amdgcn_fence(__ATOMIC_ACQUIRE, "agent");
            asm volatile("s_waitcnt vmcnt(0)" ::: "memory");
        }
    }
    __syncthreads();
}

__global__ void __launch_bounds__(512) fwd_megakernel(const Params p0) {
  extern __shared__ __attribute__((aligned(16))) unsigned char smem[];
  bf16_t* lds = (bf16_t*)smem;
  cg::grid_group grid = cg::this_grid();
  volatile XLAS unsigned* xb_st = (volatile XLAS unsigned*)((XLAS unsigned char*)smem + 131072);
  if (threadIdx.x == 0) { xb_st[0] = 0u; xb_st[1] = 0u; }
  __syncthreads();
  const XcdBarrier xbar = xcd_barrier_post((unsigned*)(p0.ws + OFF_BAR), xb_st);
  if (p0.ph_lo == 0) {
    const Params& p = p0;
    const int tid = opaque_tid(), lane = tid & 63, wid = tid >> 6, wm = wid >> 1, wn = wid & 1, h2 = lane >> 5, r = lane & 31;
    unsigned char* ws = p0.ws;
    asm volatile("" : "+s"(ws));
    bf16_t* WB = (bf16_t*)(ws + OFF_R0);
    bf16_t* PM = (bf16_t*)(ws + OFF_R1);
    bf16_t* MIX = (bf16_t*)(ws + OFF_MIX);
    unsigned char* SG8 = ws + OFF_SG8;
    bf16_t* YA = (bf16_t*)(ws + OFF_YA);
    bf16_t* ACT = (bf16_t*)(ws + OFF_R1);
    bf16_t* PS = (bf16_t*)(ws + OFF_R2);
    bf16_t* QA = (bf16_t*)(ws + OFF_R2);
    bf16_t* KAV = (bf16_t*)(ws + OFF_R3);
    bf16_t* H = (bf16_t*)(ws + OFF_R3);
    bf16_t* HF = (bf16_t*)(ws + OFF_HF);
    bf16_t* HB = (bf16_t*)(ws + OFF_HB);
    bf16_t* GQ = (bf16_t*)(ws + OFF_GQ);
    bf16_t* GK = (bf16_t*)(ws + OFF_GK);
    bf16_t* GV = (bf16_t*)(ws + OFF_GV);
    bf16_t* QL = (bf16_t*)(ws + OFF_QL);
    bf16_t* CKV = (bf16_t*)(ws + OFF_CKV);
    bf16_t* KR = (bf16_t*)(ws + OFF_KR);
    float* G = (float*)(ws + OFF_G);
    float* MOD = (float*)(ws + OFF_MOD);
    unsigned* CNT = (unsigned*)(ws + OFF_CNT);


    if (opaque_bid() == 0 && tid < (int)(sizeof(Params) / 8)) ((unsigned long long*)(ws + OFF_PCOPY))[tid] = ((const unsigned long long*)&p0)[tid];
      if (opaque_bid() == 0 && tid < 64) CNT[tid] = 0u;
      cvt_layer(p, 0, WB, lds);
      mod_phase(p, MOD, (float*)smem);
      rope_tables((f32x2*)(ws + OFF_TG), (f32x2*)(ws + OFF_TA));
    if (p0.ph_hi > 1) xcd_barrier(xbar);
  }
  if (p0.ph_hi < 0) grid.sync();
  for (int ph = (p0.ph_lo > 1 ? p0.ph_lo : 1); ph < p0.ph_hi; ++ph) {
    if ((ph - 1) % 13 == 10) continue;
    const int tid = opaque_tid(), lane = tid & 63, wid = tid >> 6, wm = wid >> 1, wn = wid & 1, h2 = lane >> 5, r = lane & 31;
    unsigned char* ws = p0.ws;
    asm volatile("" : "+s"(ws));
    const Params& p = *(const Params*)(ws + OFF_PCOPY);
    bf16_t* WB = (bf16_t*)(ws + OFF_R0);
    bf16_t* PM = (bf16_t*)(ws + OFF_R1);
    bf16_t* MIX = (bf16_t*)(ws + OFF_MIX);
    unsigned char* SG8 = ws + OFF_SG8;
    bf16_t* YA = (bf16_t*)(ws + OFF_YA);
    bf16_t* ACT = (bf16_t*)(ws + OFF_R1);
    bf16_t* PS = (bf16_t*)(ws + OFF_R2);
    bf16_t* QA = (bf16_t*)(ws + OFF_R2);
    bf16_t* KAV = (bf16_t*)(ws + OFF_R3);
    bf16_t* H = (bf16_t*)(ws + OFF_R3);
    bf16_t* HF = (bf16_t*)(ws + OFF_HF);
    bf16_t* HB = (bf16_t*)(ws + OFF_HB);
    bf16_t* GQ = (bf16_t*)(ws + OFF_GQ);
    bf16_t* GK = (bf16_t*)(ws + OFF_GK);
    bf16_t* GV = (bf16_t*)(ws + OFF_GV);
    bf16_t* QL = (bf16_t*)(ws + OFF_QL);
    bf16_t* CKV = (bf16_t*)(ws + OFF_CKV);
    bf16_t* KR = (bf16_t*)(ws + OFF_KR);
    float* G = (float*)(ws + OFF_G);
    float* MOD = (float*)(ws + OFF_MOD);
    unsigned* CNT = (unsigned*)(ws + OFF_CNT);


    {
      const int l = (ph - 1) / 13, sp = (ph - 1) % 13;
      const float* MODl = MOD + (size_t)l * 5 * 6144;
      if (sp == 0) {
        if (l == 1) cvt_layer(p, 1, WB, lds);
        else normmod_rows(p, true, p.norm1_g, MODl, 0, 1024, H);
      } else if (sp == 1 || sp == 7 || sp == 11) {
        const int mode = (sp == 1) ? 0 : (sp == 7) ? 1 : 2;
        const int Nn = (mode == 0) ? 3328 : (mode == 1) ? 3072 : 5632;
        const size_t boff = (mode == 0) ? WB_WIN + (size_t)3072 * 1024 : (mode == 1) ? WB_WIN : WB_WFI;
        pg8::Gemm g{H, WB + boff, NTOK, Nn, 1024};
        pg8::StaticOrder S; S.init(NTOK, Nn, opaque_gdim(), opaque_bid());
        EpiU E{mode, EpiP2{PM, PS, G, p.b_mgate + l * 16}, EpiGate8{SG8}, EpiSwiGLU{ACT}};
        pg8::gemm_phase<EpiU, pg8::StaticOrder, false>((PG8_LAS unsigned char*)smem, g, S, E, nullptr);
      } else if (sp == 2) {
        post_small(p, l, PS, QL, CKV, KR, GQ, GK, GV, (const f32x2*)(ws + OFF_TG));
      } else if (sp == 3) {
        size_t wz4_ = 0;
        asm volatile("" : "+s"(wz4_));
        unsigned char* wsg4 = p0.ws + wz4_;
        const bf16_t* gQL = (const bf16_t*)(wsg4 + OFF_QL); const bf16_t* gCKV = (const bf16_t*)(wsg4 + OFF_CKV); const bf16_t* gWB = (const bf16_t*)(wsg4 + OFF_R0);
        bf16_t* gQA = (bf16_t*)(wsg4 + OFF_R2); bf16_t* gKAV = (bf16_t*)(wsg4 + OFF_R3);
        for (int tile = opaque_bid(); tile < 384 + 544; tile += opaque_gdim()) {
          f32x16 acc[2][2];
          zero_acc<2>(acc);
          if (tile < 384) {
            const int tm = tile & 63, tn = tile >> 6;
            gemm_acc<2>(acc, gQL + (size_t)tm * 256 * 256, 256, 64, gWB + WB_WUQ + (size_t)tn * 128 * 256, 256, 4, lds);
#pragma unroll
            for (int mi = 0; mi < 2; ++mi)
#pragma unroll
              for (int ni = 0; ni < 2; ++ni) {
                const int col = tn * 128 + wn * 64 + ni * 32 + r;
#pragma unroll
                for (int rg = 0; rg < 16; ++rg) {
                  const int row = tm * 256 + wm * 64 + mi * 32 + rowof(rg, h2);
                  gQA[(size_t)row * 768 + col] = f2bf(acc[mi][ni][rg]);
                }
              }
          } else {
            const int t2 = tile - 384, tm = t2 % 68, tn = t2 / 68;
            gemm_acc<2>(acc, gCKV + (size_t)tm * 256 * 128, 128, 64, gWB + WB_WUKV + (size_t)tn * 128 * 128, 128, 2, lds);
#pragma unroll
            for (int mi = 0; mi < 2; ++mi)
#pragma unroll
              for (int ni = 0; ni < 2; ++ni) {
                const int col = tn * 128 + wn * 64 + ni * 32 + r;
                const int hd = col >> 7, jj = col & 127;
                const int dcol = hd * 160 + (jj < 64 ? jj : jj + 32);
#pragma unroll
                for (int rg = 0; rg < 16; ++rg) {
                  const int row = tm * 256 + wm * 64 + mi * 32 + rowof(rg, h2);
                  gKAV[(size_t)row * 1280 + dcol] = f2bf(acc[mi][ni][rg]);
                }
              }
          }
        }
      } else if (sp == 4) {
        post_mla(p, l, QA, KAV, KR, (const f32x2*)(ws + OFF_TA));
      } else if (sp == 5) {
        size_t wz_ = 0;
        asm volatile("" : "+s"(wz_));
        unsigned char* wsg = p0.ws + wz_;
        const ParamsG* pg_ = (const ParamsG*)(wsg + OFF_PCOPY);
        Params pm_;
        pm_.st_C = (const float*)pg_->f[2]; pm_.st_n = (const float*)pg_->f[3]; pm_.st_m = (const float*)pg_->f[4];
        pm_.out = (float*)pg_->out;
        mixers_phase(pm_, l, (unsigned*)(wsg + OFF_CNT) + l, (const bf16_t*)(wsg + OFF_R1), (const float*)(wsg + OFF_G), (bf16_t*)(wsg + OFF_HF), (bf16_t*)(wsg + OFF_HB),
                     (bf16_t*)(wsg + OFF_R2), (bf16_t*)(wsg + OFF_YA), (const bf16_t*)(wsg + OFF_R3), (bf16_t*)(wsg + OFF_GQ), (const bf16_t*)(wsg + OFF_GK),
                     (const bf16_t*)(wsg + OFF_GV), lds, 1088);
      } else if (sp == 6) {
        post_mlstm(p, l, HF, HB, PM);
        normmod_rows(p, l == 0, p.norm1_g + l * 1024, MODl, 0, 1024, H);
      } else if (sp == 8) {
        pg8::Gemm g{HF, WB + WB_WBR, 3 * NTOK, 1024, 512};
        BranchOrder S{opaque_gdim(), opaque_bid()};
        EpiMixAcc E{SG8, MIX};
        pg8::gemm_phase<EpiMixAcc, BranchOrder, false>((PG8_LAS unsigned char*)smem, g, S, E, nullptr);
      } else if (sp == 9 || sp == 12) {
        const bool is9 = (sp == 9);
        pg8::Gemm g{is9 ? MIX : ACT, WB + (is9 ? WB_WOUT : WB_WFO), NTOK, 1024, is9 ? 1024 : DFF};
        pg8::StaticOrder S; S.init(NTOK, 1024, opaque_gdim(), opaque_bid());
        const bool donorm = is9 || l == 0;
        const int ln = is9 ? l : 1;
        EpiRes E{p.x_prompt, p.x_sample, p.out, MODl, is9 ? 2048 : 5120, (is9 && l == 0) ? 1 : 0,
                 donorm ? 1 : 0, (is9 ? p.norm2_g : p.norm1_g) + ln * 1024, MOD + (size_t)ln * 5 * 6144, is9 ? 3072 : 0, is9 ? 4096 : 1024, H,
                 (unsigned*)(ws + OFF_SS), CNT + 128 + (l * 2 + (is9 ? 0 : 1)) * 64};
        pg8::gemm_phase<EpiRes, pg8::StaticOrder, false>((PG8_LAS unsigned char*)smem, g, S, E, nullptr);
      }
    }
    if (ph + 1 < p0.ph_hi) xcd_barrier(xbar);
  }
}

extern "C" void kernel_launch(void* const* d_in, const int* in_sizes, int n_in, void* d_out, int out_size, void* d_ws, size_t ws_size,
                              hipStream_t stream) {
  static int grid_blocks = 0;
  if (!grid_blocks) {
    int dev = 0, cus = 0, per_cu = 0;
    (void)hipGetDevice(&dev);
    (void)hipDeviceGetAttribute(&cus, hipDeviceAttributeMultiprocessorCount, dev);
    (void)hipFuncSetAttribute((const void*)fwd_megakernel, hipFuncAttributeMaxDynamicSharedMemorySize, (int)DYN_LDS);
    (void)hipOccupancyMaxActiveBlocksPerMultiprocessor(&per_cu, fwd_megakernel, 512, DYN_LDS);
    if (per_cu > 1) per_cu = 1;
    if (per_cu < 1) per_cu = 1;
    grid_blocks = cus * per_cu;
  }
  if (ws_size < WS_END) fprintf(stderr, "workspace too small: %zu < %zu\n", ws_size, (size_t)WS_END);
  Params p{};
  const float* const* in = (const float* const*)d_in;
  p.x_prompt = in[0]; p.x_sample = in[1]; p.st_C = in[2]; p.st_n = in[3]; p.st_m = in[4]; p.c_ckv = in[5]; p.c_kr = in[6];
  p.c_gk = in[7]; p.c_gv = in[8]; p.c = in[9]; p.c_ctx = in[10]; p.w_mod = in[11]; p.b_mod = in[12]; p.norm1_g = in[13];
  p.w_in = in[14]; p.b_mgate = in[15]; p.m_norm_g = in[16]; p.a_qlora_g = in[17]; p.a_kvlora_g = in[18]; p.w_uq = in[19];
  p.w_ukv = in[20]; p.a_qnorm_g = in[21]; p.a_knorm_g = in[22]; p.g_qnorm_g = in[23]; p.g_knorm_g = in[24]; p.w_branch = in[25];
  p.w_out = in[26]; p.norm2_g = in[27]; p.w_ffn_in = in[28]; p.w_ffn_out = in[29];
  p.out = (float*)d_out;
  p.ws = (unsigned char*)d_ws;
  (void)hipMemsetAsync((unsigned char*)d_ws + OFF_CNT, 0, 4096 + 16384, stream);
#if MULTI_LAUNCH
#ifndef RUN_PHASES
#define RUN_PHASES NPHASE
#endif
  for (int ph = 0; ph < RUN_PHASES; ++ph) {
    p.ph_lo = ph; p.ph_hi = ph + 1;
    hipLaunchKernelGGL(fwd_megakernel, dim3(grid_blocks), dim3(512), DYN_LDS, stream, p);
  }
#ifdef DUMP_OFF
  p.ph_lo = 99; p.ph_hi = 100;
  hipLaunchKernelGGL(fwd_megakernel, dim3(grid_blocks), dim3(512), DYN_LDS, stream, p);
#endif
#else
  p.ph_lo = 0; p.ph_hi = NPHASE;
  void* args[] = {&p};
  hipError_t e = hipLaunchCooperativeKernel((void*)fwd_megakernel, dim3(grid_blocks), dim3(512), args, DYN_LDS, stream);
  if (e != hipSuccess) fprintf(stderr, "cooperative launch failed: %s (grid %d)\n", hipGetErrorString(e), grid_blocks);
#endif
}
```

```cpp
#include <hip/hip_runtime.h>
#include <hip/hip_cooperative_groups.h>
#include <cstdio>
namespace cg = cooperative_groups;

typedef unsigned short bf16_t;
typedef short bf16x8 __attribute__((ext_vector_type(8)));
typedef float f32x16 __attribute__((ext_vector_type(16)));
typedef float f32x4 __attribute__((ext_vector_type(4)));
typedef float f32x2 __attribute__((ext_vector_type(2)));
typedef unsigned u32x4 __attribute__((ext_vector_type(4)));
typedef unsigned u32x2 __attribute__((ext_vector_type(2)));

#ifndef MIXSEL
#define MIXSEL 7
#endif
#ifndef MULTI_LAUNCH
#define MULTI_LAUNCH 0
#endif

constexpr int NTOK = 16384, NCTX = 8192, NKV = 17408;
constexpr int DIN = 6320, DFF = 2816;
constexpr float EPS = 1e-6f;
constexpr int NPHASE = 27;
constexpr size_t DYN_LDS = 131072 + 64;

constexpr size_t WB_WIN = 0;
constexpr size_t WB_WUQ = WB_WIN + 6400ull * 1024;
constexpr size_t WB_WUKV = WB_WUQ + 768ull * 256;
constexpr size_t WB_WBR = WB_WUKV + 1024ull * 128;
constexpr size_t WB_WOUT = WB_WBR + 3ull * 1024 * 512;
constexpr size_t WB_WFI = WB_WOUT + 1024ull * 1024;
constexpr size_t WB_WFO = WB_WFI + 5632ull * 1024;
constexpr size_t WB_ELEMS = WB_WFO + 1024ull * 2816;

constexpr size_t OFF_R0 = 0;
constexpr size_t OFF_R1 = OFF_R0 + WB_ELEMS * 2;
constexpr size_t OFF_R2 = OFF_R1 + 16384ull * 2048 * 2;
constexpr size_t OFF_R3 = OFF_R2 + 16384ull * 1216 * 2;
constexpr size_t OFF_HF = OFF_R3 + 17408ull * 1280 * 2;
constexpr size_t OFF_YA = OFF_HF + 16384ull * 512 * 2;
constexpr size_t OFF_QL = OFF_YA;
constexpr size_t OFF_CKV = OFF_QL + 16384ull * 256 * 2;
constexpr size_t OFF_KR = OFF_CKV + 17408ull * 128 * 2;
constexpr size_t OFF_GQ = OFF_YA + 16384ull * 512 * 2;
constexpr size_t OFF_HB = OFF_GQ + 16384ull * 512 * 2;
constexpr size_t OFF_GK = OFF_HB + 16384ull * 512 * 2;
constexpr size_t OFF_GV = OFF_GK + 17408ull * 128 * 2;
constexpr size_t OFF_G = OFF_GV + 17408ull * 128 * 2;
constexpr size_t OFF_MOD = OFF_G + 16384ull * 16 * 4;
constexpr size_t OFF_CNT = OFF_MOD + 2ull * 5 * 6144 * 4;
static_assert(OFF_KR + 17408ull * 32 * 2 <= OFF_GQ, "QL/CKV/KR must fit under YA");
constexpr size_t OFF_SG8 = OFF_R1;
constexpr size_t OFF_MIX = OFF_R1 + 16384ull * 3072;
constexpr size_t OFF_PCOPY = OFF_CNT + 2048;
constexpr size_t OFF_BAR = OFF_CNT + 4096;
constexpr size_t OFF_TG = OFF_BAR + 16384;
constexpr size_t OFF_TA = OFF_TG + 2048ull * 32 * 8;
constexpr size_t OFF_SS = OFF_TA + 2048ull * 16 * 8;
constexpr size_t WS_END = OFF_SS + 16384ull * 4 * 4;

constexpr size_t O_Y = 0;
constexpr size_t O_C = 16777216;
constexpr size_t O_N = O_C + 8388608;
constexpr size_t O_M = O_N + 65536;
constexpr size_t O_CKV = O_M + 512;
constexpr size_t O_KR = O_CKV + 2097152;
constexpr size_t O_GK = O_KR + 524288;
constexpr size_t O_GV = O_GK + 2097152;

struct Params {
  const float *x_prompt, *x_sample, *st_C, *st_n, *st_m, *c_ckv, *c_kr, *c_gk, *c_gv, *c, *c_ctx;
  const float *w_mod, *b_mod, *norm1_g, *w_in, *b_mgate, *m_norm_g, *a_qlora_g, *a_kvlora_g, *w_uq, *w_ukv;
  const float *a_qnorm_g, *a_knorm_g, *g_qnorm_g, *g_knorm_g, *w_branch, *w_out, *norm2_g, *w_ffn_in, *w_ffn_out;
  float* out;
  unsigned char* ws;
  int ph_lo, ph_hi;
};

typedef __attribute__((address_space(1))) const float* gcfp_t;
struct ParamsG {
  gcfp_t f[30];
  __attribute__((address_space(1))) float* out;
  __attribute__((address_space(1))) unsigned char* ws;
  int ph_lo, ph_hi;
};
static_assert(sizeof(ParamsG) == sizeof(Params), "ParamsG must mirror Params");

typedef __bf16 bf16x2_t __attribute__((ext_vector_type(2)));
__device__ __forceinline__ unsigned cvt_pk_bf16(float lo, float hi) {
  f32x2 v = {lo, hi};
  bf16x2_t b = __builtin_convertvector(v, bf16x2_t);
  return __builtin_bit_cast(unsigned, b);
}
__device__ __forceinline__ bf16_t f2bf(float f) { return (bf16_t)(cvt_pk_bf16(f, 0.f) & 0xffffu); }
__device__ __forceinline__ float bf2f(bf16_t v) { return __uint_as_float(((unsigned)v) << 16); }
__device__ __forceinline__ float bflo(unsigned u) { return __uint_as_float(u << 16); }
__device__ __forceinline__ float bfhi(unsigned u) { return __uint_as_float(u & 0xffff0000u); }
__device__ __forceinline__ float wave_sum(float v) {
#pragma unroll
  for (int d = 1; d < 64; d <<= 1) v += __shfl_xor(v, d);
  return v;
}
__device__ __forceinline__ float half_sum(float v) {
#pragma unroll
  for (int d = 1; d < 32; d <<= 1) v += __shfl_xor(v, d);
  return v;
}
__device__ __forceinline__ float wave_max(float v) {
#pragma unroll
  for (int d = 1; d < 64; d <<= 1) v = fmaxf(v, __shfl_xor(v, d));
  return v;
}
__device__ __forceinline__ int opaque_tid() {
  int t = threadIdx.x;
  asm volatile("" : "+v"(t));
  return t;
}
__device__ __forceinline__ int opaque_bid() {
  int b = blockIdx.x;
  asm volatile("" : "+s"(b));
  return b;
}
__device__ __forceinline__ int opaque_gdim() {
  int g = gridDim.x;
  asm volatile("" : "+s"(g));
  return g;
}
__device__ __forceinline__ float cross_half_max(float x) {
  const unsigned u = __float_as_uint(x);
  const u32x2 rr = __builtin_amdgcn_permlane32_swap(u, u, false, false);
  return fmaxf(__uint_as_float(rr[0]), __uint_as_float(rr[1]));
}
__device__ __forceinline__ void lds_barrier() {
  asm volatile("s_waitcnt lgkmcnt(0)" ::: "memory");
  __builtin_amdgcn_s_barrier();
  asm volatile("" ::: "memory");
}
__device__ __forceinline__ float sigmoidf_(float x) { return __builtin_amdgcn_rcpf(1.0f + __builtin_amdgcn_exp2f(x * -1.4426950408889634f)); }
__device__ __forceinline__ int rowof(int reg, int h2) { return (reg & 3) + 8 * (reg >> 2) + 4 * h2; }
__device__ __forceinline__ int mod_index(int row) { return row < NCTX ? 0 : 1 + ((row - NCTX) >> 11); }

namespace pg8 {
#define PG8_LAS __attribute__((address_space(3)))
typedef unsigned short bf16_t;
typedef short bf16x8 __attribute__((ext_vector_type(8)));
typedef float f32x4 __attribute__((ext_vector_type(4)));
typedef unsigned u32x4 __attribute__((ext_vector_type(4)));
constexpr int BM = 256, BK = 64, HALF = 128, HTB = HALF * BK * 2  , STAGE_BYTES = 8 * HTB, NXCD = 8, WGM = 4;

__host__ __device__ __forceinline__ int lds_byte(int r, int c) { const int st = (r >> 4) * 2 + (c >> 5), rr = r & 15, cc = c & 31, ob = rr * 64 + cc * 2; return st * 1024 + (ob ^ (((ob >> 9) & 1) << 5)); }
__host__ __device__ __forceinline__ void stage_rc(int b, int& R, int& C) { const int st = b / 1024, sb = b % 1024, swz = sb ^ (((sb >> 9) & 1) << 5); R = (st >> 1) * 16 + swz / 64; C = (st & 1) * 32 + (swz % 64) / 2; }
__host__ __device__ __forceinline__ int perm32(int rho) { const int n = rho >> 4, i = rho & 15; return 8 * (i >> 2) + 4 * n + (i & 3); }

struct Unit { int pm, pn; };
struct Gemm { const bf16_t* A; const bf16_t* Bt; int M, N, K; };

struct StaticOrder {
    int nM, nN, nwg, G, c;
    __host__ __device__ void init(int M, int N, int G_, int c_) { nM = M / BM; nN = N / BM; nwg = nM * nN; G = G_; c = c_; }
    __host__ __device__ bool next(int i, Unit& u) const {
        const long L = (long)i * G + c; if (L >= nwg) return false;
        int wgid = (int)L; { const int q = nwg / NXCD, r = nwg % NXCD, xcd = wgid % NXCD, off = wgid / NXCD; wgid = (xcd < r ? xcd * (q + 1) : r * (q + 1) + (xcd - r) * q) + off; }
        const int nig = WGM * nN, gid = wgid / nig, fm = gid * WGM, gsz = (nM - fm) < WGM ? (nM - fm) : WGM;
        u.pm = fm + ((wgid % nig) % gsz); u.pn = (wgid % nig) / gsz; return true;
    }
    __device__ __forceinline__ void a_ready(const Unit&) const {}
    __device__ __forceinline__ void done(const Unit&) const {}
};
template <class Epi, class Sched, bool STAMP = false>
__device__ __forceinline__ void gemm_phase(PG8_LAS unsigned char* lds, const Gemm g, const Sched& S, const Epi& E, unsigned long long* stamps) {
    const int tid = opaque_tid(), wid = __builtin_amdgcn_readfirstlane(tid >> 6), lane = tid & 63, wr = wid >> 2, wc = wid & 3, fr = lane & 15, fq = lane >> 4;
    const int K = g.K, nt = K / BK;
    int ts_lo = 0, ts_hi = 0, nts = 0; const unsigned long long rt_entry = STAMP ? (unsigned long long)wall_clock64() : 0ull;
#define PG8_STAMP() do { if (STAMP && wid == 0 && nts < 64) { const unsigned long long _c = (unsigned long long)clock64(); \
        ts_lo = (lane == nts) ? (int)(unsigned)_c : ts_lo; ts_hi = (lane == nts) ? (int)(unsigned)(_c >> 32) : ts_hi; ++nts; } } while (0)
    PG8_STAMP();
    unsigned voffA[2], voffB[2];
#pragma unroll
    for (int i = 0; i < 2; ++i) { int R, C; stage_rc(tid * 16 + i * 8192, R, C); const int Rb = Epi::PERM ? ((R & ~31) + perm32(R & 31)) : R;
        voffA[i] = (unsigned)(R * K + C) * 2u; voffB[i] = (unsigned)(Rb * K + C) * 2u; }
    const size_t kstep = (size_t)(BK * 2);
    const size_t hstep = (size_t)HALF * K * 2;
    const size_t tstep = 2 * hstep;
    const unsigned ldsw = (unsigned)wid * 1024u;
    const int aoff = lds_byte(wr * 64 + fr, fq * 8), boff = lds_byte(wc * 32 + fr, fq * 8);
#define PG8_SA(b, h) (((b) * 2 + (h)) * HTB)
#define PG8_SB(b, h) ((4 + (b) * 2 + (h)) * HTB)
#define PG8_STAGE(bufoff, gbase, voff) do { _Pragma("unroll") for (int _i = 0; _i < 2; ++_i) \
        __builtin_amdgcn_global_load_lds((const unsigned*)((const char*)(gbase) + (voff)[_i]), (PG8_LAS unsigned*)(lds + (bufoff) + ldsw + _i * 8192), 16, 0, 0); } while (0)
#define PG8_LDA(dst, b, h) do { _Pragma("unroll") for (int m = 0; m < 4; ++m) _Pragma("unroll") for (int k = 0; k < 2; ++k) dst[m][k] = *(const PG8_LAS bf16x8*)(lds + PG8_SA(b, h) + aoff + m * 2048 + k * 1024); } while (0)
#define PG8_LDB(dst, b, h) do { _Pragma("unroll") for (int n = 0; n < 2; ++n) _Pragma("unroll") for (int k = 0; k < 2; ++k) dst[n][k] = *(const PG8_LAS bf16x8*)(lds + PG8_SB(b, h) + boff + n * 2048 + k * 1024); } while (0)
#define PG8_MMA(ai, bj, At, Bt) do { __builtin_amdgcn_s_setprio(1); _Pragma("unroll") for (int m = 0; m < 4; ++m) _Pragma("unroll") for (int n = 0; n < 2; ++n) _Pragma("unroll") for (int k = 0; k < 2; ++k) \
        acc[ai][bj][m][n] = __builtin_amdgcn_mfma_f32_16x16x32_bf16(Bt[n][k], At[m][k], acc[ai][bj][m][n], 0, 0, 0); __builtin_amdgcn_s_setprio(0); } while (0)
#define PG8_WAIT_V(n) asm volatile("s_waitcnt vmcnt(" #n ")" ::: "memory")
#define PG8_WAIT_L(n) asm volatile("s_waitcnt lgkmcnt(" #n ")" ::: "memory")
#define PG8_BAR __builtin_amdgcn_s_barrier()
#define PG8_SCHED __builtin_amdgcn_sched_barrier(0)
    Unit cur, nxt; int ui = 0;
    if (!S.next(0, cur)) return;
    f32x4 acc[2][2][4][2];
#pragma unroll
    for (int a = 0; a < 2; ++a)
#pragma unroll
        for (int b = 0; b < 2; ++b)
#pragma unroll
            for (int m = 0; m < 4; ++m)
#pragma unroll
                for (int n = 0; n < 2; ++n) acc[a][b][m][n] = (f32x4){0.f, 0.f, 0.f, 0.f};
    bf16x8 At[4][2], B0[2][2], B1[2][2];
    const char* cA = (const char*)g.A + (size_t)cur.pm * tstep; const char* cB = (const char*)g.Bt + (size_t)cur.pn * tstep;
    S.a_ready(cur);
    PG8_STAGE(PG8_SB(0, 0), cB, voffB); PG8_STAGE(PG8_SA(0, 0), cA, voffA); PG8_STAGE(PG8_SB(0, 1), cB + hstep, voffB); PG8_STAGE(PG8_SA(0, 1), cA + hstep, voffA);
    if (wr == 1) PG8_BAR;
    PG8_WAIT_V(4); PG8_BAR;
    PG8_STAGE(PG8_SB(1, 0), cB + kstep, voffB); PG8_STAGE(PG8_SA(1, 0), cA + kstep, voffA); PG8_STAGE(PG8_SB(1, 1), cB + hstep + kstep, voffB);
    PG8_WAIT_V(6); PG8_BAR;
    PG8_STAMP();
    for (;;) {
        const bool has_next = S.next(ui + 1, nxt);
        const char* nA = has_next ? (const char*)g.A + (size_t)nxt.pm * tstep : cA; const char* nB = has_next ? (const char*)g.Bt + (size_t)nxt.pn * tstep : cB;
        for (int t = 0; t < nt; t += 2) {
            const bool last = (t == nt - 2);
            const char* a1 = cA + (size_t)(t + 1) * kstep;
            const char* a2 = last ? nA : cA + (size_t)(t + 2) * kstep; const char* b2 = last ? nB : cB + (size_t)(t + 2) * kstep;
            const char* a3 = a2 + kstep; const char* b3 = b2 + kstep;
            if (last && has_next) S.a_ready(nxt);
            PG8_LDB(B0, 0, 0); PG8_SCHED; PG8_LDA(At, 0, 0); PG8_STAGE(PG8_SA(1, 1), a1 + hstep, voffA);
            PG8_WAIT_L(8); PG8_BAR; PG8_WAIT_L(0); PG8_MMA(0, 0, At, B0); PG8_BAR; PG8_SCHED;
            PG8_LDB(B1, 0, 1); PG8_STAGE(PG8_SB(0, 0), b2, voffB);
            PG8_BAR; PG8_WAIT_L(0); PG8_MMA(0, 1, At, B1); PG8_BAR;
            PG8_LDA(At, 0, 1); PG8_STAGE(PG8_SA(0, 0), a2, voffA);
            PG8_BAR; PG8_WAIT_L(0); PG8_MMA(1, 0, At, B0); PG8_BAR; PG8_SCHED;
            PG8_STAGE(PG8_SB(0, 1), b2 + hstep, voffB);
            PG8_WAIT_V(6); PG8_BAR; PG8_MMA(1, 1, At, B1); PG8_BAR;
            PG8_LDB(B0, 1, 0); PG8_SCHED; PG8_LDA(At, 1, 0); PG8_STAGE(PG8_SA(0, 1), a2 + hstep, voffA);
            PG8_WAIT_L(8); PG8_BAR; PG8_WAIT_L(0); PG8_MMA(0, 0, At, B0); PG8_BAR; PG8_SCHED;
            PG8_LDB(B1, 1, 1); PG8_STAGE(PG8_SB(1, 0), b3, voffB);
            PG8_BAR; PG8_WAIT_L(0); PG8_MMA(0, 1, At, B1); PG8_BAR;
            PG8_LDA(At, 1, 1); PG8_STAGE(PG8_SA(1, 0), a3, voffA);
            PG8_BAR; PG8_WAIT_L(0); PG8_MMA(1, 0, At, B0); PG8_BAR; PG8_SCHED;
            PG8_STAGE(PG8_SB(1, 1), b3 + hstep, voffB);
            PG8_WAIT_V(6); PG8_BAR; PG8_MMA(1, 1, At, B1); PG8_BAR;
        }
        PG8_STAMP();
        if constexpr (!Epi::AFTER_DRAIN) { E(acc, cur, wr, wc, fr, fq); S.done(cur); }
        PG8_STAMP();
        if (!has_next) break;
#pragma unroll
        for (int a = 0; a < 2; ++a)
#pragma unroll
            for (int b = 0; b < 2; ++b)
#pragma unroll
                for (int m = 0; m < 4; ++m)
#pragma unroll
                    for (int n = 0; n < 2; ++n) acc[a][b][m][n] = (f32x4){0.f, 0.f, 0.f, 0.f};
        cur = nxt; cA = nA; cB = nB; ++ui;
    }
    PG8_WAIT_V(0);
    if (wr == 0) PG8_BAR;
    PG8_BAR;
    if constexpr (Epi::AFTER_DRAIN) { E.fused(acc, cur, wr, wc, fr, fq, lds, wid, lane); S.done(cur); }
    PG8_STAMP();
    if (STAMP && wid == 0) { stamps[lane] = lane < nts ? (((unsigned long long)(unsigned)ts_hi << 32) | (unsigned)ts_lo) : 0ull;
        if (lane == 62) stamps[62] = rt_entry; if (lane == 63) stamps[63] = (unsigned long long)wall_clock64(); }
#undef PG8_STAMP
#undef PG8_SA
#undef PG8_SB
#undef PG8_STAGE
#undef PG8_LDA
#undef PG8_LDB
#undef PG8_MMA
#undef PG8_WAIT_V
#undef PG8_WAIT_L
#undef PG8_BAR
#undef PG8_SCHED
}
}

struct EpiP2 {
  static constexpr bool PERM = true, AFTER_DRAIN = false;
  bf16_t* PM; bf16_t* PS; float* G; const float* bias;
  __device__ __forceinline__ void operator()(const f32x4 (&acc)[2][2][4][2], const pg8::Unit& u, int wr, int wc, int fr, int fq) const {
    const int row0 = u.pm * 256 + wr * 64 + fr, colt = u.pn * 256 + wc * 32 + 8 * fq;
#pragma unroll
    for (int ai = 0; ai < 2; ++ai)
#pragma unroll
      for (int m = 0; m < 4; ++m) {
        const int row = row0 + ai * 128 + m * 16;
#pragma unroll
        for (int bj = 0; bj < 2; ++bj) {
          const int col = colt + bj * 128;
          const f32x4 v0 = acc[ai][bj][m][0], v1 = acc[ai][bj][m][1];
          u32x4 w;
          w.x = cvt_pk_bf16(v0[0], v0[1]); w.y = cvt_pk_bf16(v0[2], v0[3]);
          w.z = cvt_pk_bf16(v1[0], v1[1]); w.w = cvt_pk_bf16(v1[2], v1[3]);
          if (u.pn < 8) *(u32x4*)(PM + (size_t)row * 2048 + col) = w;
          else {
            const int c2 = col - 2048;
            if (c2 < 1200) *(u32x4*)(PS + (size_t)row * 1216 + c2) = w;
            if (c2 < 16) {
              *(f32x4*)(G + (size_t)row * 16 + c2) = v0 + *(const f32x4*)(bias + c2);
              *(f32x4*)(G + (size_t)row * 16 + c2 + 4) = v1 + *(const f32x4*)(bias + c2 + 4);
            }
          }
        }
      }
  }
};
struct EpiRes {
  static constexpr bool PERM = false, AFTER_DRAIN = true;
  const float* xp; const float* xs; float* out; const float* MODl; int gt_off; int from_input;
  int do_norm; const float* ng; const float* MODn; int sh_off, sc_off; bf16_t* H; unsigned* SS; unsigned* cnt;
  __device__ __forceinline__ void fused(f32x4 (&acc)[2][2][4][2], const pg8::Unit& u, int wr, int wc, int fr, int fq, PG8_LAS unsigned char* lds, int wid, int lane) const {
    const int row0 = u.pm * 256 + wr * 64 + fr, colt = u.pn * 256 + wc * 32 + 4 * fq;
#pragma unroll
    for (int ai = 0; ai < 2; ++ai)
#pragma unroll
      for (int m = 0; m < 4; ++m) {
        const int row = row0 + ai * 128 + m * 16;
        const float* md = MODl + mod_index(row) * 6144 + gt_off;
        const float* xin = from_input ? (row < NCTX ? xp + (size_t)row * 1024 : xs + (size_t)(row - NCTX) * 1024) : out + (size_t)row * 1024;
        float* xo = out + (size_t)row * 1024;
#pragma unroll
        for (int bj = 0; bj < 2; ++bj)
#pragma unroll
          for (int n = 0; n < 2; ++n) {
            const int col = colt + bj * 128 + n * 16;
            const f32x4 gt = *(const f32x4*)(md + col), xi = *(const f32x4*)(xin + col);
            const f32x4 v = xi + gt * acc[ai][bj][m][n];
            acc[ai][bj][m][n] = v;
            *(f32x4*)(xo + col) = v;
          }
      }
    if (!do_norm) return;
    PG8_LAS float* P = (PG8_LAS float*)lds;
    PG8_LAS float* Rr = (PG8_LAS float*)(lds + 4096);
    const int t = wid * 64 + lane;
#pragma unroll
    for (int ai = 0; ai < 2; ++ai)
#pragma unroll
      for (int m = 0; m < 4; ++m) {
        float ss = 0.f;
#pragma unroll
        for (int bj = 0; bj < 2; ++bj)
#pragma unroll
          for (int n = 0; n < 2; ++n) { const f32x4 v = acc[ai][bj][m][n]; ss += (v[0] * v[0] + v[1] * v[1]) + (v[2] * v[2] + v[3] * v[3]); }
        ss += __shfl_xor(ss, 16);
        ss += __shfl_xor(ss, 32);
        if (fq == 0) P[(ai * 128 + wr * 64 + m * 16 + fr) * 4 + wc] = ss;
      }
    lds_barrier();
    if (t < 256) {
      const float s = (P[t * 4 + 0] + P[t * 4 + 1]) + (P[t * 4 + 2] + P[t * 4 + 3]);
      __hip_atomic_store(SS + (size_t)(u.pm * 256 + t) * 4 + u.pn, __float_as_uint(s), __ATOMIC_RELAXED, __HIP_MEMORY_SCOPE_AGENT);
    }
    asm volatile("s_waitcnt vmcnt(0)" ::: "memory");
    lds_barrier();
    if (t == 0) __hip_atomic_fetch_add(cnt + u.pm, 1u, __ATOMIC_RELAXED, __HIP_MEMORY_SCOPE_AGENT);
    if (wid == 0) {
      unsigned sp_ = 0;
      while ((unsigned)__builtin_amdgcn_readfirstlane(__hip_atomic_load(cnt + u.pm, __ATOMIC_RELAXED, __HIP_MEMORY_SCOPE_AGENT)) < 4u) {
        __builtin_amdgcn_s_sleep(2);
        if (++sp_ > (1u << 20)) break;
      }
      __builtin_amdgcn_fence(__ATOMIC_ACQUIRE, "agent");
      asm volatile("s_waitcnt vmcnt(0)" ::: "memory");
    }
    lds_barrier();
    if (t < 256) {
      const unsigned* sl = SS + (size_t)(u.pm * 256 + t) * 4;
      float tot = 0.f;
#pragma unroll
      for (int q = 0; q < 4; ++q) tot += __uint_as_float(__hip_atomic_load(sl + q, __ATOMIC_RELAXED, __HIP_MEMORY_SCOPE_AGENT));
      Rr[t] = rsqrtf(tot * (1.0f / 1024.0f) + EPS);
    }
    lds_barrier();
    const float* mn = MODn + mod_index(u.pm * 256) * 6144;
#pragma unroll
    for (int bj = 0; bj < 2; ++bj)
#pragma unroll
      for (int n = 0; n < 2; ++n) {
        const int col = colt + bj * 128 + n * 16;
        const f32x4 g4 = *(const f32x4*)(ng + col), sc = *(const f32x4*)(mn + sc_off + col), sh = *(const f32x4*)(mn + sh_off + col);
#pragma unroll
        for (int ai = 0; ai < 2; ++ai)
#pragma unroll
          for (int m = 0; m < 4; ++m) {
            const int rl = ai * 128 + wr * 64 + m * 16 + fr;
            const float rstd = Rr[rl];
            const f32x4 v = acc[ai][bj][m][n];
            float y[4];
#pragma unroll
            for (int e = 0; e < 4; ++e) y[e] = v[e] * rstd * g4[e] * (1.0f + sc[e]) + sh[e];
            u32x2 w;
            w.x = cvt_pk_bf16(y[0], y[1]);
            w.y = cvt_pk_bf16(y[2], y[3]);
            *(u32x2*)(H + (size_t)(u.pm * 256 + rl) * 1024 + col) = w;
          }
      }
  }
};
struct EpiSwiGLU {
  static constexpr bool PERM = true, AFTER_DRAIN = false;
  bf16_t* ACT;
  __device__ __forceinline__ void operator()(const f32x4 (&acc)[2][2][4][2], const pg8::Unit& u, int wr, int wc, int fr, int fq) const {
    const int row0 = u.pm * 256 + wr * 64 + fr, colt = u.pn * 128 + wc * 32 + 8 * fq;
#pragma unroll
    for (int ai = 0; ai < 2; ++ai)
#pragma unroll
      for (int m = 0; m < 4; ++m) {
        const int row = row0 + ai * 128 + m * 16;
        float y[8];
#pragma unroll
        for (int n = 0; n < 2; ++n) {
          const f32x4 g = acc[ai][0][m][n], v = acc[ai][1][m][n];
#pragma unroll
          for (int e = 0; e < 4; ++e) y[4 * n + e] = g[e] * sigmoidf_(g[e]) * v[e];
        }
        u32x4 w;
        w.x = cvt_pk_bf16(y[0], y[1]); w.y = cvt_pk_bf16(y[2], y[3]); w.z = cvt_pk_bf16(y[4], y[5]); w.w = cvt_pk_bf16(y[6], y[7]);
        *(u32x4*)(ACT + (size_t)row * DFF + colt) = w;
      }
  }
};
struct EpiGate8 {
  static constexpr bool PERM = true, AFTER_DRAIN = false;
  unsigned char* SG;
  __device__ __forceinline__ void operator()(const f32x4 (&acc)[2][2][4][2], const pg8::Unit& u, int wr, int wc, int fr, int fq) const {
    const int row0 = u.pm * 256 + wr * 64 + fr, colt = u.pn * 256 + wc * 32 + 8 * fq;
#pragma unroll
    for (int ai = 0; ai < 2; ++ai)
#pragma unroll
      for (int m = 0; m < 4; ++m) {
        const int row = row0 + ai * 128 + m * 16;
#pragma unroll
        for (int bj = 0; bj < 2; ++bj) {
          u32x2 w = {0u, 0u};
#pragma unroll
          for (int e = 0; e < 4; ++e) {
            w.x |= ((unsigned)(sigmoidf_(acc[ai][bj][m][0][e]) * 255.0f + 0.5f)) << (8 * e);
            w.y |= ((unsigned)(sigmoidf_(acc[ai][bj][m][1][e]) * 255.0f + 0.5f)) << (8 * e);
          }
          *(u32x2*)(SG + (size_t)row * 3072 + colt + bj * 128) = w;
        }
      }
  }
};
struct EpiU {
  static constexpr bool PERM = true, AFTER_DRAIN = false;
  int mode;
  EpiP2 e0; EpiGate8 e1; EpiSwiGLU e2;
  __device__ __forceinline__ void operator()(const f32x4 (&acc)[2][2][4][2], const pg8::Unit& u, int wr, int wc, int fr, int fq) const {
    if (mode == 0) e0(acc, u, wr, wc, fr, fq);
    else if (mode == 1) e1(acc, u, wr, wc, fr, fq);
    else e2(acc, u, wr, wc, fr, fq);
  }
};
struct BranchOrder {
  int G, c;
  __device__ bool next(int i, pg8::Unit& u) const {
    const int n = i % 3, t = c + (i / 3) * G;
    if (t >= 256) return false;
    u.pm = n * 64 + (t >> 2); u.pn = n * 4 + (t & 3);
    return true;
  }
  __device__ __forceinline__ void a_ready(const pg8::Unit&) const {}
  __device__ __forceinline__ void done(const pg8::Unit&) const {}
};
struct EpiMixAcc {
  static constexpr bool PERM = true, AFTER_DRAIN = false;
  const unsigned char* SG; bf16_t* MIX;
  __device__ __forceinline__ void operator()(const f32x4 (&acc)[2][2][4][2], const pg8::Unit& u, int wr, int wc, int fr, int fq) const {
    const int nb = u.pn >> 2, pn = u.pn & 3, pm = u.pm - nb * 64;
    const int row0 = pm * 256 + wr * 64 + fr, colt = pn * 256 + wc * 32 + 8 * fq;
#pragma unroll
    for (int ai = 0; ai < 2; ++ai)
#pragma unroll
      for (int m = 0; m < 4; ++m) {
        const int row = row0 + ai * 128 + m * 16;
#pragma unroll
        for (int bj = 0; bj < 2; ++bj) {
          const int col = colt + bj * 128;
          const u32x2 g = *(const u32x2*)(SG + (size_t)row * 3072 + nb * 1024 + col);
          const f32x4 a0 = acc[ai][bj][m][0], a1 = acc[ai][bj][m][1];
          float y[8];
#pragma unroll
          for (int e = 0; e < 4; ++e) {
            y[e] = (float)((g.x >> (8 * e)) & 255u) * (1.0f / 255.0f) * a0[e];
            y[4 + e] = (float)((g.y >> (8 * e)) & 255u) * (1.0f / 255.0f) * a1[e];
          }
          bf16_t* mp = MIX + (size_t)row * 1024 + col;
          if (nb > 0) {
            const u32x4 o = *(const u32x4*)mp;
            y[0] += bflo(o.x); y[1] += bfhi(o.x); y[2] += bflo(o.y); y[3] += bfhi(o.y);
            y[4] += bflo(o.z); y[5] += bfhi(o.z); y[6] += bflo(o.w); y[7] += bfhi(o.w);
          }
          u32x4 w;
          w.x = cvt_pk_bf16(y[0], y[1]); w.y = cvt_pk_bf16(y[2], y[3]); w.z = cvt_pk_bf16(y[4], y[5]); w.w = cvt_pk_bf16(y[6], y[7]);
          *(u32x4*)mp = w;
        }
      }
  }
};

constexpr int LSTR = 72;
constexpr int A_TILE_EL = 256 * LSTR;
constexpr int B_TILE_EL = 128 * LSTR;
constexpr int STAGE_EL = A_TILE_EL + B_TILE_EL;

template <int NI>
__device__ __forceinline__ void gemm_acc(f32x16 (&acc)[2][NI], const bf16_t* __restrict__ A, int lda, int akstride,
                                         const bf16_t* __restrict__ Bt, int ldb, int nk, bf16_t* lds) {
  const int tid = opaque_tid(), lane = tid & 63, wid = tid >> 6, wm = wid >> 1, wn = wid & 1;
  const int lr = tid >> 3, lc = (tid & 7) * 8;
  u32x4 ra[4], rb[NI];
  const bf16_t* ap = A + (size_t)lr * lda + lc;
  const bf16_t* bp = Bt + (size_t)lr * ldb + lc;
#pragma unroll
  for (int i = 0; i < 4; ++i) ra[i] = *(const u32x4*)(ap + (size_t)(64 * i) * lda);
#pragma unroll
  for (int i = 0; i < NI; ++i) rb[i] = *(const u32x4*)(bp + (size_t)(64 * i) * ldb);
  {
    bf16_t* sA = lds;
    bf16_t* sB = lds + A_TILE_EL;
#pragma unroll
    for (int i = 0; i < 4; ++i) *(u32x4*)(sA + (lr + 64 * i) * LSTR + lc) = ra[i];
#pragma unroll
    for (int i = 0; i < NI; ++i) *(u32x4*)(sB + (lr + 64 * i) * LSTR + lc) = rb[i];
  }
  __syncthreads();
  const int arow = wm * 64 + (lane & 31), brow = wn * (32 * NI) + (lane & 31), kof = (lane >> 5) * 8;
  for (int kt = 0; kt < nk; ++kt) {
    const int cur = kt & 1;
    if (kt + 1 < nk) {
      const bf16_t* ap2 = ap + (size_t)(kt + 1) * akstride;
      const bf16_t* bp2 = bp + (size_t)(kt + 1) * 64;
#pragma unroll
      for (int i = 0; i < 4; ++i) ra[i] = *(const u32x4*)(ap2 + (size_t)(64 * i) * lda);
#pragma unroll
      for (int i = 0; i < NI; ++i) rb[i] = *(const u32x4*)(bp2 + (size_t)(64 * i) * ldb);
    }
    const bf16_t* cA = lds + cur * STAGE_EL;
    const bf16_t* cB = cA + A_TILE_EL;
#pragma unroll
    for (int ks = 0; ks < 4; ++ks) {
      bf16x8 af[2], bfr[NI];
#pragma unroll
      for (int mi = 0; mi < 2; ++mi) af[mi] = *(const bf16x8*)(cA + (arow + mi * 32) * LSTR + ks * 16 + kof);
#pragma unroll
      for (int ni = 0; ni < NI; ++ni) bfr[ni] = *(const bf16x8*)(cB + (brow + ni * 32) * LSTR + ks * 16 + kof);
#pragma unroll
      for (int mi = 0; mi < 2; ++mi)
#pragma unroll
        for (int ni = 0; ni < NI; ++ni)
          acc[mi][ni] = __builtin_amdgcn_mfma_f32_32x32x16_bf16(af[mi], bfr[ni], acc[mi][ni], 0, 0, 0);
    }
    if (kt + 1 < nk) {
      bf16_t* sA = lds + (cur ^ 1) * STAGE_EL;
      bf16_t* sB = sA + A_TILE_EL;
#pragma unroll
      for (int i = 0; i < 4; ++i) *(u32x4*)(sA + (lr + 64 * i) * LSTR + lc) = ra[i];
#pragma unroll
      for (int i = 0; i < NI; ++i) *(u32x4*)(sB + (lr + 64 * i) * LSTR + lc) = rb[i];
    }
    __syncthreads();
  }
}

template <int NI>
__device__ __forceinline__ void zero_acc(f32x16 (&acc)[2][NI]) {
#pragma unroll
  for (int mi = 0; mi < 2; ++mi)
#pragma unroll
    for (int ni = 0; ni < NI; ++ni)
#pragma unroll
      for (int r = 0; r < 16; ++r) acc[mi][ni][r] = 0.f;
}

struct CvtJob { const float* src; bf16_t* dst; int K, ld, nvalid, mode, tn, tk; };
constexpr int CVT_TILES = 2216;
__device__ __forceinline__ CvtJob cvt_decode(const Params& p, int l, bf16_t* WB, int tile) {
  CvtJob j;
  j.mode = 0;
  int tl = tile;
  if (tl < 800) { j.src = p.w_in + (size_t)l * 1024 * DIN; j.dst = WB + WB_WIN; j.K = 1024; j.ld = DIN; j.nvalid = DIN; }
  else if ((tl -= 800) < 24) { j.src = p.w_uq + (size_t)l * 256 * 768; j.dst = WB + WB_WUQ; j.K = 256; j.ld = 768; j.nvalid = 768; }
  else if ((tl -= 24) < 16) { j.src = p.w_ukv + (size_t)l * 128 * 1024; j.dst = WB + WB_WUKV; j.K = 128; j.ld = 1024; j.nvalid = 1024; }
  else if ((tl -= 16) < 192) { const int n = tl >> 6; tl &= 63; j.src = p.w_branch + (size_t)(l * 3 + n) * 512 * 1024; j.dst = WB + WB_WBR + (size_t)n * 1024 * 512; j.K = 512; j.ld = 1024; j.nvalid = 1024; }
  else if ((tl -= 192) < 128) { j.src = p.w_out + (size_t)l * 1024 * 1024; j.dst = WB + WB_WOUT; j.K = 1024; j.ld = 1024; j.nvalid = 1024; }
  else if ((tl -= 128) < 704) { j.src = p.w_ffn_in + (size_t)l * 1024 * 5632; j.dst = WB + WB_WFI; j.K = 1024; j.ld = 5632; j.nvalid = 5632; j.mode = 1; }
  else { tl -= 704; j.src = p.w_ffn_out + (size_t)l * DFF * 1024; j.dst = WB + WB_WFO; j.K = DFF; j.ld = 1024; j.nvalid = 1024; }
  const int nkt = j.K >> 7;
  j.tn = tl / nkt; j.tk = tl - j.tn * nkt;
  return j;
}
__device__ __forceinline__ void cvt_load(const CvtJob& j, int tid, f32x4 (&v)[4]) {
  const int kk = tid >> 4, n4 = (tid & 15) * 4, np = j.tn * 64 + n4;
  int nsrc = np;
  if (j.mode == 1) { const int g = np >> 8, r = np & 255; nsrc = (r < 128 ? 0 : DFF) + 128 * g + (r & 127); }
#pragma unroll
  for (int i = 0; i < 4; ++i) v[i] = (f32x4){0.f, 0.f, 0.f, 0.f};
  if (np < j.nvalid) {
#pragma unroll
    for (int i = 0; i < 4; ++i) v[i] = *(const f32x4*)(j.src + (size_t)(j.tk * 128 + kk + 32 * i) * j.ld + nsrc);
  }
}
__device__ __forceinline__ int cvt_tile_of(int part, int i) { return part == 0 ? 384 + i : (i < 384 ? i : i + 456); }
__device__ void cvt_layer(const Params& p, int l, bf16_t* WB, bf16_t* lds) {
  const int tid = opaque_tid();
  const int kk = tid >> 4, n4 = (tid & 15) * 4, nl = tid >> 3, kc = (tid & 7) * 8;
  float* Tbase = (float*)lds;
  int tile = opaque_bid(), buf = 0;
  f32x4 v[4];
  if (tile < 456) { const CvtJob j = cvt_decode(p, l, WB, cvt_tile_of(0, tile)); cvt_load(j, tid, v); }
  while (tile < 456) {
    float* T = Tbase + buf * (128 * 65);
#pragma unroll
    for (int i = 0; i < 4; ++i) {
      float* tp = T + (kk + 32 * i) * 65 + n4;
      tp[0] = v[i][0]; tp[1] = v[i][1]; tp[2] = v[i][2]; tp[3] = v[i][3];
    }
    const CvtJob jc = cvt_decode(p, l, WB, cvt_tile_of(0, tile));
    const int next = tile + opaque_gdim();
    if (next < 456) { const CvtJob jn = cvt_decode(p, l, WB, cvt_tile_of(0, next)); cvt_load(jn, tid, v); }
    lds_barrier();
#pragma unroll
    for (int hlf = 0; hlf < 2; ++hlf) {
      const int k0 = hlf * 64 + kc;
      u32x4 w;
      w.x = cvt_pk_bf16(T[(k0 + 0) * 65 + nl], T[(k0 + 1) * 65 + nl]);
      w.y = cvt_pk_bf16(T[(k0 + 2) * 65 + nl], T[(k0 + 3) * 65 + nl]);
      w.z = cvt_pk_bf16(T[(k0 + 4) * 65 + nl], T[(k0 + 5) * 65 + nl]);
      w.w = cvt_pk_bf16(T[(k0 + 6) * 65 + nl], T[(k0 + 7) * 65 + nl]);
      *(u32x4*)(jc.dst + (size_t)(jc.tn * 64 + nl) * jc.K + jc.tk * 128 + k0) = w;
    }
    buf ^= 1;
    tile = next;
  }
  __syncthreads();
}

__device__ void cvt_rest(const Params& p, int l, bf16_t* WB, bf16_t* lds, unsigned* counter) {
  const int tid = opaque_tid();
  const int kk = tid >> 4, n4 = (tid & 15) * 4, nl = tid >> 3, kc = (tid & 7) * 8;
  float* T = (float*)lds;
  int* slot = (int*)(T + 128 * 65);
  for (;;) {
    if (tid == 0) *slot = (int)atomicAdd(counter, 1u);
    __syncthreads();
    const int i = *slot;
    if (i >= 1760) break;
    const CvtJob jc = cvt_decode(p, l, WB, cvt_tile_of(1, i));
    f32x4 v[4];
    cvt_load(jc, tid, v);
#pragma unroll
    for (int q = 0; q < 4; ++q) {
      float* tp = T + (kk + 32 * q) * 65 + n4;
      tp[0] = v[q][0]; tp[1] = v[q][1]; tp[2] = v[q][2]; tp[3] = v[q][3];
    }
    __syncthreads();
#pragma unroll
    for (int hlf = 0; hlf < 2; ++hlf) {
      const int k0 = hlf * 64 + kc;
      u32x4 w;
      w.x = cvt_pk_bf16(T[(k0 + 0) * 65 + nl], T[(k0 + 1) * 65 + nl]);
      w.y = cvt_pk_bf16(T[(k0 + 2) * 65 + nl], T[(k0 + 3) * 65 + nl]);
      w.z = cvt_pk_bf16(T[(k0 + 4) * 65 + nl], T[(k0 + 5) * 65 + nl]);
      w.w = cvt_pk_bf16(T[(k0 + 6) * 65 + nl], T[(k0 + 7) * 65 + nl]);
      *(u32x4*)(jc.dst + (size_t)(jc.tn * 64 + nl) * jc.K + jc.tk * 128 + k0) = w;
    }
    __syncthreads();
  }
  __syncthreads();
}

__device__ void mod_phase(const Params& p, float* MOD, float* S) {
  const int tid = opaque_tid();
  float* R = S + 5120;
  for (int i = tid; i < 5120; i += 512) {
    const int j = i >> 10, k = i & 1023;
    const float c = (j == 0) ? p.c_ctx[k] : p.c[(j - 1) * 1024 + k];
    S[i] = c / (1.0f + __expf(-c));
  }
  __syncthreads();
  for (int item = opaque_bid(); item < 768; item += opaque_gdim()) {
    const int l = item / 384, cgp = item - l * 384, c16 = tid & 15, ks = tid >> 4;
    const float* w = p.w_mod + (size_t)l * 1024 * 6144 + cgp * 16 + c16;
    float a0 = 0.f, a1 = 0.f, a2 = 0.f, a3 = 0.f, a4 = 0.f;
#pragma unroll 8
    for (int kk2 = 0; kk2 < 32; ++kk2) {
      const int k = ks * 32 + kk2;
      const float wv = w[(size_t)k * 6144];
      a0 += S[k] * wv; a1 += S[1024 + k] * wv; a2 += S[2048 + k] * wv; a3 += S[3072 + k] * wv; a4 += S[4096 + k] * wv;
    }
    R[(ks * 5 + 0) * 16 + c16] = a0; R[(ks * 5 + 1) * 16 + c16] = a1; R[(ks * 5 + 2) * 16 + c16] = a2;
    R[(ks * 5 + 3) * 16 + c16] = a3; R[(ks * 5 + 4) * 16 + c16] = a4;
    __syncthreads();
    if (tid < 80) {
      const int j = tid >> 4, c = tid & 15;
      float s = 0.f;
      for (int q = 0; q < 32; ++q) s += R[(q * 5 + j) * 16 + c];
      MOD[(size_t)(l * 5 + j) * 6144 + cgp * 16 + c] = s + p.b_mod[l * 6144 + cgp * 16 + c];
    }
    __syncthreads();
  }
}

__device__ void normmod_rows(const Params& p, bool from_input, const float* g, const float* MODl, int sh_off, int sc_off, bf16_t* H) {
  const int tid_ = opaque_tid(), lane = tid_ & 63, wid = tid_ >> 6;
  const int stride = opaque_gdim() * 8;
  for (int row0 = opaque_bid() * 8 + wid; row0 < NTOK; row0 += stride * 4) {
    f32x4 v[4][4];
    float ss[4];
#pragma unroll
    for (int k = 0; k < 4; ++k) {
      const int row = row0 + k * stride;
      ss[k] = 0.f;
      if (row < NTOK) {
        const float* x = from_input ? (row < NCTX ? p.x_prompt + (size_t)row * 1024 : p.x_sample + (size_t)(row - NCTX) * 1024)
                                    : p.out + (size_t)row * 1024;
#pragma unroll
        for (int i = 0; i < 4; ++i) {
          v[k][i] = *(const f32x4*)(x + i * 256 + lane * 4);
          ss[k] += v[k][i][0] * v[k][i][0] + v[k][i][1] * v[k][i][1] + v[k][i][2] * v[k][i][2] + v[k][i][3] * v[k][i][3];
        }
      }
    }
#pragma unroll
    for (int d = 1; d < 64; d <<= 1) {
#pragma unroll
      for (int k = 0; k < 4; ++k) ss[k] += __shfl_xor(ss[k], d);
    }
#pragma unroll
    for (int k = 0; k < 4; ++k) {
      const int row = row0 + k * stride;
      if (row < NTOK) {
        const float* md = MODl + mod_index(row) * 6144;
        const float rstd = rsqrtf(ss[k] * (1.0f / 1024.0f) + EPS);
#pragma unroll
        for (int i = 0; i < 4; ++i) {
          const int c = i * 256 + lane * 4;
          const f32x4 g4 = *(const f32x4*)(g + c), sc = *(const f32x4*)(md + sc_off + c), sh = *(const f32x4*)(md + sh_off + c);
          float y[4];
#pragma unroll
          for (int e = 0; e < 4; ++e) y[e] = v[k][i][e] * rstd * g4[e] * (1.0f + sc[e]) + sh[e];
          u32x2 w;
          w.x = cvt_pk_bf16(y[0], y[1]);
          w.y = cvt_pk_bf16(y[2], y[3]);
          *(u32x2*)(H + (size_t)row * 1024 + c) = w;
        }
      }
    }
  }
}

__device__ __forceinline__ void rope_cs(int t, int pidx, int nfreq, float& c, float& s) {
  const int fi = pidx < nfreq ? pidx : pidx - nfreq;
  const float pos = pidx < nfreq ? (float)(t >> 6) : (float)(t & 63);
  const float freq = exp2f(-(float)fi / (float)nfreq * 13.287712379549449f);
  const float ang = pos * freq;
  sincosf(ang, &s, &c);
}

__device__ void rope_tables(f32x2* TG, f32x2* TA) {
  for (int i = opaque_bid() * 512 + opaque_tid(); i < 2048 * 48; i += opaque_gdim() * 512) {
    const int t = i / 48, j = i - t * 48;
    float c, s;
    if (j < 32) { rope_cs(t, j, 16, c, s); TG[t * 32 + j] = (f32x2){c, s}; }
    else { rope_cs(t, j - 32, 8, c, s); TA[t * 16 + (j - 32)] = (f32x2){c, s}; }
  }
}
__device__ __forceinline__ float sum8(float v) { v += __shfl_xor(v, 1); v += __shfl_xor(v, 2); v += __shfl_xor(v, 4); return v; }

__device__ void post_small(const Params& p, int l, const bf16_t* PS, bf16_t* QL, bf16_t* CKV, bf16_t* KR, bf16_t* GQ, bf16_t* GK, bf16_t* GV, const f32x2* TG) {
  const int tid_ = opaque_tid(), lane = tid_ & 63, wid = tid_ >> 6;
  const int head = lane >> 3, j8 = lane & 7;
  const float gq_scale = 0.125f * 1.4426950408889634f;
  const f32x4 gqa = *(const f32x4*)(p.g_qnorm_g + l * 64 + 4 * j8), gqb = *(const f32x4*)(p.g_qnorm_g + l * 64 + 32 + 4 * j8);
  const f32x4 gka = *(const f32x4*)(p.g_knorm_g + l * 64 + 4 * j8), gkb = *(const f32x4*)(p.g_knorm_g + l * 64 + 32 + 4 * j8);
  const f32x4 gql = *(const f32x4*)(p.a_qlora_g + l * 256 + lane * 4);
  const f32x2 gkv = *(const f32x2*)(p.a_kvlora_g + l * 128 + lane * 2);
  for (int row = opaque_bid() * 8 + wid; row < NKV; row += opaque_gdim() * 8) {
    if (row < NTOK) {
      const bf16_t* ps = PS + (size_t)row * 1216;
      const bool ctx = row < NCTX;
      const int b = ctx ? (row >> 8) : ((row - NCTX) >> 11);
      const int t = ctx ? (row & 255) : ((row - NCTX) & 2047);
      const size_t obase = (size_t)((b * 2 + l) * 256 + t);
      const u32x2 wq = *(const u32x2*)(ps + 16 + lane * 4);
      const unsigned wkv = *(const unsigned*)(ps + 272 + lane * 2);
      const u32x2 g1 = *(const u32x2*)(ps + 432 + head * 64 + 4 * j8), g2 = *(const u32x2*)(ps + 432 + head * 64 + 32 + 4 * j8);
      const int khead = (lane >> 3) & 1;
      const u32x2 k1 = *(const u32x2*)(ps + 944 + khead * 64 + 4 * j8), k2 = *(const u32x2*)(ps + 944 + khead * 64 + 32 + 4 * j8);
      f32x4 c4 = {1.f, 1.f, 1.f, 1.f}, s4 = {0.f, 0.f, 0.f, 0.f}, c4b = c4, s4b = s4;
      if (!ctx) {
        const f32x4 r0 = *(const f32x4*)(TG + t * 32 + 4 * j8), r1 = *(const f32x4*)(TG + t * 32 + 4 * j8 + 2);
        c4 = (f32x4){r0[0], r0[2], r1[0], r1[2]}; s4 = (f32x4){r0[1], r0[3], r1[1], r1[3]};
      }
      (void)c4b; (void)s4b;
      float q0 = bflo(wq.x), q1 = bfhi(wq.x), q2 = bflo(wq.y), q3 = bfhi(wq.y);
      float v0 = bflo(wkv), v1 = bfhi(wkv);
      float ssq = q0 * q0 + q1 * q1 + q2 * q2 + q3 * q3, sskv = v0 * v0 + v1 * v1;
#pragma unroll
      for (int d = 1; d < 64; d <<= 1) { ssq += __shfl_xor(ssq, d); sskv += __shfl_xor(sskv, d); }
      {
        const float rstd = rsqrtf(ssq * (1.0f / 256.0f) + EPS);
        u32x2 o;
        o.x = cvt_pk_bf16(q0 * rstd * gql[0], q1 * rstd * gql[1]);
        o.y = cvt_pk_bf16(q2 * rstd * gql[2], q3 * rstd * gql[3]);
        *(u32x2*)(QL + (size_t)row * 256 + lane * 4) = o;
      }
      {
        const float rstd = rsqrtf(sskv * (1.0f / 128.0f) + EPS);
        v0 = v0 * rstd * gkv[0]; v1 = v1 * rstd * gkv[1];
        *(unsigned*)(CKV + (size_t)row * 128 + lane * 2) = cvt_pk_bf16(v0, v1);
        if (ctx) { f32x2 o = {v0, v1}; *(f32x2*)(p.out + O_CKV + obase * 128 + lane * 2) = o; }
      }
      {
        float x1[4] = {bflo(g1.x), bfhi(g1.x), bflo(g1.y), bfhi(g1.y)}, x2[4] = {bflo(g2.x), bfhi(g2.x), bflo(g2.y), bfhi(g2.y)};
        float ss = 0.f;
#pragma unroll
        for (int e = 0; e < 4; ++e) ss += x1[e] * x1[e] + x2[e] * x2[e];
        ss = sum8(ss);
        const float rstd = rsqrtf(ss * (1.0f / 64.0f) + EPS) ;
        float y1[4], y2[4];
#pragma unroll
        for (int e = 0; e < 4; ++e) {
          const float a1 = x1[e] * rstd * gqa[e], a2 = x2[e] * rstd * gqb[e];
          y1[e] = (a1 * c4[e] - a2 * s4[e]) * gq_scale;
          y2[e] = (a1 * s4[e] + a2 * c4[e]) * gq_scale;
        }
        u32x2 o1, o2;
        o1.x = cvt_pk_bf16(y1[0], y1[1]); o1.y = cvt_pk_bf16(y1[2], y1[3]);
        o2.x = cvt_pk_bf16(y2[0], y2[1]); o2.y = cvt_pk_bf16(y2[2], y2[3]);
        *(u32x2*)(GQ + (size_t)row * 512 + head * 64 + 4 * j8) = o1;
        *(u32x2*)(GQ + (size_t)row * 512 + head * 64 + 32 + 4 * j8) = o2;
      }
      {
        float x1[4] = {bflo(k1.x), bfhi(k1.x), bflo(k1.y), bfhi(k1.y)}, x2[4] = {bflo(k2.x), bfhi(k2.x), bflo(k2.y), bfhi(k2.y)};
        float ss = 0.f;
#pragma unroll
        for (int e = 0; e < 4; ++e) ss += x1[e] * x1[e] + x2[e] * x2[e];
        ss = sum8(ss);
        const float rstd = rsqrtf(ss * (1.0f / 64.0f) + EPS);
        float y1[4], y2[4];
#pragma unroll
        for (int e = 0; e < 4; ++e) {
          const float a1 = x1[e] * rstd * gka[e], a2 = x2[e] * rstd * gkb[e];
          y1[e] = a1 * c4[e] - a2 * s4[e];
          y2[e] = a1 * s4[e] + a2 * c4[e];
        }
        if (lane < 16) {
          if (ctx) {
            *(f32x4*)(p.out + O_GK + obase * 128 + khead * 64 + 4 * j8) = (f32x4){y1[0], y1[1], y1[2], y1[3]};
            *(f32x4*)(p.out + O_GK + obase * 128 + khead * 64 + 32 + 4 * j8) = (f32x4){y2[0], y2[1], y2[2], y2[3]};
          }
          u32x2 o1, o2;
          o1.x = cvt_pk_bf16(y1[0], y1[1]); o1.y = cvt_pk_bf16(y1[2], y1[3]);
          o2.x = cvt_pk_bf16(y2[0], y2[1]); o2.y = cvt_pk_bf16(y2[2], y2[3]);
          *(u32x2*)(GK + (size_t)row * 128 + khead * 64 + 4 * j8) = o1;
          *(u32x2*)(GK + (size_t)row * 128 + khead * 64 + 32 + 4 * j8) = o2;
        }
      }
      if (lane >= 32) {
        const int e0 = (lane - 32) * 4;
        const u32x2 w = *(const u32x2*)(ps + 1072 + e0);
        *(u32x2*)(GV + (size_t)row * 128 + e0) = w;
        if (ctx) *(f32x4*)(p.out + O_GV + obase * 128 + e0) = (f32x4){bflo(w.x), bfhi(w.x), bflo(w.y), bfhi(w.y)};
      } else if (lane >= 16 && lane < 24) {
        const int e0 = (lane - 16) * 4;
        const u32x2 w = *(const u32x2*)(ps + 400 + e0);
        *(u32x2*)(KR + (size_t)row * 32 + e0) = w;
        if (ctx) *(f32x4*)(p.out + O_KR + obase * 32 + e0) = (f32x4){bflo(w.x), bfhi(w.x), bflo(w.y), bfhi(w.y)};
      }
    } else {
      const int r = row - NTOK, b = r >> 8, s = r & 255;
      const size_t cb = (size_t)((b * 2 + l) * 256 + s);
      {
        const f32x2 v = *(const f32x2*)(p.c_ckv + cb * 128 + lane * 2);
        *(unsigned*)(CKV + (size_t)row * 128 + lane * 2) = cvt_pk_bf16(v[0], v[1]);
      }
      if (lane < 32) KR[(size_t)row * 32 + lane] = f2bf(p.c_kr[cb * 32 + lane]);
      {
        const f32x2 v = *(const f32x2*)(p.c_gk + cb * 128 + lane * 2);
        *(unsigned*)(GK + (size_t)row * 128 + lane * 2) = cvt_pk_bf16(v[0], v[1]);
      }
      {
        const f32x2 v = *(const f32x2*)(p.c_gv + cb * 128 + lane * 2);
        *(unsigned*)(GV + (size_t)row * 128 + lane * 2) = cvt_pk_bf16(v[0], v[1]);
      }
    }
  }
}

__device__ __forceinline__ void mla_head_vec(bf16_t* np, bf16_t* rp_out, const u32x2 rw, const f32x4 ga, const f32x4 gb, const f32x4 gr,
                                             bool lat, int j8, const f32x4 c4, const f32x4 s4, float oscale) {
  const u32x4 nw = *(const u32x4*)np;
  float x[8] = {bflo(nw.x), bfhi(nw.x), bflo(nw.y), bfhi(nw.y), bflo(nw.z), bfhi(nw.z), bflo(nw.w), bfhi(nw.w)};
  float rr[4] = {bflo(rw.x), bfhi(rw.x), bflo(rw.y), bfhi(rw.y)};
  float ss = 0.f;
#pragma unroll
  for (int e = 0; e < 8; ++e) ss += x[e] * x[e];
#pragma unroll
  for (int e = 0; e < 4; ++e) ss += rr[e] * rr[e];
  ss = sum8(ss);
  const float rstd = rsqrtf(ss * (1.0f / 96.0f) + EPS);
#pragma unroll
  for (int e = 0; e < 4; ++e) { x[e] *= rstd * ga[e] * oscale; x[4 + e] *= rstd * gb[e] * oscale; rr[e] *= rstd * gr[e]; }
  float ro[4];
#pragma unroll
  for (int e = 0; e < 4; ++e) {
    const float other = __shfl_xor(rr[e], 4);
    ro[e] = rr[e];
    if (lat) ro[e] = (j8 < 4) ? (rr[e] * c4[e] - other * s4[e]) : (other * s4[e] + rr[e] * c4[e]);
    ro[e] *= oscale;
  }
  u32x4 ow;
  ow.x = cvt_pk_bf16(x[0], x[1]); ow.y = cvt_pk_bf16(x[2], x[3]); ow.z = cvt_pk_bf16(x[4], x[5]); ow.w = cvt_pk_bf16(x[6], x[7]);
  *(u32x4*)np = ow;
  u32x2 orw;
  orw.x = cvt_pk_bf16(ro[0], ro[1]); orw.y = cvt_pk_bf16(ro[2], ro[3]);
  *(u32x2*)rp_out = orw;
}
__device__ void post_mla(const Params& p, int l, bf16_t* QA, bf16_t* KAV, const bf16_t* KR, const f32x2* TA) {
  const int tid_ = opaque_tid(), lane = tid_ & 63, wid = tid_ >> 6;
  const int head = lane >> 3, j8 = lane & 7;
  const float q_scale = 0.10206207261596577f * 1.4426950408889634f;
  const f32x4 gka = *(const f32x4*)(p.a_knorm_g + l * 96 + 8 * j8), gkb = *(const f32x4*)(p.a_knorm_g + l * 96 + 8 * j8 + 4), gkr = *(const f32x4*)(p.a_knorm_g + l * 96 + 64 + 4 * j8);
  const f32x4 gqa = *(const f32x4*)(p.a_qnorm_g + l * 96 + 8 * j8), gqb = *(const f32x4*)(p.a_qnorm_g + l * 96 + 8 * j8 + 4), gqr = *(const f32x4*)(p.a_qnorm_g + l * 96 + 64 + 4 * j8);
  for (int row = opaque_bid() * 8 + wid; row < NKV; row += opaque_gdim() * 8) {
    const bool lat = (row >= NCTX) && (row < NTOK);
    const int t = (row - NCTX) & 2047;
    f32x4 c4 = {1.f, 1.f, 1.f, 1.f}, s4 = {0.f, 0.f, 0.f, 0.f};
    if (lat) {
      const f32x4 r0 = *(const f32x4*)(TA + t * 16 + 4 * (j8 & 3)), r1 = *(const f32x4*)(TA + t * 16 + 4 * (j8 & 3) + 2);
      c4 = (f32x4){r0[0], r0[2], r1[0], r1[2]}; s4 = (f32x4){r0[1], r0[3], r1[1], r1[3]};
    }
    {
      bf16_t* kp = KAV + (size_t)row * 1280 + head * 160;
      const u32x2 rw = *(const u32x2*)(KR + (size_t)row * 32 + 4 * j8);
      mla_head_vec(kp + 8 * j8, kp + 64 + 4 * j8, rw, gka, gkb, gkr, lat, j8, c4, s4, 1.0f);
    }
    if (row < NTOK) {
      bf16_t* qp = QA + (size_t)row * 768 + head * 96;
      const u32x2 rw = *(const u32x2*)(qp + 64 + 4 * j8);
      mla_head_vec(qp + 8 * j8, qp + 64 + 4 * j8, rw, gqa, gqb, gqr, lat, j8, c4, s4, q_scale);
    }
  }
}

__device__ void post_mlstm(const Params& p, int l, bf16_t* HF, const bf16_t* HB, const bf16_t* PM) {
  const int tid_ = opaque_tid(), lane = tid_ & 63, wid = tid_ >> 6;
  const int head = lane >> 4, j16 = lane & 15;
  const f32x4 ga = *(const f32x4*)(p.m_norm_g + l * 128 + 8 * j16), gb = *(const f32x4*)(p.m_norm_g + l * 128 + 8 * j16 + 4);
  for (int row = opaque_bid() * 8 + wid; row < NTOK; row += opaque_gdim() * 8) {
    const u32x4 wf = *(const u32x4*)(HF + (size_t)row * 512 + head * 128 + 8 * j16);
    const u32x4 wb = *(const u32x4*)(HB + (size_t)row * 512 + head * 128 + 8 * j16);
    const u32x4 wo = *(const u32x4*)(PM + (size_t)row * 2048 + 1536 + head * 128 + 8 * j16);
    float v[8] = {bflo(wf.x) + bflo(wb.x), bfhi(wf.x) + bfhi(wb.x), bflo(wf.y) + bflo(wb.y), bfhi(wf.y) + bfhi(wb.y),
                  bflo(wf.z) + bflo(wb.z), bfhi(wf.z) + bfhi(wb.z), bflo(wf.w) + bflo(wb.w), bfhi(wf.w) + bfhi(wb.w)};
    const float mo[8] = {bflo(wo.x), bfhi(wo.x), bflo(wo.y), bfhi(wo.y), bflo(wo.z), bfhi(wo.z), bflo(wo.w), bfhi(wo.w)};
    float ss = 0.f;
#pragma unroll
    for (int e = 0; e < 8; ++e) ss += v[e] * v[e];
    ss = sum8(ss);
    ss += __shfl_xor(ss, 8);
    const float rstd = rsqrtf(ss * (1.0f / 128.0f) + EPS);
#pragma unroll
    for (int e = 0; e < 4; ++e) { v[e] = v[e] * rstd * ga[e] * sigmoidf_(mo[e]); v[4 + e] = v[4 + e] * rstd * gb[e] * sigmoidf_(mo[4 + e]); }
    u32x4 o;
    o.x = cvt_pk_bf16(v[0], v[1]); o.y = cvt_pk_bf16(v[2], v[3]); o.z = cvt_pk_bf16(v[4], v[5]); o.w = cvt_pk_bf16(v[6], v[7]);
    *(u32x4*)(HF + (size_t)row * 512 + head * 128 + 8 * j16) = o;
  }
}

template <int DQK>
__device__ __forceinline__ void attn_item(const bf16_t* qptr, bf16_t* optr, const bf16_t* Kb, int kstride, const bf16_t* Vb, int vstride,
                                          int seg0_row, int seg0_tiles, int seg1_row, int ntiles, bf16_t* lds, bool nostore = false) {
  constexpr int KSTR = DQK + 8, KT_EL = 64 * KSTR, VT_EL = 64 * 72, NKK = DQK / 16, KCH = DQK / 8;
  const int tid = opaque_tid(), lane = tid & 63, h2 = lane >> 5, r = lane & 31;
  bf16_t* const sKb = lds;
  bf16_t* const sVb = lds + 2 * KT_EL;
  bf16x8 qf[NKK];
#pragma unroll
  for (int kk = 0; kk < NKK; ++kk) qf[kk] = *(const bf16x8*)(qptr + kk * 16 + h2 * 8);
  f32x16 o0, o1;
#pragma unroll
  for (int i = 0; i < 16; ++i) { o0[i] = 0.f; o1[i] = 0.f; }
  float m_run = -1e30f, l_run = 0.f;
  const int key0 = tid / KCH, c0 = tid - key0 * KCH;
  const int id1 = tid + 512, key1 = id1 / KCH, c1 = id1 - key1 * KCH;
  const bool has1 = (DQK == 96) && (tid < 256);
  const int vkey = tid & 63, vc = tid >> 6;
  const int vpos = (vkey & ~12) | ((vkey & 4) << 1) | ((vkey & 8) >> 1);
  u32x4 kr0, kr1 = {0u, 0u, 0u, 0u}, vr;
#define ATTN_ROW0(j) (((j) < seg0_tiles) ? seg0_row + (j) * 64 : seg1_row + ((j) - seg0_tiles) * 64)
#define ATTN_LOADK(j)                                                                        \
  {                                                                                          \
    const int row0_ = ATTN_ROW0(j);                                                          \
    kr0 = *(const u32x4*)(Kb + (size_t)(row0_ + key0) * kstride + c0 * 8);                   \
    if (has1) kr1 = *(const u32x4*)(Kb + (size_t)(row0_ + key1) * kstride + c1 * 8);        \
  }
#define ATTN_LOADV(j) { const int row0_ = ATTN_ROW0(j); vr = *(const u32x4*)(Vb + (size_t)(row0_ + vkey) * vstride + vc * 8); }
#define ATTN_STOREK(buf)                                                                     \
  {                                                                                          \
    bf16_t* sK_ = sKb + (buf) * KT_EL;                                                       \
    *(u32x4*)(sK_ + key0 * KSTR + c0 * 8) = kr0;                                             \
    if (has1) *(u32x4*)(sK_ + key1 * KSTR + c1 * 8) = kr1;                                   \
  }
#define ATTN_STOREV(buf)                                                                     \
  {                                                                                          \
    bf16_t* sV_ = sVb + (buf) * VT_EL;                                                       \
    sV_[(vc * 8 + 0) * 72 + vpos] = (bf16_t)(vr.x & 0xffffu);                                \
    sV_[(vc * 8 + 1) * 72 + vpos] = (bf16_t)(vr.x >> 16);                                    \
    sV_[(vc * 8 + 2) * 72 + vpos] = (bf16_t)(vr.y & 0xffffu);                                \
    sV_[(vc * 8 + 3) * 72 + vpos] = (bf16_t)(vr.y >> 16);                                    \
    sV_[(vc * 8 + 4) * 72 + vpos] = (bf16_t)(vr.z & 0xffffu);                                \
    sV_[(vc * 8 + 5) * 72 + vpos] = (bf16_t)(vr.z >> 16);                                    \
    sV_[(vc * 8 + 6) * 72 + vpos] = (bf16_t)(vr.w & 0xffffu);                                \
    sV_[(vc * 8 + 7) * 72 + vpos] = (bf16_t)(vr.w >> 16);                                    \
  }
#define ATTN_QK(dst0, dst1, buf)                                                             \
  {                                                                                          \
    const bf16_t* sK_ = sKb + (buf) * KT_EL;                                                 \
    _Pragma("unroll") for (int i = 0; i < 16; ++i) { dst0[i] = 0.f; dst1[i] = 0.f; }         \
    __builtin_amdgcn_s_setprio(1);                                                           \
    bf16x8 ka0_[NKK], ka1_[NKK];     \
    _Pragma("unroll") for (int kk = 0; kk < NKK; ++kk) {                                     \
      ka0_[kk] = *(const bf16x8*)(sK_ + r * KSTR + kk * 16 + h2 * 8);                        \
      ka1_[kk] = *(const bf16x8*)(sK_ + (32 + r) * KSTR + kk * 16 + h2 * 8);                 \
    }                                                                                        \
    __builtin_amdgcn_sched_barrier(0);         \
    _Pragma("unroll") for (int kk = 0; kk < NKK; ++kk) {                                     \
      dst0 = __builtin_amdgcn_mfma_f32_32x32x16_bf16(ka0_[kk], qf[kk], dst0, 0, 0, 0);       \
      dst1 = __builtin_amdgcn_mfma_f32_32x32x16_bf16(ka1_[kk], qf[kk], dst1, 0, 0, 0);       \
    }                                                                                        \
    __builtin_amdgcn_s_setprio(0);                                                           \
  }
  ATTN_LOADK(0); ATTN_LOADV(0);
  ATTN_STOREK(0); ATTN_STOREV(0);
  ATTN_LOADK(1);
  ATTN_STOREK(1);
  lds_barrier();
  f32x16 s0, s1;
  ATTN_QK(s0, s1, 0);
  lds_barrier();
  for (int j = 0; j < ntiles; ++j) {
    const int cur = j & 1;
    if (j + 1 < ntiles) ATTN_LOADV(j + 1);
    if (j + 2 < ntiles) ATTN_LOADK(j + 2);
    f32x16 n0, n1;
    if (j + 1 < ntiles) { ATTN_QK(n0, n1, cur ^ 1); }
    else {
#pragma unroll
      for (int i = 0; i < 16; ++i) { n0[i] = 0.f; n1[i] = 0.f; }
    }
    const bf16_t* sV = sVb + cur * VT_EL;
    {
      float mx = fmaxf(s0[0], s1[0]);
#pragma unroll
      for (int i = 1; i < 16; ++i) mx = fmaxf(mx, fmaxf(s0[i], s1[i]));
      mx = cross_half_max(mx);
      if (__any(mx > m_run + 11.5f)) {
        const float m_new = fmaxf(m_run, mx);
        const float alpha = __builtin_amdgcn_exp2f(m_run - m_new);
        l_run *= alpha;
#pragma unroll
        for (int i = 0; i < 16; ++i) { o0[i] *= alpha; o1[i] *= alpha; }
        m_run = m_new;
      }
      float ls = 0.f;
#pragma unroll
      for (int i = 0; i < 16; ++i) {
        s0[i] = __builtin_amdgcn_exp2f(s0[i] - m_run);
        s1[i] = __builtin_amdgcn_exp2f(s1[i] - m_run);
        ls += s0[i] + s1[i];
      }
      l_run += ls;
      u32x4 pa, pb, pc, pd;
      pa.x = cvt_pk_bf16(s0[0], s0[1]); pa.y = cvt_pk_bf16(s0[2], s0[3]); pa.z = cvt_pk_bf16(s0[4], s0[5]); pa.w = cvt_pk_bf16(s0[6], s0[7]);
      pb.x = cvt_pk_bf16(s0[8], s0[9]); pb.y = cvt_pk_bf16(s0[10], s0[11]); pb.z = cvt_pk_bf16(s0[12], s0[13]); pb.w = cvt_pk_bf16(s0[14], s0[15]);
      pc.x = cvt_pk_bf16(s1[0], s1[1]); pc.y = cvt_pk_bf16(s1[2], s1[3]); pc.z = cvt_pk_bf16(s1[4], s1[5]); pc.w = cvt_pk_bf16(s1[6], s1[7]);
      pd.x = cvt_pk_bf16(s1[8], s1[9]); pd.y = cvt_pk_bf16(s1[10], s1[11]); pd.z = cvt_pk_bf16(s1[12], s1[13]); pd.w = cvt_pk_bf16(s1[14], s1[15]);
      const bf16x8 pf[4] = {__builtin_bit_cast(bf16x8, pa), __builtin_bit_cast(bf16x8, pb), __builtin_bit_cast(bf16x8, pc), __builtin_bit_cast(bf16x8, pd)};
      bf16x8 vf0[4], vf1[4];
#pragma unroll
      for (int q = 0; q < 4; ++q) {
        vf0[q] = *(const bf16x8*)(sV + r * 72 + q * 16 + h2 * 8);
        vf1[q] = *(const bf16x8*)(sV + (32 + r) * 72 + q * 16 + h2 * 8);
      }
      __builtin_amdgcn_sched_barrier(0);
#pragma unroll
      for (int q = 0; q < 4; ++q) {
        o0 = __builtin_amdgcn_mfma_f32_32x32x16_bf16(vf0[q], pf[q], o0, 0, 0, 0);
        o1 = __builtin_amdgcn_mfma_f32_32x32x16_bf16(vf1[q], pf[q], o1, 0, 0, 0);
      }
    }
    if (j + 1 < ntiles) ATTN_STOREV(cur ^ 1);
    if (j + 2 < ntiles) ATTN_STOREK(cur);
    lds_barrier();
    s0 = n0; s1 = n1;
  }
#undef ATTN_ROW0
#undef ATTN_LOADK
#undef ATTN_LOADV
#undef ATTN_STOREK
#undef ATTN_STOREV
#undef ATTN_QK
  const float l_tot = l_run + __shfl_xor(l_run, 32);
  const float inv = 1.0f / l_tot;
  if (nostore && inv != 12345.f) return;
#pragma unroll
  for (int g = 0; g < 4; ++g) {
    u32x2 w0, w1;
    w0.x = cvt_pk_bf16(o0[4 * g] * inv, o0[4 * g + 1] * inv);
    w0.y = cvt_pk_bf16(o0[4 * g + 2] * inv, o0[4 * g + 3] * inv);
    w1.x = cvt_pk_bf16(o1[4 * g] * inv, o1[4 * g + 1] * inv);
    w1.y = cvt_pk_bf16(o1[4 * g + 2] * inv, o1[4 * g + 3] * inv);
    *(u32x2*)(optr + 8 * g + 4 * h2) = w0;
    *(u32x2*)(optr + 32 + 8 * g + 4 * h2) = w1;
  }
}

__device__ void mlstm_chain(const Params& p, int l, bool lat, int b, int h, int dir, const bf16_t* PM, const float* G, bf16_t* Hout, bf16_t* lds) {
  const int tid = opaque_tid(), lane = tid & 63, wid = tid >> 6, h2 = lane >> 5, r = lane & 31;
  const int T = lat ? 2048 : 256, base_row = lat ? NCTX + b * 2048 : b * 256, nc = T >> 6;
  const float kscale = 0.08838834764831845f;
  bf16_t* Qs = lds;
  bf16_t* Ks = Qs + 64 * 136;
  bf16_t* KwT = Ks + 64 * 136;
  bf16_t* VT = KwT + 128 * 72;
  bf16_t* CT = VT + 128 * 72;
  bf16_t* Ss = CT + 128 * 136;
  float* F = (float*)(Ss + 64 * 72);
  float* qnv = F + 768; float* hdv = F + 832; float* nvec = F + 896;
  const int dkt = wid >> 1, dvt0 = (wid & 1) * 2;
  const int lt = wid >> 2, dvt = wid & 3;
  f32x16 accC[2];
  float m_state = 0.f;
  const size_t sidx = (size_t)(((b * 2 + l) * 2 + dir) * 4 + h);
  if (lat) {
#pragma unroll
    for (int i = 0; i < 2; ++i)
#pragma unroll
      for (int rg = 0; rg < 16; ++rg)
        accC[i][rg] = p.st_C[sidx * 16384 + (size_t)(dkt * 32 + rowof(rg, h2)) * 128 + (dvt0 + i) * 32 + r];
    asm volatile("" ::: "memory");
    if (tid < 128) nvec[tid] = p.st_n[sidx * 128 + tid];
    m_state = p.st_m[sidx];
  } else {
#pragma unroll
    for (int i = 0; i < 2; ++i)
#pragma unroll
      for (int rg = 0; rg < 16; ++rg) accC[i][rg] = 0.f;
    if (tid < 128) nvec[tid] = 0.f;
  }
#pragma unroll
  for (int i = 0; i < 2; ++i)
#pragma unroll
    for (int g = 0; g < 4; ++g) {
      u32x2 w;
      w.x = cvt_pk_bf16(accC[i][4 * g], accC[i][4 * g + 1]);
      w.y = cvt_pk_bf16(accC[i][4 * g + 2], accC[i][4 * g + 3]);
      *(u32x2*)(CT + ((dvt0 + i) * 32 + r) * 136 + dkt * 32 + 8 * g + 4 * h2) = w;
    }
  const int j0 = tid >> 4, cc = tid & 15;
  const int vj = tid & 63, vc8 = tid >> 6;
  u32x4 rq[2], rk[2], rv[2];
  float gi = 0.f, gf = 0.f;
#define MLSTM_ROW(c, j) (base_row + (dir ? (T - 1 - ((c) * 64 + (j))) : ((c) * 64 + (j))))
  const int rstep = dir ? -64 : 64;
  const bf16_t* pq0 = PM + (size_t)MLSTM_ROW(0, j0) * 2048 + h * 128 + cc * 8;
  const bf16_t* pq1 = PM + (size_t)MLSTM_ROW(0, j0 + 32) * 2048 + h * 128 + cc * 8;
  const bf16_t* pv0 = PM + (size_t)MLSTM_ROW(0, vj) * 2048 + 1024 + h * 128 + vc8 * 8;
  const float* pgt = G + (size_t)MLSTM_ROW(0, lane) * 16 + (2 * dir) * 4 + h;
  const long cstride = (long)rstep * 2048;
  const int sgn = dir ? -1 : 1;
  bf16_t* const ph0 = Hout + (size_t)MLSTM_ROW(0, lt * 32 + 4 * h2) * 512 + h * 128 + dvt * 32 + r;
#define MLSTM_LOAD(c)                                                                     \
  {                                                                                       \
    const long co_ = (long)(c) * cstride;                                                 \
    rq[0] = *(const u32x4*)(pq0 + co_); rk[0] = *(const u32x4*)(pq0 + co_ + 512);         \
    rq[1] = *(const u32x4*)(pq1 + co_); rk[1] = *(const u32x4*)(pq1 + co_ + 512);         \
    rv[0] = *(const u32x4*)(pv0 + co_); rv[1] = *(const u32x4*)(pv0 + co_ + 64);          \
  }
#define MLSTM_GATES(c)                                                                    \
  if (wid == 7) {                                                                         \
    const float* gp_ = pgt + (long)(c) * (rstep * 16);                                    \
    gi = gp_[0];                                                                          \
    gf = gp_[4];                                                                          \
  }
#define MLSTM_SCAL(par)                                                                   \
  if (wid == 7) {                                                                         \
    float* Fp = F + (par) * 384;                                                          \
    const float iv = gi;                                                                  \
    float bc = fminf(gf, 0.f) - log1pf(__expf(-fabsf(gf)));                               \
    _Pragma("unroll") for (int d = 1; d < 64; d <<= 1) { const float tt = __shfl_up(bc, d); if (lane >= d) bc += tt; } \
    const float a = iv - bc;                                                              \
    float pm = a;                                                                         \
    _Pragma("unroll") for (int d = 1; d < 64; d <<= 1) { const float tt = __shfl_up(pm, d); if (lane >= d) pm = fmaxf(pm, tt); } \
    const float mt = bc + fmaxf(m_state, pm);                                             \
    const float tot = __shfl(bc, 63);                                                     \
    const float gg = tot + a;                                                             \
    const float gmax = wave_max(gg);                                                      \
    const float total = tot + m_state;                                                    \
    const float m_new = fmaxf(total, gmax);                                               \
    Fp[lane] = bc - mt;                                                           \
    Fp[64 + lane] = a;                                                             \
    Fp[128 + lane] = mt;                                                          \
    Fp[192 + lane] = __expf(bc + m_state - mt);                                  \
    Fp[256 + lane] = __expf(gg - m_new) * kscale;                                \
    if (lane == 0) Fp[320] = __expf(total - m_new);                             \
    m_state = m_new;                                                                      \
  }
  MLSTM_LOAD(0);
  MLSTM_GATES(0);
  MLSTM_SCAL(0);
  if (nc > 1) MLSTM_GATES(1);
  for (int c = 0; c < nc; ++c) {
#pragma unroll
    for (int i = 0; i < 2; ++i) {
      const int j = j0 + 32 * i;
      *(u32x4*)(Qs + j * 136 + cc * 8) = rq[i];
      *(u32x4*)(Ks + j * 136 + cc * 8) = rk[i];
      const int vr0 = (vc8 + 8 * i) * 8;
      VT[(vr0 + 0) * 72 + vj] = (bf16_t)(rv[i].x & 0xffffu);
      VT[(vr0 + 1) * 72 + vj] = (bf16_t)(rv[i].x >> 16);
      VT[(vr0 + 2) * 72 + vj] = (bf16_t)(rv[i].y & 0xffffu);
      VT[(vr0 + 3) * 72 + vj] = (bf16_t)(rv[i].y >> 16);
      VT[(vr0 + 4) * 72 + vj] = (bf16_t)(rv[i].z & 0xffffu);
      VT[(vr0 + 5) * 72 + vj] = (bf16_t)(rv[i].z >> 16);
      VT[(vr0 + 6) * 72 + vj] = (bf16_t)(rv[i].w & 0xffffu);
      VT[(vr0 + 7) * 72 + vj] = (bf16_t)(rv[i].w >> 16);
    }
    lds_barrier();
    const float* e1v = F + (c & 1) * 384; const float* av = e1v + 64; const float* mtv = e1v + 128;
    const float* winv = e1v + 192; const float* wgkv = e1v + 256; const float* scal = e1v + 320;
    if (c + 1 < nc) MLSTM_LOAD(c + 1);
    if (c + 1 < nc) { MLSTM_SCAL((c + 1) & 1); if (c + 2 < nc) MLSTM_GATES(c + 2); }
    {
      const int j = tid & 63;
      const float wk = wgkv[j];
#pragma unroll
      for (int i = 0; i < 2; ++i) {
        const int dkb = (tid >> 6) * 8 + 64 * i;
        const u32x4 w = *(const u32x4*)(Ks + j * 136 + dkb);
        KwT[(dkb + 0) * 72 + j] = f2bf(bflo(w.x) * wk);
        KwT[(dkb + 1) * 72 + j] = f2bf(bfhi(w.x) * wk);
        KwT[(dkb + 2) * 72 + j] = f2bf(bflo(w.y) * wk);
        KwT[(dkb + 3) * 72 + j] = f2bf(bfhi(w.y) * wk);
        KwT[(dkb + 4) * 72 + j] = f2bf(bflo(w.z) * wk);
        KwT[(dkb + 5) * 72 + j] = f2bf(bfhi(w.z) * wk);
        KwT[(dkb + 6) * 72 + j] = f2bf(bflo(w.w) * wk);
        KwT[(dkb + 7) * 72 + j] = f2bf(bfhi(w.w) * wk);
      }
    }
    f32x16 acc;
#pragma unroll
    for (int i = 0; i < 16; ++i) acc[i] = 0.f;
    const bf16_t* qcA = Qs + (lt * 32 + r) * 136 + h2 * 8;
    const bf16_t* qcB = CT + (dvt * 32 + r) * 136 + h2 * 8;
    if (wid < 4) {
      const int lt2 = wid >> 1, st = wid & 1;
      const bf16_t* sA = Qs + (lt2 * 32 + r) * 136 + h2 * 8;
      const bf16_t* sB = Ks + (st * 32 + r) * 136 + h2 * 8;
      f32x16 sacc;
#pragma unroll
      for (int i = 0; i < 16; ++i) sacc[i] = 0.f;
#pragma unroll
      for (int kb = 0; kb < 4; ++kb) {
        bf16x8 fa[2], fb[2], ga[2], gb[2];
#pragma unroll
        for (int u = 0; u < 2; ++u) {
          fa[u] = *(const bf16x8*)(sA + (2 * kb + u) * 16); fb[u] = *(const bf16x8*)(sB + (2 * kb + u) * 16);
          ga[u] = *(const bf16x8*)(qcA + (2 * kb + u) * 16); gb[u] = *(const bf16x8*)(qcB + (2 * kb + u) * 16);
        }
        __builtin_amdgcn_sched_barrier(0);
#pragma unroll
        for (int u = 0; u < 2; ++u) {
          sacc = __builtin_amdgcn_mfma_f32_32x32x16_bf16(fa[u], fb[u], sacc, 0, 0, 0);
          acc = __builtin_amdgcn_mfma_f32_32x32x16_bf16(ga[u], gb[u], acc, 0, 0, 0);
        }
      }
      const int scol = st * 32 + r;
      const float as = av[scol];
      float ev[16];
#pragma unroll
      for (int rg = 0; rg < 16; ++rg) ev[rg] = e1v[lt2 * 32 + rowof(rg, h2)];
#pragma unroll
      for (int rg = 0; rg < 16; ++rg) {
        const int lrow = lt2 * 32 + rowof(rg, h2);
        const float ex = (scol <= lrow) ? (ev[rg] + as) * 1.4426950408889634f : -__builtin_inff();
        const float val = sacc[rg] * kscale * __builtin_amdgcn_exp2f(ex);
        Ss[lrow * 72 + scol] = f2bf(val);
      }
    } else {
#pragma unroll
      for (int kb = 0; kb < 2; ++kb) {
        bf16x8 ga[4], gb[4];
#pragma unroll
        for (int u = 0; u < 4; ++u) { ga[u] = *(const bf16x8*)(qcA + (4 * kb + u) * 16); gb[u] = *(const bf16x8*)(qcB + (4 * kb + u) * 16); }
        __builtin_amdgcn_sched_barrier(0);
#pragma unroll
        for (int u = 0; u < 4; ++u) acc = __builtin_amdgcn_mfma_f32_32x32x16_bf16(ga[u], gb[u], acc, 0, 0, 0);
      }
    }
#pragma unroll
    for (int rg = 0; rg < 16; ++rg) acc[rg] *= winv[lt * 32 + rowof(rg, h2)];
    {
      const int lq = tid >> 3, part = tid & 7;
      float sq = 0.f;
#pragma unroll
      for (int e4 = 0; e4 < 2; ++e4) {
        const u32x4 qw = *(const u32x4*)(Qs + lq * 136 + part * 16 + e4 * 8);
        const f32x4 n0 = *(const f32x4*)(nvec + part * 16 + e4 * 8), n1 = *(const f32x4*)(nvec + part * 16 + e4 * 8 + 4);
        sq += bflo(qw.x) * n0[0] + bfhi(qw.x) * n0[1] + bflo(qw.y) * n0[2] + bfhi(qw.y) * n0[3];
        sq += bflo(qw.z) * n1[0] + bfhi(qw.z) * n1[1] + bflo(qw.w) * n1[2] + bfhi(qw.w) * n1[3];
      }
      sq += __shfl_xor(sq, 1); sq += __shfl_xor(sq, 2); sq += __shfl_xor(sq, 4);
      if (part == 0) qnv[lq] = sq;
    }
    lds_barrier();
    {
      bf16x8 sa[4], sb[4];
#pragma unroll
      for (int ks = 0; ks < 4; ++ks) {
        sa[ks] = *(const bf16x8*)(Ss + (lt * 32 + r) * 72 + ks * 16 + h2 * 8);
        sb[ks] = *(const bf16x8*)(VT + (dvt * 32 + r) * 72 + ks * 16 + h2 * 8);
      }
      __builtin_amdgcn_sched_barrier(0);
#pragma unroll
      for (int ks = 0; ks < 4; ++ks) acc = __builtin_amdgcn_mfma_f32_32x32x16_bf16(sa[ks], sb[ks], acc, 0, 0, 0);
    }
    {
      const int lq = tid >> 3, part = tid & 7;
      const u32x4 sw = *(const u32x4*)(Ss + lq * 72 + part * 8);
      float rs = (bflo(sw.x) + bfhi(sw.x)) + (bflo(sw.y) + bfhi(sw.y)) + (bflo(sw.z) + bfhi(sw.z)) + (bflo(sw.w) + bfhi(sw.w));
      rs += __shfl_xor(rs, 1); rs += __shfl_xor(rs, 2); rs += __shfl_xor(rs, 4);
      if (part == 0) {
        const float den = qnv[lq] * winv[lq] + rs;
        hdv[lq] = 1.0f / fmaxf(fabsf(den), __expf(-mtv[lq]));
      }
    }
    {
      const float decay = scal[0];
      bf16x8 ka[4], kv0[4], kv1[4];
#pragma unroll
      for (int ks = 0; ks < 4; ++ks) {
        ka[ks] = *(const bf16x8*)(KwT + (dkt * 32 + r) * 72 + ks * 16 + h2 * 8);
        kv0[ks] = *(const bf16x8*)(VT + (dvt0 * 32 + r) * 72 + ks * 16 + h2 * 8);
        kv1[ks] = *(const bf16x8*)(VT + ((dvt0 + 1) * 32 + r) * 72 + ks * 16 + h2 * 8);
      }
      __builtin_amdgcn_sched_barrier(0);
#pragma unroll
      for (int rg = 0; rg < 16; ++rg) { accC[0][rg] *= decay; accC[1][rg] *= decay; }
#pragma unroll
      for (int ks = 0; ks < 4; ++ks) {
        accC[0] = __builtin_amdgcn_mfma_f32_32x32x16_bf16(ka[ks], kv0[ks], accC[0], 0, 0, 0);
        accC[1] = __builtin_amdgcn_mfma_f32_32x32x16_bf16(ka[ks], kv1[ks], accC[1], 0, 0, 0);
      }
#pragma unroll
      for (int i = 0; i < 2; ++i) {
#pragma unroll
        for (int g = 0; g < 4; ++g) {
          u32x2 w;
          w.x = cvt_pk_bf16(accC[i][4 * g], accC[i][4 * g + 1]);
          w.y = cvt_pk_bf16(accC[i][4 * g + 2], accC[i][4 * g + 3]);
          *(u32x2*)(CT + ((dvt0 + i) * 32 + r) * 136 + dkt * 32 + 8 * g + 4 * h2) = w;
        }
      }
      {
        const int ndk = tid >> 2, npart = tid & 3;
        const u32x4 k0 = *(const u32x4*)(KwT + ndk * 72 + npart * 16), k1 = *(const u32x4*)(KwT + ndk * 72 + npart * 16 + 8);
        float sn = (bflo(k0.x) + bfhi(k0.x)) + (bflo(k0.y) + bfhi(k0.y)) + (bflo(k0.z) + bfhi(k0.z)) + (bflo(k0.w) + bfhi(k0.w));
        sn += (bflo(k1.x) + bfhi(k1.x)) + (bflo(k1.y) + bfhi(k1.y)) + (bflo(k1.z) + bfhi(k1.z)) + (bflo(k1.w) + bfhi(k1.w));
        sn += __shfl_xor(sn, 1); sn += __shfl_xor(sn, 2);
        if (npart == 0) nvec[ndk] = nvec[ndk] * decay + sn;
      }
    }
    lds_barrier();
    {
      bf16_t* const phc = ph0 + (long)c * (rstep * 512);
#pragma unroll
      for (int rg = 0; rg < 16; ++rg) {
        const int lrow = lt * 32 + rowof(rg, h2);
        phc[sgn * (((rg & 3) + 8 * (rg >> 2)) * 512)] = f2bf(acc[rg] * hdv[lrow]);
      }
    }
  }
#undef MLSTM_LOAD
#undef MLSTM_GATES
#undef MLSTM_SCAL
#undef MLSTM_ROW
  if (!lat) {
#pragma unroll
    for (int i = 0; i < 2; ++i)
#pragma unroll
      for (int rg = 0; rg < 16; ++rg)
        p.out[O_C + sidx * 16384 + (size_t)(dkt * 32 + rowof(rg, h2)) * 128 + (dvt0 + i) * 32 + r] = accC[i][rg];
    if (tid < 128) p.out[O_N + sidx * 128 + tid] = nvec[tid];
    if (tid == 448) p.out[O_M + sidx] = m_state;
  }
  __syncthreads();
}

__device__ void mixers_phase(const Params& p, int l, unsigned* counter, const bf16_t* PM, const float* G, bf16_t* HF, bf16_t* HB,
                             bf16_t* QA, bf16_t* YA, const bf16_t* KAV, bf16_t* GQ, const bf16_t* GK, const bf16_t* GV, bf16_t* lds, int item_limit, int item_first = 0, bool nostore = false) {
  const int tid = opaque_tid(), lane = tid & 63, wid = tid >> 6, r = lane & 31;
  int* slot = (int*)((unsigned char*)lds + 130048);
#ifndef STATIC_SCHED
#define STATIC_SCHED 0
#endif
  for (int it_ = 0;; ++it_) {
#if STATIC_SCHED
    const int item = opaque_bid() + it_ * opaque_gdim();
    (void)slot; (void)counter;
#else
    if (tid == 0) *slot = (int)atomicAdd(counter, 1u);
    __syncthreads();
    int item = *slot;
    __syncthreads();
#endif
    item += item_first;
    if (item >= item_limit) break;
    if (item < 64) {
#if MIXSEL & 1
      const bool lat = item < 32;
      const int nch = lat ? 1 : 8, ch0 = lat ? item : (item - 32) * 8;
      for (int q = 0; q < nch; ++q) {
        const int ch = ch0 + q;
        const int dir = ch & 1, h = (ch >> 1) & 3, b = ch >> 3;
        mlstm_chain(p, l, lat, b, h, dir, PM, G, dir ? HB : HF, lds);
      }
#endif
    } else if (item < 320 || (item >= 576 && item < 832)) {
#if MIXSEL & 2
      const bool lat = item < 320;
      const int i = lat ? item - 64 : item - 576;
      const int b = lat ? (i >> 6) : (i >> 3), h = lat ? ((i >> 3) & 7) : (i & 7), qt = lat ? (i & 7) : 0;
      const int own0 = lat ? NCTX + b * 2048 : b * 256;
      const int qrow = own0 + qt * 256 + wid * 32 + r;
      bf16_t* qp = QA + (size_t)qrow * 768 + h * 96;
      attn_item<96>(qp, YA + (size_t)qrow * 512 + h * 64, KAV + h * 160, 1280, KAV + h * 160 + 96, 1280, NTOK + b * 256, lat ? 4 : 0, own0, lat ? 36 : 4, lds, nostore);
#endif
    } else {
#if MIXSEL & 4
      const bool lat = item < 576;
      const int i = lat ? item - 320 : item - 832;
      const int b = lat ? (i >> 6) : (i >> 3), kvh = lat ? ((i >> 5) & 1) : ((i >> 2) & 1), tile = lat ? (i & 31) : (i & 3);
      const int own0 = lat ? NCTX + b * 2048 : b * 256;
      const int head = kvh * 4 + (wid >> 1);
      const int qrow = own0 + tile * 64 + (wid & 1) * 32 + r;
      bf16_t* qp = GQ + (size_t)qrow * 512 + head * 64;
      attn_item<64>(qp, qp, GK + kvh * 64, 128, GV + kvh * 64, 128, NTOK + b * 256, lat ? 4 : 0, own0, lat ? 36 : 4, lds, nostore);
#endif
    }
  }
}

#define XB_TMO      128
#define XB_XCNT(j)  (256  + 64 * (j))
#define XB_XSUB(j)  (1280 + 64 * (j))
#define XB_XGEN(j)  (2304 + 64 * (j))
#define XB_TOP      3328
#define XB_TOPGEN   3392
#define XCD_BAR_WORDS 3456
#define XB_SPIN_CAP (1u << 18)
#define XLAS __attribute__((address_space(3)))

__device__ __forceinline__ unsigned xb_ld(unsigned* p)              { return __hip_atomic_load(p, __ATOMIC_RELAXED, __HIP_MEMORY_SCOPE_AGENT); }
__device__ __forceinline__ unsigned xb_add(unsigned* p, unsigned v) { return __hip_atomic_fetch_add(p, v, __ATOMIC_RELAXED, __HIP_MEMORY_SCOPE_AGENT); }
__device__ __forceinline__ unsigned xb_xcc_id() { return (unsigned)__builtin_amdgcn_s_getreg((3 << 11) | 20) & 0xFu; }
#define XB_SPIN(cond, bar) do { unsigned _sp = 0; while (cond) { __builtin_amdgcn_s_sleep(1); \
    if ((++_sp & 255u) == 0u) { if (xb_ld(&(bar)[XB_TMO])) break; if (_sp > XB_SPIN_CAP) { atomicAdd(&(bar)[XB_TMO], 1u); break; } } } } while (0)

struct XcdBarrier {
    unsigned* bar; unsigned x;
    volatile XLAS unsigned* st;
};

__device__ __forceinline__ XcdBarrier xcd_barrier_post(unsigned* bar, volatile XLAS unsigned* st) {
    XcdBarrier b; b.bar = bar; b.x = xb_xcc_id(); b.st = st;
    if (threadIdx.x == 0) (void)xb_add(&bar[XB_XCNT(b.x)], 1u);
    return b;
}
__device__ __forceinline__ void xcd_barrier_complete(unsigned* bar, unsigned x, unsigned& nloc, unsigned& nx) {
    const unsigned G = gridDim.x * gridDim.y * gridDim.z;
    unsigned sum, cnt, mine, sp = 0u;
    for (;;) {
        sum = 0u; cnt = 0u; mine = 0u;
#pragma unroll
        for (unsigned j = 0; j < 16; ++j) { const unsigned c = xb_ld(&bar[XB_XCNT(j)]); sum += c; cnt += (c > 0u) ? 1u : 0u; mine = (j == x) ? c : mine; }
        if (sum == G) break;
        __builtin_amdgcn_s_sleep(1);
        if ((++sp & 255u) == 0u) { if (xb_ld(&bar[XB_TMO])) break; if (sp > XB_SPIN_CAP) { atomicAdd(&bar[XB_TMO], 1u); break; } }
    }
    nloc = mine > 0u ? mine : 1u; nx = cnt > 0u ? cnt : 1u;
}

__device__ __forceinline__ void xcd_barrier(const XcdBarrier& b) {
    asm volatile("s_waitcnt vmcnt(0)" ::: "memory");
    __syncthreads();
    if (threadIdx.x == 0) {
        unsigned* bar = b.bar;
        __builtin_amdgcn_s_waitcnt(0);
        unsigned nloc = b.st[0], nx = b.st[1];
        if (nloc == 0u) { xcd_barrier_complete(bar, b.x, nloc, nx); b.st[0] = nloc; b.st[1] = nx; }
        const unsigned old = xb_add(&bar[XB_XSUB(b.x)], 1u);
        const unsigned gen = old / nloc;
        if (old + 1u == (gen + 1u) * nloc) {
            __builtin_amdgcn_fence(__ATOMIC_RELEASE, "agent");
            asm volatile("s_waitcnt vmcnt(0)" ::: "memory");
            const unsigned og = xb_add(&bar[XB_TOP], 1u);
            const unsigned tg = og / nx;
            if (og + 1u == (tg + 1u) * nx) xb_add(&bar[XB_TOPGEN], 1u);
            else XB_SPIN(xb_ld(&bar[XB_TOPGEN]) == tg, bar);
            __builtin_amdgcn_fence(__ATOMIC_ACQUIRE, "agent");
            xb_add(&bar[XB_XGEN(b.x)], 1u);
            asm volatile("s_waitcnt vmcnt(0)" ::: "memory");
        } else {
            XB_SPIN(xb_ld(&bar[XB_XGEN(b.x)]) == gen, bar);
            __builtin_amdgcn_fence(__ATOMIC_ACQUIRE, "agent");
            asm volatile("s_waitcnt vmcnt(0)" ::: "memory");
        }
    }
    __syncthreads();
}

__global__ void __launch_bounds__(512) fwd_megakernel(const Params p0) {
  extern __shared__ __attribute__((aligned(16))) unsigned char smem[];
  bf16_t* lds = (bf16_t*)smem;
  cg::grid_group grid = cg::this_grid();
  volatile XLAS unsigned* xb_st = (volatile XLAS unsigned*)((XLAS unsigned char*)smem + 131072);
  if (threadIdx.x == 0) { xb_st[0] = 0u; xb_st[1] = 0u; }
  __syncthreads();
  const XcdBarrier xbar = xcd_barrier_post((unsigned*)(p0.ws + OFF_BAR), xb_st);
  if (p0.ph_lo == 0) {
    const Params& p = p0;
    const int tid = opaque_tid(), lane = tid & 63, wid = tid >> 6, wm = wid >> 1, wn = wid & 1, h2 = lane >> 5, r = lane & 31;
    unsigned char* ws = p0.ws;
    asm volatile("" : "+s"(ws));
    bf16_t* WB = (bf16_t*)(ws + OFF_R0);
    bf16_t* PM = (bf16_t*)(ws + OFF_R1);
    bf16_t* MIX = (bf16_t*)(ws + OFF_MIX);
    unsigned char* SG8 = ws + OFF_SG8;
    bf16_t* YA = (bf16_t*)(ws + OFF_YA);
    bf16_t* ACT = (bf16_t*)(ws + OFF_R1);
    bf16_t* PS = (bf16_t*)(ws + OFF_R2);
    bf16_t* QA = (bf16_t*)(ws + OFF_R2);
    bf16_t* KAV = (bf16_t*)(ws + OFF_R3);
    bf16_t* H = (bf16_t*)(ws + OFF_R3);
    bf16_t* HF = (bf16_t*)(ws + OFF_HF);
    bf16_t* HB = (bf16_t*)(ws + OFF_HB);
    bf16_t* GQ = (bf16_t*)(ws + OFF_GQ);
    bf16_t* GK = (bf16_t*)(ws + OFF_GK);
    bf16_t* GV = (bf16_t*)(ws + OFF_GV);
    bf16_t* QL = (bf16_t*)(ws + OFF_QL);
    bf16_t* CKV = (bf16_t*)(ws + OFF_CKV);
    bf16_t* KR = (bf16_t*)(ws + OFF_KR);
    float* G = (float*)(ws + OFF_G);
    float* MOD = (float*)(ws + OFF_MOD);
    unsigned* CNT = (unsigned*)(ws + OFF_CNT);


    if (opaque_bid() == 0 && tid < (int)(sizeof(Params) / 8)) ((unsigned long long*)(ws + OFF_PCOPY))[tid] = ((const unsigned long long*)&p0)[tid];
      if (opaque_bid() == 0 && tid < 64) CNT[tid] = 0u;
      cvt_layer(p, 0, WB, lds);
      mod_phase(p, MOD, (float*)smem);
      rope_tables((f32x2*)(ws + OFF_TG), (f32x2*)(ws + OFF_TA));
    if (p0.ph_hi > 1) xcd_barrier(xbar);
  }
  if (p0.ph_hi < 0) grid.sync();
  for (int ph = (p0.ph_lo > 1 ? p0.ph_lo : 1); ph < p0.ph_hi; ++ph) {
    if ((ph - 1) % 13 == 10) continue;
    const int tid = opaque_tid(), lane = tid & 63, wid = tid >> 6, wm = wid >> 1, wn = wid & 1, h2 = lane >> 5, r = lane & 31;
    unsigned char* ws = p0.ws;
    asm volatile("" : "+s"(ws));
    const Params& p = *(const Params*)(ws + OFF_PCOPY);
    bf16_t* WB = (bf16_t*)(ws + OFF_R0);
    bf16_t* PM = (bf16_t*)(ws + OFF_R1);
    bf16_t* MIX = (bf16_t*)(ws + OFF_MIX);
    unsigned char* SG8 = ws + OFF_SG8;
    bf16_t* YA = (bf16_t*)(ws + OFF_YA);
    bf16_t* ACT = (bf16_t*)(ws + OFF_R1);
    bf16_t* PS = (bf16_t*)(ws + OFF_R2);
    bf16_t* QA = (bf16_t*)(ws + OFF_R2);
    bf16_t* KAV = (bf16_t*)(ws + OFF_R3);
    bf16_t* H = (bf16_t*)(ws + OFF_R3);
    bf16_t* HF = (bf16_t*)(ws + OFF_HF);
    bf16_t* HB = (bf16_t*)(ws + OFF_HB);
    bf16_t* GQ = (bf16_t*)(ws + OFF_GQ);
    bf16_t* GK = (bf16_t*)(ws + OFF_GK);
    bf16_t* GV = (bf16_t*)(ws + OFF_GV);
    bf16_t* QL = (bf16_t*)(ws + OFF_QL);
    bf16_t* CKV = (bf16_t*)(ws + OFF_CKV);
    bf16_t* KR = (bf16_t*)(ws + OFF_KR);
    float* G = (float*)(ws + OFF_G);
    float* MOD = (float*)(ws + OFF_MOD);
    unsigned* CNT = (unsigned*)(ws + OFF_CNT);


    {
      const int l = (ph - 1) / 13, sp = (ph - 1) % 13;
      const float* MODl = MOD + (size_t)l * 5 * 6144;
      if (sp == 0) {
        if (l == 1) cvt_layer(p, 1, WB, lds);
        else normmod_rows(p, true, p.norm1_g, MODl, 0, 1024, H);
      } else if (sp == 1 || sp == 7 || sp == 11) {
        const int mode = (sp == 1) ? 0 : (sp == 7) ? 1 : 2;
        const int Nn = (mode == 0) ? 3328 : (mode == 1) ? 3072 : 5632;
        const size_t boff = (mode == 0) ? WB_WIN + (size_t)3072 * 1024 : (mode == 1) ? WB_WIN : WB_WFI;
        pg8::Gemm g{H, WB + boff, NTOK, Nn, 1024};
        pg8::StaticOrder S; S.init(NTOK, Nn, opaque_gdim(), opaque_bid());
        EpiU E{mode, EpiP2{PM, PS, G, p.b_mgate + l * 16}, EpiGate8{SG8}, EpiSwiGLU{ACT}};
        pg8::gemm_phase<EpiU, pg8::StaticOrder, false>((PG8_LAS unsigned char*)smem, g, S, E, nullptr);
        if (mode == 0) cvt_rest(p, l, WB, lds, CNT + 32 + l);
      } else if (sp == 2) {
        post_small(p, l, PS, QL, CKV, KR, GQ, GK, GV, (const f32x2*)(ws + OFF_TG));
      } else if (sp == 3) {
        size_t wz4_ = 0;
        asm volatile("" : "+s"(wz4_));
        unsigned char* wsg4 = p0.ws + wz4_;
        const bf16_t* gQL = (const bf16_t*)(wsg4 + OFF_QL); const bf16_t* gCKV = (const bf16_t*)(wsg4 + OFF_CKV); const bf16_t* gWB = (const bf16_t*)(wsg4 + OFF_R0);
        bf16_t* gQA = (bf16_t*)(wsg4 + OFF_R2); bf16_t* gKAV = (bf16_t*)(wsg4 + OFF_R3);
        for (int tile = opaque_bid(); tile < 384 + 544; tile += opaque_gdim()) {
          f32x16 acc[2][2];
          zero_acc<2>(acc);
          if (tile < 384) {
            const int tm = tile & 63, tn = tile >> 6;
            gemm_acc<2>(acc, gQL + (size_t)tm * 256 * 256, 256, 64, gWB + WB_WUQ + (size_t)tn * 128 * 256, 256, 4, lds);
#pragma unroll
            for (int mi = 0; mi < 2; ++mi)
#pragma unroll
              for (int ni = 0; ni < 2; ++ni) {
                const int col = tn * 128 + wn * 64 + ni * 32 + r;
#pragma unroll
                for (int rg = 0; rg < 16; ++rg) {
                  const int row = tm * 256 + wm * 64 + mi * 32 + rowof(rg, h2);
                  gQA[(size_t)row * 768 + col] = f2bf(acc[mi][ni][rg]);
                }
              }
          } else {
            const int t2 = tile - 384, tm = t2 % 68, tn = t2 / 68;
            gemm_acc<2>(acc, gCKV + (size_t)tm * 256 * 128, 128, 64, gWB + WB_WUKV + (size_t)tn * 128 * 128, 128, 2, lds);
#pragma unroll
            for (int mi = 0; mi < 2; ++mi)
#pragma unroll
              for (int ni = 0; ni < 2; ++ni) {
                const int col = tn * 128 + wn * 64 + ni * 32 + r;
                const int hd = col >> 7, jj = col & 127;
                const int dcol = hd * 160 + (jj < 64 ? jj : jj + 32);
#pragma unroll
                for (int rg = 0; rg < 16; ++rg) {
                  const int row = tm * 256 + wm * 64 + mi * 32 + rowof(rg, h2);
                  gKAV[(size_t)row * 1280 + dcol] = f2bf(acc[mi][ni][rg]);
                }
              }
          }
        }
      } else if (sp == 4) {
        post_mla(p, l, QA, KAV, KR, (const f32x2*)(ws + OFF_TA));
      } else if (sp == 5) {
        size_t wz_ = 0;
        asm volatile("" : "+s"(wz_));
        unsigned char* wsg = p0.ws + wz_;
        const ParamsG* pg_ = (const ParamsG*)(wsg + OFF_PCOPY);
        Params pm_;
        pm_.st_C = (const float*)pg_->f[2]; pm_.st_n = (const float*)pg_->f[3]; pm_.st_m = (const float*)pg_->f[4];
        pm_.out = (float*)pg_->out;
        mixers_phase(pm_, l, (unsigned*)(wsg + OFF_CNT) + l, (const bf16_t*)(wsg + OFF_R1), (const float*)(wsg + OFF_G), (bf16_t*)(wsg + OFF_HF), (bf16_t*)(wsg + OFF_HB),
                     (bf16_t*)(wsg + OFF_R2), (bf16_t*)(wsg + OFF_YA), (const bf16_t*)(wsg + OFF_R3), (bf16_t*)(wsg + OFF_GQ), (const bf16_t*)(wsg + OFF_GK),
                     (const bf16_t*)(wsg + OFF_GV), lds, 1088);
      } else if (sp == 6) {
        post_mlstm(p, l, HF, HB, PM);
        normmod_rows(p, l == 0, p.norm1_g + l * 1024, MODl, 0, 1024, H);
      } else if (sp == 8) {
        pg8::Gemm g{HF, WB + WB_WBR, 3 * NTOK, 1024, 512};
        BranchOrder S{opaque_gdim(), opaque_bid()};
        EpiMixAcc E{SG8, MIX};
        pg8::gemm_phase<EpiMixAcc, BranchOrder, false>((PG8_LAS unsigned char*)smem, g, S, E, nullptr);
      } else if (sp == 9 || sp == 12) {
        const bool is9 = (sp == 9);
        pg8::Gemm g{is9 ? MIX : ACT, WB + (is9 ? WB_WOUT : WB_WFO), NTOK, 1024, is9 ? 1024 : DFF};
        pg8::StaticOrder S; S.init(NTOK, 1024, opaque_gdim(), opaque_bid());
        const bool donorm = is9 || l == 0;
        const int ln = is9 ? l : 1;
        EpiRes E{p.x_prompt, p.x_sample, p.out, MODl, is9 ? 2048 : 5120, (is9 && l == 0) ? 1 : 0,
                 donorm ? 1 : 0, (is9 ? p.norm2_g : p.norm1_g) + ln * 1024, MOD + (size_t)ln * 5 * 6144, is9 ? 3072 : 0, is9 ? 4096 : 1024, H,
                 (unsigned*)(ws + OFF_SS), CNT + 128 + (l * 2 + (is9 ? 0 : 1)) * 64};
        pg8::gemm_phase<EpiRes, pg8::StaticOrder, false>((PG8_LAS unsigned char*)smem, g, S, E, nullptr);
      }
    }
    if (ph + 1 < p0.ph_hi) xcd_barrier(xbar);
  }
}

extern "C" void kernel_launch(void* const* d_in, const int* in_sizes, int n_in, void* d_out, int out_size, void* d_ws, size_t ws_size,
                              hipStream_t stream) {
  static int grid_blocks = 0;
  if (!grid_blocks) {
    int dev = 0, cus = 0, per_cu = 0;
    (void)hipGetDevice(&dev);
    (void)hipDeviceGetAttribute(&cus, hipDeviceAttributeMultiprocessorCount, dev);
    (void)hipFuncSetAttribute((const void*)fwd_megakernel, hipFuncAttributeMaxDynamicSharedMemorySize, (int)DYN_LDS);
    (void)hipOccupancyMaxActiveBlocksPerMultiprocessor(&per_cu, fwd_megakernel, 512, DYN_LDS);
    if (per_cu > 1) per_cu = 1;
    if (per_cu < 1) per_cu = 1;
    grid_blocks = cus * per_cu;
  }
  if (ws_size < WS_END) fprintf(stderr, "workspace too small: %zu < %zu\n", ws_size, (size_t)WS_END);
  Params p{};
  const float* const* in = (const float* const*)d_in;
  p.x_prompt = in[0]; p.x_sample = in[1]; p.st_C = in[2]; p.st_n = in[3]; p.st_m = in[4]; p.c_ckv = in[5]; p.c_kr = in[6];
  p.c_gk = in[7]; p.c_gv = in[8]; p.c = in[9]; p.c_ctx = in[10]; p.w_mod = in[11]; p.b_mod = in[12]; p.norm1_g = in[13];
  p.w_in = in[14]; p.b_mgate = in[15]; p.m_norm_g = in[16]; p.a_qlora_g = in[17]; p.a_kvlora_g = in[18]; p.w_uq = in[19];
  p.w_ukv = in[20]; p.a_qnorm_g = in[21]; p.a_knorm_g = in[22]; p.g_qnorm_g = in[23]; p.g_knorm_g = in[24]; p.w_branch = in[25];
  p.w_out = in[26]; p.norm2_g = in[27]; p.w_ffn_in = in[28]; p.w_ffn_out = in[29];
  p.out = (float*)d_out;
  p.ws = (unsigned char*)d_ws;
  (void)hipMemsetAsync((unsigned char*)d_ws + OFF_CNT, 0, 4096 + 16384, stream);
#if MULTI_LAUNCH
#ifndef RUN_PHASES
#define RUN_PHASES NPHASE
#endif
  for (int ph = 0; ph < RUN_PHASES; ++ph) {
    p.ph_lo = ph; p.ph_hi = ph + 1;
    hipLaunchKernelGGL(fwd_megakernel, dim3(grid_blocks), dim3(512), DYN_LDS, stream, p);
  }
#ifdef DUMP_OFF
  p.ph_lo = 99; p.ph_hi = 100;
  hipLaunchKernelGGL(fwd_megakernel, dim3(grid_blocks), dim3(512), DYN_LDS, stream, p);
#endif
#else
  p.ph_lo = 0; p.ph_hi = NPHASE;
  void* args[] = {&p};
  hipError_t e = hipLaunchCooperativeKernel((void*)fwd_megakernel, dim3(grid_blocks), dim3(512), args, DYN_LDS, stream);
  if (e != hipSuccess) fprintf(stderr, "cooperative launch failed: %s (grid %d)\n", hipGetErrorString(e), grid_blocks);
#endif
}
```

```cpp
#include <hip/hip_runtime.h>
#include <hip/hip_cooperative_groups.h>
#include <cstdio>
namespace cg = cooperative_groups;

typedef unsigned short bf16_t;
typedef short bf16x8 __attribute__((ext_vector_type(8)));
typedef float f32x16 __attribute__((ext_vector_type(16)));
typedef float f32x4 __attribute__((ext_vector_type(4)));
typedef float f32x2 __attribute__((ext_vector_type(2)));
typedef unsigned u32x4 __attribute__((ext_vector_type(4)));
typedef unsigned u32x2 __attribute__((ext_vector_type(2)));

#ifndef MIXSEL
#define MIXSEL 7
#endif
#ifndef MULTI_LAUNCH
#define MULTI_LAUNCH 0
#endif

constexpr int NTOK = 16384, NCTX = 8192, NKV = 17408;
constexpr int DIN = 6320, DFF = 2816;
constexpr float EPS = 1e-6f;
constexpr int NPHASE = 27;
constexpr size_t DYN_LDS = 131072 + 64;

constexpr size_t WB_WIN = 0;
constexpr size_t WB_WUQ = WB_WIN + 6400ull * 1024;
constexpr size_t WB_WUKV = WB_WUQ + 768ull * 256;
constexpr size_t WB_WBR = WB_WUKV + 1024ull * 128;
constexpr size_t WB_WOUT = WB_WBR + 3ull * 1024 * 512;
constexpr size_t WB_WFI = WB_WOUT + 1024ull * 1024;
constexpr size_t WB_WFO = WB_WFI + 5632ull * 1024;
constexpr size_t WB_ELEMS = WB_WFO + 1024ull * 2816;

constexpr size_t OFF_R0 = 0;
constexpr size_t OFF_R1 = OFF_R0 + WB_ELEMS * 2;
constexpr size_t OFF_R2 = OFF_R1 + 16384ull * 2048 * 2;
constexpr size_t OFF_R3 = OFF_R2 + 16384ull * 1216 * 2;
constexpr size_t OFF_HF = OFF_R3 + 17408ull * 1280 * 2;
constexpr size_t OFF_YA = OFF_HF + 16384ull * 512 * 2;
constexpr size_t OFF_QL = OFF_YA;
constexpr size_t OFF_CKV = OFF_QL + 16384ull * 256 * 2;
constexpr size_t OFF_KR = OFF_CKV + 17408ull * 128 * 2;
constexpr size_t OFF_GQ = OFF_YA + 16384ull * 512 * 2;
constexpr size_t OFF_HB = OFF_GQ + 16384ull * 512 * 2;
constexpr size_t OFF_GK = OFF_HB + 16384ull * 512 * 2;
constexpr size_t OFF_GV = OFF_GK + 17408ull * 128 * 2;
constexpr size_t OFF_G = OFF_GV + 17408ull * 128 * 2;
constexpr size_t OFF_MOD = OFF_G + 16384ull * 16 * 4;
constexpr size_t OFF_CNT = OFF_MOD + 2ull * 5 * 6144 * 4;
static_assert(OFF_KR + 17408ull * 32 * 2 <= OFF_GQ, "QL/CKV/KR must fit under YA");
constexpr size_t OFF_SG8 = OFF_R1;
constexpr size_t OFF_MIX = OFF_R1 + 16384ull * 3072;
constexpr size_t OFF_PCOPY = OFF_CNT + 2048;
constexpr size_t OFF_BAR = OFF_CNT + 4096;
constexpr size_t OFF_TG = OFF_BAR + 16384;
constexpr size_t OFF_TA = OFF_TG + 2048ull * 32 * 8;
constexpr size_t OFF_SS = OFF_TA + 2048ull * 16 * 8;
constexpr size_t WS_END = OFF_SS + 16384ull * 4 * 4;

constexpr size_t O_Y = 0;
constexpr size_t O_C = 16777216;
constexpr size_t O_N = O_C + 8388608;
constexpr size_t O_M = O_N + 65536;
constexpr size_t O_CKV = O_M + 512;
constexpr size_t O_KR = O_CKV + 2097152;
constexpr size_t O_GK = O_KR + 524288;
constexpr size_t O_GV = O_GK + 2097152;

struct Params {
  const float *x_prompt, *x_sample, *st_C, *st_n, *st_m, *c_ckv, *c_kr, *c_gk, *c_gv, *c, *c_ctx;
  const float *w_mod, *b_mod, *norm1_g, *w_in, *b_mgate, *m_norm_g, *a_qlora_g, *a_kvlora_g, *w_uq, *w_ukv;
  const float *a_qnorm_g, *a_knorm_g, *g_qnorm_g, *g_knorm_g, *w_branch, *w_out, *norm2_g, *w_ffn_in, *w_ffn_out;
  float* out;
  unsigned char* ws;
  int ph_lo, ph_hi;
};

typedef __attribute__((address_space(1))) const float* gcfp_t;
struct ParamsG {
  gcfp_t f[30];
  __attribute__((address_space(1))) float* out;
  __attribute__((address_space(1))) unsigned char* ws;
  int ph_lo, ph_hi;
};
static_assert(sizeof(ParamsG) == sizeof(Params), "ParamsG must mirror Params");

typedef __bf16 bf16x2_t __attribute__((ext_vector_type(2)));
__device__ __forceinline__ unsigned cvt_pk_bf16(float lo, float hi) {
  f32x2 v = {lo, hi};
  bf16x2_t b = __builtin_convertvector(v, bf16x2_t);
  return __builtin_bit_cast(unsigned, b);
}
__device__ __forceinline__ bf16_t f2bf(float f) { return (bf16_t)(cvt_pk_bf16(f, 0.f) & 0xffffu); }
__device__ __forceinline__ float bf2f(bf16_t v) { return __uint_as_float(((unsigned)v) << 16); }
__device__ __forceinline__ float bflo(unsigned u) { return __uint_as_float(u << 16); }
__device__ __forceinline__ float bfhi(unsigned u) { return __uint_as_float(u & 0xffff0000u); }
__device__ __forceinline__ float wave_sum(float v) {
#pragma unroll
  for (int d = 1; d < 64; d <<= 1) v += __shfl_xor(v, d);
  return v;
}
__device__ __forceinline__ float half_sum(float v) {
#pragma unroll
  for (int d = 1; d < 32; d <<= 1) v += __shfl_xor(v, d);
  return v;
}
__device__ __forceinline__ float wave_max(float v) {
#pragma unroll
  for (int d = 1; d < 64; d <<= 1) v = fmaxf(v, __shfl_xor(v, d));
  return v;
}
__device__ __forceinline__ int opaque_tid() {
  int t = threadIdx.x;
  asm volatile("" : "+v"(t));
  return t;
}
__device__ __forceinline__ int opaque_bid() {
  int b = blockIdx.x;
  asm volatile("" : "+s"(b));
  return b;
}
__device__ __forceinline__ int opaque_gdim() {
  int g = gridDim.x;
  asm volatile("" : "+s"(g));
  return g;
}
__device__ __forceinline__ float cross_half_max(float x) {
  const unsigned u = __float_as_uint(x);
  const u32x2 rr = __builtin_amdgcn_permlane32_swap(u, u, false, false);
  return fmaxf(__uint_as_float(rr[0]), __uint_as_float(rr[1]));
}
__device__ __forceinline__ void lds_barrier() {
  asm volatile("s_waitcnt lgkmcnt(0)" ::: "memory");
  __builtin_amdgcn_s_barrier();
  asm volatile("" ::: "memory");
}
__device__ __forceinline__ float sigmoidf_(float x) { return __builtin_amdgcn_rcpf(1.0f + __builtin_amdgcn_exp2f(x * -1.4426950408889634f)); }
__device__ __forceinline__ int rowof(int reg, int h2) { return (reg & 3) + 8 * (reg >> 2) + 4 * h2; }
__device__ __forceinline__ int mod_index(int row) { return row < NCTX ? 0 : 1 + ((row - NCTX) >> 11); }

namespace pg8 {
#define PG8_LAS __attribute__((address_space(3)))
typedef unsigned short bf16_t;
typedef short bf16x8 __attribute__((ext_vector_type(8)));
typedef float f32x4 __attribute__((ext_vector_type(4)));
typedef unsigned u32x4 __attribute__((ext_vector_type(4)));
constexpr int BM = 256, BK = 64, HALF = 128, HTB = HALF * BK * 2  , STAGE_BYTES = 8 * HTB, NXCD = 8, WGM = 4;

__host__ __device__ __forceinline__ int lds_byte(int r, int c) { const int st = (r >> 4) * 2 + (c >> 5), rr = r & 15, cc = c & 31, ob = rr * 64 + cc * 2; return st * 1024 + (ob ^ (((ob >> 9) & 1) << 5)); }
__host__ __device__ __forceinline__ void stage_rc(int b, int& R, int& C) { const int st = b / 1024, sb = b % 1024, swz = sb ^ (((sb >> 9) & 1) << 5); R = (st >> 1) * 16 + swz / 64; C = (st & 1) * 32 + (swz % 64) / 2; }
__host__ __device__ __forceinline__ int perm32(int rho) { const int n = rho >> 4, i = rho & 15; return 8 * (i >> 2) + 4 * n + (i & 3); }

struct Unit { int pm, pn; };
struct Gemm { const bf16_t* A; const bf16_t* Bt; int M, N, K; };

struct StaticOrder {
    int nM, nN, nwg, G, c;
    __host__ __device__ void init(int M, int N, int G_, int c_) { nM = M / BM; nN = N / BM; nwg = nM * nN; G = G_; c = c_; }
    __host__ __device__ bool next(int i, Unit& u) const {
        const long L = (long)i * G + c; if (L >= nwg) return false;
        int wgid = (int)L; { const int q = nwg / NXCD, r = nwg % NXCD, xcd = wgid % NXCD, off = wgid / NXCD; wgid = (xcd < r ? xcd * (q + 1) : r * (q + 1) + (xcd - r) * q) + off; }
        const int nig = WGM * nN, gid = wgid / nig, fm = gid * WGM, gsz = (nM - fm) < WGM ? (nM - fm) : WGM;
        u.pm = fm + ((wgid % nig) % gsz); u.pn = (wgid % nig) / gsz; return true;
    }
    __device__ __forceinline__ void a_ready(const Unit&) const {}
    __device__ __forceinline__ void done(const Unit&) const {}
};
template <class Epi, class Sched, bool STAMP = false>
__device__ __forceinline__ void gemm_phase(PG8_LAS unsigned char* lds, const Gemm g, const Sched& S, const Epi& E, unsigned long long* stamps) {
    const int tid = opaque_tid(), wid = __builtin_amdgcn_readfirstlane(tid >> 6), lane = tid & 63, wr = wid >> 2, wc = wid & 3, fr = lane & 15, fq = lane >> 4;
    const int K = g.K, nt = K / BK;
    int ts_lo = 0, ts_hi = 0, nts = 0; const unsigned long long rt_entry = STAMP ? (unsigned long long)wall_clock64() : 0ull;
#define PG8_STAMP() do { if (STAMP && wid == 0 && nts < 64) { const unsigned long long _c = (unsigned long long)clock64(); \
        ts_lo = (lane == nts) ? (int)(unsigned)_c : ts_lo; ts_hi = (lane == nts) ? (int)(unsigned)(_c >> 32) : ts_hi; ++nts; } } while (0)
    PG8_STAMP();
    unsigned voffA[2], voffB[2];
#pragma unroll
    for (int i = 0; i < 2; ++i) { int R, C; stage_rc(tid * 16 + i * 8192, R, C); const int Rb = Epi::PERM ? ((R & ~31) + perm32(R & 31)) : R;
        voffA[i] = (unsigned)(R * K + C) * 2u; voffB[i] = (unsigned)(Rb * K + C) * 2u; }
    const size_t kstep = (size_t)(BK * 2);
    const size_t hstep = (size_t)HALF * K * 2;
    const size_t tstep = 2 * hstep;
    const unsigned ldsw = (unsigned)wid * 1024u;
    const int aoff = lds_byte(wr * 64 + fr, fq * 8), boff = lds_byte(wc * 32 + fr, fq * 8);
#define PG8_SA(b, h) (((b) * 2 + (h)) * HTB)
#define PG8_SB(b, h) ((4 + (b) * 2 + (h)) * HTB)
#define PG8_STAGE(bufoff, gbase, voff) do { _Pragma("unroll") for (int _i = 0; _i < 2; ++_i) \
        __builtin_amdgcn_global_load_lds((const unsigned*)((const char*)(gbase) + (voff)[_i]), (PG8_LAS unsigned*)(lds + (bufoff) + ldsw + _i * 8192), 16, 0, 0); } while (0)
#define PG8_LDA(dst, b, h) do { _Pragma("unroll") for (int m = 0; m < 4; ++m) _Pragma("unroll") for (int k = 0; k < 2; ++k) dst[m][k] = *(const PG8_LAS bf16x8*)(lds + PG8_SA(b, h) + aoff + m * 2048 + k * 1024); } while (0)
#define PG8_LDB(dst, b, h) do { _Pragma("unroll") for (int n = 0; n < 2; ++n) _Pragma("unroll") for (int k = 0; k < 2; ++k) dst[n][k] = *(const PG8_LAS bf16x8*)(lds + PG8_SB(b, h) + boff + n * 2048 + k * 1024); } while (0)
#define PG8_MMA(ai, bj, At, Bt) do { __builtin_amdgcn_s_setprio(1); _Pragma("unroll") for (int m = 0; m < 4; ++m) _Pragma("unroll") for (int n = 0; n < 2; ++n) _Pragma("unroll") for (int k = 0; k < 2; ++k) \
        acc[ai][bj][m][n] = __builtin_amdgcn_mfma_f32_16x16x32_bf16(Bt[n][k], At[m][k], acc[ai][bj][m][n], 0, 0, 0); __builtin_amdgcn_s_setprio(0); } while (0)
#define PG8_WAIT_V(n) asm volatile("s_waitcnt vmcnt(" #n ")" ::: "memory")
#define PG8_WAIT_L(n) asm volatile("s_waitcnt lgkmcnt(" #n ")" ::: "memory")
#define PG8_BAR __builtin_amdgcn_s_barrier()
#define PG8_SCHED __builtin_amdgcn_sched_barrier(0)
    Unit cur, nxt; int ui = 0;
    if (!S.next(0, cur)) return;
    f32x4 acc[2][2][4][2];
#pragma unroll
    for (int a = 0; a < 2; ++a)
#pragma unroll
        for (int b = 0; b < 2; ++b)
#pragma unroll
            for (int m = 0; m < 4; ++m)
#pragma unroll
                for (int n = 0; n < 2; ++n) acc[a][b][m][n] = (f32x4){0.f, 0.f, 0.f, 0.f};
    bf16x8 At[4][2], B0[2][2], B1[2][2];
    const char* cA = (const char*)g.A + (size_t)cur.pm * tstep; const char* cB = (const char*)g.Bt + (size_t)cur.pn * tstep;
    S.a_ready(cur);
    PG8_STAGE(PG8_SB(0, 0), cB, voffB); PG8_STAGE(PG8_SA(0, 0), cA, voffA); PG8_STAGE(PG8_SB(0, 1), cB + hstep, voffB); PG8_STAGE(PG8_SA(0, 1), cA + hstep, voffA);
    if (wr == 1) PG8_BAR;
    PG8_WAIT_V(4); PG8_BAR;
    PG8_STAGE(PG8_SB(1, 0), cB + kstep, voffB); PG8_STAGE(PG8_SA(1, 0), cA + kstep, voffA); PG8_STAGE(PG8_SB(1, 1), cB + hstep + kstep, voffB);
    PG8_WAIT_V(6); PG8_BAR;
    PG8_STAMP();
    for (;;) {
        const bool has_next = S.next(ui + 1, nxt);
        const char* nA = has_next ? (const char*)g.A + (size_t)nxt.pm * tstep : cA; const char* nB = has_next ? (const char*)g.Bt + (size_t)nxt.pn * tstep : cB;
        for (int t = 0; t < nt; t += 2) {
            const bool last = (t == nt - 2);
            const char* a1 = cA + (size_t)(t + 1) * kstep;
            const char* a2 = last ? nA : cA + (size_t)(t + 2) * kstep; const char* b2 = last ? nB : cB + (size_t)(t + 2) * kstep;
            const char* a3 = a2 + kstep; const char* b3 = b2 + kstep;
            if (last && has_next) S.a_ready(nxt);
            PG8_LDB(B0, 0, 0); PG8_SCHED; PG8_LDA(At, 0, 0); PG8_STAGE(PG8_SA(1, 1), a1 + hstep, voffA);
            PG8_WAIT_L(8); PG8_BAR; PG8_WAIT_L(0); PG8_MMA(0, 0, At, B0); PG8_BAR; PG8_SCHED;
            PG8_LDB(B1, 0, 1); PG8_STAGE(PG8_SB(0, 0), b2, voffB);
            PG8_BAR; PG8_WAIT_L(0); PG8_MMA(0, 1, At, B1); PG8_BAR;
            PG8_LDA(At, 0, 1); PG8_STAGE(PG8_SA(0, 0), a2, voffA);
            PG8_BAR; PG8_WAIT_L(0); PG8_MMA(1, 0, At, B0); PG8_BAR; PG8_SCHED;
            PG8_STAGE(PG8_SB(0, 1), b2 + hstep, voffB);
            PG8_WAIT_V(6); PG8_BAR; PG8_MMA(1, 1, At, B1); PG8_BAR;
            PG8_LDB(B0, 1, 0); PG8_SCHED; PG8_LDA(At, 1, 0); PG8_STAGE(PG8_SA(0, 1), a2 + hstep, voffA);
            PG8_WAIT_L(8); PG8_BAR; PG8_WAIT_L(0); PG8_MMA(0, 0, At, B0); PG8_BAR; PG8_SCHED;
            PG8_LDB(B1, 1, 1); PG8_STAGE(PG8_SB(1, 0), b3, voffB);
            PG8_BAR; PG8_WAIT_L(0); PG8_MMA(0, 1, At, B1); PG8_BAR;
            PG8_LDA(At, 1, 1); PG8_STAGE(PG8_SA(1, 0), a3, voffA);
            PG8_BAR; PG8_WAIT_L(0); PG8_MMA(1, 0, At, B0); PG8_BAR; PG8_SCHED;
            PG8_STAGE(PG8_SB(1, 1), b3 + hstep, voffB);
            PG8_WAIT_V(6); PG8_BAR; PG8_MMA(1, 1, At, B1); PG8_BAR;
        }
        PG8_STAMP();
        if constexpr (!Epi::AFTER_DRAIN) { E(acc, cur, wr, wc, fr, fq); S.done(cur); }
        PG8_STAMP();
        if (!has_next) break;
#pragma unroll
        for (int a = 0; a < 2; ++a)
#pragma unroll
            for (int b = 0; b < 2; ++b)
#pragma unroll
                for (int m = 0; m < 4; ++m)
#pragma unroll
                    for (int n = 0; n < 2; ++n) acc[a][b][m][n] = (f32x4){0.f, 0.f, 0.f, 0.f};
        cur = nxt; cA = nA; cB = nB; ++ui;
    }
    PG8_WAIT_V(0);
    if (wr == 0) PG8_BAR;
    PG8_BAR;
    if constexpr (Epi::AFTER_DRAIN) { E.fused(acc, cur, wr, wc, fr, fq, lds, wid, lane); S.done(cur); }
    PG8_STAMP();
    if (STAMP && wid == 0) { stamps[lane] = lane < nts ? (((unsigned long long)(unsigned)ts_hi << 32) | (unsigned)ts_lo) : 0ull;
        if (lane == 62) stamps[62] = rt_entry; if (lane == 63) stamps[63] = (unsigned long long)wall_clock64(); }
#undef PG8_STAMP
#undef PG8_SA
#undef PG8_SB
#undef PG8_STAGE
#undef PG8_LDA
#undef PG8_LDB
#undef PG8_MMA
#undef PG8_WAIT_V
#undef PG8_WAIT_L
#undef PG8_BAR
#undef PG8_SCHED
}
}

struct EpiP2 {
  static constexpr bool PERM = true, AFTER_DRAIN = false;
  bf16_t* PM; bf16_t* PS; float* G; const float* bias;
  __device__ __forceinline__ void operator()(const f32x4 (&acc)[2][2][4][2], const pg8::Unit& u, int wr, int wc, int fr, int fq) const {
    const int row0 = u.pm * 256 + wr * 64 + fr, colt = u.pn * 256 + wc * 32 + 8 * fq;
#pragma unroll
    for (int ai = 0; ai < 2; ++ai)
#pragma unroll
      for (int m = 0; m < 4; ++m) {
        const int row = row0 + ai * 128 + m * 16;
#pragma unroll
        for (int bj = 0; bj < 2; ++bj) {
          const int col = colt + bj * 128;
          const f32x4 v0 = acc[ai][bj][m][0], v1 = acc[ai][bj][m][1];
          u32x4 w;
          w.x = cvt_pk_bf16(v0[0], v0[1]); w.y = cvt_pk_bf16(v0[2], v0[3]);
          w.z = cvt_pk_bf16(v1[0], v1[1]); w.w = cvt_pk_bf16(v1[2], v1[3]);
          if (u.pn < 8) *(u32x4*)(PM + (size_t)row * 2048 + col) = w;
          else {
            const int c2 = col - 2048;
            if (c2 < 1200) *(u32x4*)(PS + (size_t)row * 1216 + c2) = w;
            if (c2 < 16) {
              *(f32x4*)(G + (size_t)row * 16 + c2) = v0 + *(const f32x4*)(bias + c2);
              *(f32x4*)(G + (size_t)row * 16 + c2 + 4) = v1 + *(const f32x4*)(bias + c2 + 4);
            }
          }
        }
      }
  }
};
struct EpiRes {
  static constexpr bool PERM = false, AFTER_DRAIN = true;
  const float* xp; const float* xs; float* out; const float* MODl; int gt_off; int from_input;
  int do_norm; const float* ng; const float* MODn; int sh_off, sc_off; bf16_t* H; unsigned* SS; unsigned* cnt;
  __device__ __forceinline__ void fused(f32x4 (&acc)[2][2][4][2], const pg8::Unit& u, int wr, int wc, int fr, int fq, PG8_LAS unsigned char* lds, int wid, int lane) const {
    const int row0 = u.pm * 256 + wr * 64 + fr, colt = u.pn * 256 + wc * 32 + 4 * fq;
#pragma unroll
    for (int ai = 0; ai < 2; ++ai)
#pragma unroll
      for (int m = 0; m < 4; ++m) {
        const int row = row0 + ai * 128 + m * 16;
        const float* md = MODl + mod_index(row) * 6144 + gt_off;
        const float* xin = from_input ? (row < NCTX ? xp + (size_t)row * 1024 : xs + (size_t)(row - NCTX) * 1024) : out + (size_t)row * 1024;
        float* xo = out + (size_t)row * 1024;
#pragma unroll
        for (int bj = 0; bj < 2; ++bj)
#pragma unroll
          for (int n = 0; n < 2; ++n) {
            const int col = colt + bj * 128 + n * 16;
            const f32x4 gt = *(const f32x4*)(md + col), xi = *(const f32x4*)(xin + col);
            const f32x4 v = xi + gt * acc[ai][bj][m][n];
            acc[ai][bj][m][n] = v;
            *(f32x4*)(xo + col) = v;
          }
      }
    if (!do_norm) return;
    PG8_LAS float* P = (PG8_LAS float*)lds;
    PG8_LAS float* Rr = (PG8_LAS float*)(lds + 4096);
    const int t = wid * 64 + lane;
#pragma unroll
    for (int ai = 0; ai < 2; ++ai)
#pragma unroll
      for (int m = 0; m < 4; ++m) {
        float ss = 0.f;
#pragma unroll
        for (int bj = 0; bj < 2; ++bj)
#pragma unroll
          for (int n = 0; n < 2; ++n) { const f32x4 v = acc[ai][bj][m][n]; ss += (v[0] * v[0] + v[1] * v[1]) + (v[2] * v[2] + v[3] * v[3]); }
        ss += __shfl_xor(ss, 16);
        ss += __shfl_xor(ss, 32);
        if (fq == 0) P[(ai * 128 + wr * 64 + m * 16 + fr) * 4 + wc] = ss;
      }
    lds_barrier();
    if (t < 256) {
      const float s = (P[t * 4 + 0] + P[t * 4 + 1]) + (P[t * 4 + 2] + P[t * 4 + 3]);
      __hip_atomic_store(SS + (size_t)(u.pm * 256 + t) * 4 + u.pn, __float_as_uint(s), __ATOMIC_RELAXED, __HIP_MEMORY_SCOPE_AGENT);
    }
    asm volatile("s_waitcnt vmcnt(0)" ::: "memory");
    lds_barrier();
    if (t == 0) __hip_atomic_fetch_add(cnt + u.pm, 1u, __ATOMIC_RELAXED, __HIP_MEMORY_SCOPE_AGENT);
    if (wid == 0) {
      unsigned sp_ = 0;
      while ((unsigned)__builtin_amdgcn_readfirstlane(__hip_atomic_load(cnt + u.pm, __ATOMIC_RELAXED, __HIP_MEMORY_SCOPE_AGENT)) < 4u) {
        __builtin_amdgcn_s_sleep(2);
        if (++sp_ > (1u << 20)) break;
      }
      __builtin_amdgcn_fence(__ATOMIC_ACQUIRE, "agent");
      asm volatile("s_waitcnt vmcnt(0)" ::: "memory");
    }
    lds_barrier();
    if (t < 256) {
      const unsigned* sl = SS + (size_t)(u.pm * 256 + t) * 4;
      float tot = 0.f;
#pragma unroll
      for (int q = 0; q < 4; ++q) tot += __uint_as_float(__hip_atomic_load(sl + q, __ATOMIC_RELAXED, __HIP_MEMORY_SCOPE_AGENT));
      Rr[t] = rsqrtf(tot * (1.0f / 1024.0f) + EPS);
    }
    lds_barrier();
    const float* mn = MODn + mod_index(u.pm * 256) * 6144;
#pragma unroll
    for (int bj = 0; bj < 2; ++bj)
#pragma unroll
      for (int n = 0; n < 2; ++n) {
        const int col = colt + bj * 128 + n * 16;
        const f32x4 g4 = *(const f32x4*)(ng + col), sc = *(const f32x4*)(mn + sc_off + col), sh = *(const f32x4*)(mn + sh_off + col);
#pragma unroll
        for (int ai = 0; ai < 2; ++ai)
#pragma unroll
          for (int m = 0; m < 4; ++m) {
            const int rl = ai * 128 + wr * 64 + m * 16 + fr;
            const float rstd = Rr[rl];
            const f32x4 v = acc[ai][bj][m][n];
            float y[4];
#pragma unroll
            for (int e = 0; e < 4; ++e) y[e] = v[e] * rstd * g4[e] * (1.0f + sc[e]) + sh[e];
            u32x2 w;
            w.x = cvt_pk_bf16(y[0], y[1]);
            w.y = cvt_pk_bf16(y[2], y[3]);
            *(u32x2*)(H + (size_t)(u.pm * 256 + rl) * 1024 + col) = w;
          }
      }
  }
};
struct EpiSwiGLU {
  static constexpr bool PERM = true, AFTER_DRAIN = false;
  bf16_t* ACT;
  __device__ __forceinline__ void operator()(const f32x4 (&acc)[2][2][4][2], const pg8::Unit& u, int wr, int wc, int fr, int fq) const {
    const int row0 = u.pm * 256 + wr * 64 + fr, colt = u.pn * 128 + wc * 32 + 8 * fq;
#pragma unroll
    for (int ai = 0; ai < 2; ++ai)
#pragma unroll
      for (int m = 0; m < 4; ++m) {
        const int row = row0 + ai * 128 + m * 16;
        float y[8];
#pragma unroll
        for (int n = 0; n < 2; ++n) {
          const f32x4 g = acc[ai][0][m][n], v = acc[ai][1][m][n];
#pragma unroll
          for (int e = 0; e < 4; ++e) y[4 * n + e] = g[e] * sigmoidf_(g[e]) * v[e];
        }
        u32x4 w;
        w.x = cvt_pk_bf16(y[0], y[1]); w.y = cvt_pk_bf16(y[2], y[3]); w.z = cvt_pk_bf16(y[4], y[5]); w.w = cvt_pk_bf16(y[6], y[7]);
        *(u32x4*)(ACT + (size_t)row * DFF + colt) = w;
      }
  }
};
struct EpiGate8 {
  static constexpr bool PERM = true, AFTER_DRAIN = false;
  unsigned char* SG;
  __device__ __forceinline__ void operator()(const f32x4 (&acc)[2][2][4][2], const pg8::Unit& u, int wr, int wc, int fr, int fq) const {
    const int row0 = u.pm * 256 + wr * 64 + fr, colt = u.pn * 256 + wc * 32 + 8 * fq;
#pragma unroll
    for (int ai = 0; ai < 2; ++ai)
#pragma unroll
      for (int m = 0; m < 4; ++m) {
        const int row = row0 + ai * 128 + m * 16;
#pragma unroll
        for (int bj = 0; bj < 2; ++bj) {
          u32x2 w = {0u, 0u};
#pragma unroll
          for (int e = 0; e < 4; ++e) {
            w.x |= ((unsigned)(sigmoidf_(acc[ai][bj][m][0][e]) * 255.0f + 0.5f)) << (8 * e);
            w.y |= ((unsigned)(sigmoidf_(acc[ai][bj][m][1][e]) * 255.0f + 0.5f)) << (8 * e);
          }
          *(u32x2*)(SG + (size_t)row * 3072 + colt + bj * 128) = w;
        }
      }
  }
};
struct EpiU {
  static constexpr bool PERM = true, AFTER_DRAIN = false;
  int mode;
  EpiP2 e0; EpiGate8 e1; EpiSwiGLU e2;
  __device__ __forceinline__ void operator()(const f32x4 (&acc)[2][2][4][2], const pg8::Unit& u, int wr, int wc, int fr, int fq) const {
    if (mode == 0) e0(acc, u, wr, wc, fr, fq);
    else if (mode == 1) e1(acc, u, wr, wc, fr, fq);
    else e2(acc, u, wr, wc, fr, fq);
  }
};
struct BranchOrder {
  int G, c;
  __device__ bool next(int i, pg8::Unit& u) const {
    const int n = i % 3, t = c + (i / 3) * G;
    if (t >= 256) return false;
    u.pm = n * 64 + (t >> 2); u.pn = n * 4 + (t & 3);
    return true;
  }
  __device__ __forceinline__ void a_ready(const pg8::Unit&) const {}
  __device__ __forceinline__ void done(const pg8::Unit&) const {}
};
struct EpiMixAcc {
  static constexpr bool PERM = true, AFTER_DRAIN = false;
  const unsigned char* SG; bf16_t* MIX;
  __device__ __forceinline__ void operator()(const f32x4 (&acc)[2][2][4][2], const pg8::Unit& u, int wr, int wc, int fr, int fq) const {
    const int nb = u.pn >> 2, pn = u.pn & 3, pm = u.pm - nb * 64;
    const int row0 = pm * 256 + wr * 64 + fr, colt = pn * 256 + wc * 32 + 8 * fq;
#pragma unroll
    for (int ai = 0; ai < 2; ++ai)
#pragma unroll
      for (int m = 0; m < 4; ++m) {
        const int row = row0 + ai * 128 + m * 16;
#pragma unroll
        for (int bj = 0; bj < 2; ++bj) {
          const int col = colt + bj * 128;
          const u32x2 g = *(const u32x2*)(SG + (size_t)row * 3072 + nb * 1024 + col);
          const f32x4 a0 = acc[ai][bj][m][0], a1 = acc[ai][bj][m][1];
          float y[8];
#pragma unroll
          for (int e = 0; e < 4; ++e) {
            y[e] = (float)((g.x >> (8 * e)) & 255u) * (1.0f / 255.0f) * a0[e];
            y[4 + e] = (float)((g.y >> (8 * e)) & 255u) * (1.0f / 255.0f) * a1[e];
          }
          bf16_t* mp = MIX + (size_t)row * 1024 + col;
          if (nb > 0) {
            const u32x4 o = *(const u32x4*)mp;
            y[0] += bflo(o.x); y[1] += bfhi(o.x); y[2] += bflo(o.y); y[3] += bfhi(o.y);
            y[4] += bflo(o.z); y[5] += bfhi(o.z); y[6] += bflo(o.w); y[7] += bfhi(o.w);
          }
          u32x4 w;
          w.x = cvt_pk_bf16(y[0], y[1]); w.y = cvt_pk_bf16(y[2], y[3]); w.z = cvt_pk_bf16(y[4], y[5]); w.w = cvt_pk_bf16(y[6], y[7]);
          *(u32x4*)mp = w;
        }
      }
  }
};

constexpr int LSTR = 72;
constexpr int A_TILE_EL = 256 * LSTR;
constexpr int B_TILE_EL = 128 * LSTR;
constexpr int STAGE_EL = A_TILE_EL + B_TILE_EL;

template <int NI>
__device__ __forceinline__ void gemm_acc(f32x16 (&acc)[2][NI], const bf16_t* __restrict__ A, int lda, int akstride,
                                         const bf16_t* __restrict__ Bt, int ldb, int nk, bf16_t* lds) {
  const int tid = opaque_tid(), lane = tid & 63, wid = tid >> 6, wm = wid >> 1, wn = wid & 1;
  const int lr = tid >> 3, lc = (tid & 7) * 8;
  u32x4 ra[4], rb[NI];
  const bf16_t* ap = A + (size_t)lr * lda + lc;
  const bf16_t* bp = Bt + (size_t)lr * ldb + lc;
#pragma unroll
  for (int i = 0; i < 4; ++i) ra[i] = *(const u32x4*)(ap + (size_t)(64 * i) * lda);
#pragma unroll
  for (int i = 0; i < NI; ++i) rb[i] = *(const u32x4*)(bp + (size_t)(64 * i) * ldb);
  {
    bf16_t* sA = lds;
    bf16_t* sB = lds + A_TILE_EL;
#pragma unroll
    for (int i = 0; i < 4; ++i) *(u32x4*)(sA + (lr + 64 * i) * LSTR + lc) = ra[i];
#pragma unroll
    for (int i = 0; i < NI; ++i) *(u32x4*)(sB + (lr + 64 * i) * LSTR + lc) = rb[i];
  }
  __syncthreads();
  const int arow = wm * 64 + (lane & 31), brow = wn * (32 * NI) + (lane & 31), kof = (lane >> 5) * 8;
  for (int kt = 0; kt < nk; ++kt) {
    const int cur = kt & 1;
    if (kt + 1 < nk) {
      const bf16_t* ap2 = ap + (size_t)(kt + 1) * akstride;
      const bf16_t* bp2 = bp + (size_t)(kt + 1) * 64;
#pragma unroll
      for (int i = 0; i < 4; ++i) ra[i] = *(const u32x4*)(ap2 + (size_t)(64 * i) * lda);
#pragma unroll
      for (int i = 0; i < NI; ++i) rb[i] = *(const u32x4*)(bp2 + (size_t)(64 * i) * ldb);
    }
    const bf16_t* cA = lds + cur * STAGE_EL;
    const bf16_t* cB = cA + A_TILE_EL;
#pragma unroll
    for (int ks = 0; ks < 4; ++ks) {
      bf16x8 af[2], bfr[NI];
#pragma unroll
      for (int mi = 0; mi < 2; ++mi) af[mi] = *(const bf16x8*)(cA + (arow + mi * 32) * LSTR + ks * 16 + kof);
#pragma unroll
      for (int ni = 0; ni < NI; ++ni) bfr[ni] = *(const bf16x8*)(cB + (brow + ni * 32) * LSTR + ks * 16 + kof);
#pragma unroll
      for (int mi = 0; mi < 2; ++mi)
#pragma unroll
        for (int ni = 0; ni < NI; ++ni)
          acc[mi][ni] = __builtin_amdgcn_mfma_f32_32x32x16_bf16(af[mi], bfr[ni], acc[mi][ni], 0, 0, 0);
    }
    if (kt + 1 < nk) {
      bf16_t* sA = lds + (cur ^ 1) * STAGE_EL;
      bf16_t* sB = sA + A_TILE_EL;
#pragma unroll
      for (int i = 0; i < 4; ++i) *(u32x4*)(sA + (lr + 64 * i) * LSTR + lc) = ra[i];
#pragma unroll
      for (int i = 0; i < NI; ++i) *(u32x4*)(sB + (lr + 64 * i) * LSTR + lc) = rb[i];
    }
    __syncthreads();
  }
}

template <int NI>
__device__ __forceinline__ void zero_acc(f32x16 (&acc)[2][NI]) {
#pragma unroll
  for (int mi = 0; mi < 2; ++mi)
#pragma unroll
    for (int ni = 0; ni < NI; ++ni)
#pragma unroll
      for (int r = 0; r < 16; ++r) acc[mi][ni][r] = 0.f;
}

struct CvtJob { const float* src; bf16_t* dst; int K, ld, nvalid, mode, tn, tk; };
constexpr int CVT_TILES = 2216;
__device__ __forceinline__ CvtJob cvt_decode(const Params& p, int l, bf16_t* WB, int tile) {
  CvtJob j;
  j.mode = 0;
  int tl = tile;
  if (tl < 800) { j.src = p.w_in + (size_t)l * 1024 * DIN; j.dst = WB + WB_WIN; j.K = 1024; j.ld = DIN; j.nvalid = DIN; }
  else if ((tl -= 800) < 24) { j.src = p.w_uq + (size_t)l * 256 * 768; j.dst = WB + WB_WUQ; j.K = 256; j.ld = 768; j.nvalid = 768; }
  else if ((tl -= 24) < 16) { j.src = p.w_ukv + (size_t)l * 128 * 1024; j.dst = WB + WB_WUKV; j.K = 128; j.ld = 1024; j.nvalid = 1024; }
  else if ((tl -= 16) < 192) { const int n = tl >> 6; tl &= 63; j.src = p.w_branch + (size_t)(l * 3 + n) * 512 * 1024; j.dst = WB + WB_WBR + (size_t)n * 1024 * 512; j.K = 512; j.ld = 1024; j.nvalid = 1024; }
  else if ((tl -= 192) < 128) { j.src = p.w_out + (size_t)l * 1024 * 1024; j.dst = WB + WB_WOUT; j.K = 1024; j.ld = 1024; j.nvalid = 1024; }
  else if ((tl -= 128) < 704) { j.src = p.w_ffn_in + (size_t)l * 1024 * 5632; j.dst = WB + WB_WFI; j.K = 1024; j.ld = 5632; j.nvalid = 5632; j.mode = 1; }
  else { tl -= 704; j.src = p.w_ffn_out + (size_t)l * DFF * 1024; j.dst = WB + WB_WFO; j.K = DFF; j.ld = 1024; j.nvalid = 1024; }
  const int nkt = j.K >> 7;
  j.tn = tl / nkt; j.tk = tl - j.tn * nkt;
  return j;
}
__device__ __forceinline__ void cvt_load(const CvtJob& j, int tid, f32x4 (&v)[4]) {
  const int kk = tid >> 4, n4 = (tid & 15) * 4, np = j.tn * 64 + n4;
  int nsrc = np;
  if (j.mode == 1) { const int g = np >> 8, r = np & 255; nsrc = (r < 128 ? 0 : DFF) + 128 * g + (r & 127); }
#pragma unroll
  for (int i = 0; i < 4; ++i) v[i] = (f32x4){0.f, 0.f, 0.f, 0.f};
  if (np < j.nvalid) {
#pragma unroll
    for (int i = 0; i < 4; ++i) v[i] = *(const f32x4*)(j.src + (size_t)(j.tk * 128 + kk + 32 * i) * j.ld + nsrc);
  }
}
__device__ __forceinline__ int cvt_tile_of(int part, int i) { return part == 0 ? 384 + i : (i < 384 ? i : i + 456); }
__device__ void cvt_layer(const Params& p, int l, bf16_t* WB, bf16_t* lds) {
  const int tid = opaque_tid();
  const int kk = tid >> 4, n4 = (tid & 15) * 4, nl = tid >> 3, kc = (tid & 7) * 8;
  float* Tbase = (float*)lds;
  int tile = opaque_bid(), buf = 0;
  f32x4 v[4];
  if (tile < 456) { const CvtJob j = cvt_decode(p, l, WB, cvt_tile_of(0, tile)); cvt_load(j, tid, v); }
  while (tile < 456) {
    float* T = Tbase + buf * (128 * 65);
#pragma unroll
    for (int i = 0; i < 4; ++i) {
      float* tp = T + (kk + 32 * i) * 65 + n4;
      tp[0] = v[i][0]; tp[1] = v[i][1]; tp[2] = v[i][2]; tp[3] = v[i][3];
    }
    const CvtJob jc = cvt_decode(p, l, WB, cvt_tile_of(0, tile));
    const int next = tile + opaque_gdim();
    if (next < 456) { const CvtJob jn = cvt_decode(p, l, WB, cvt_tile_of(0, next)); cvt_load(jn, tid, v); }
    lds_barrier();
#pragma unroll
    for (int hlf = 0; hlf < 2; ++hlf) {
      const int k0 = hlf * 64 + kc;
      u32x4 w;
      w.x = cvt_pk_bf16(T[(k0 + 0) * 65 + nl], T[(k0 + 1) * 65 + nl]);
      w.y = cvt_pk_bf16(T[(k0 + 2) * 65 + nl], T[(k0 + 3) * 65 + nl]);
      w.z = cvt_pk_bf16(T[(k0 + 4) * 65 + nl], T[(k0 + 5) * 65 + nl]);
      w.w = cvt_pk_bf16(T[(k0 + 6) * 65 + nl], T[(k0 + 7) * 65 + nl]);
      *(u32x4*)(jc.dst + (size_t)(jc.tn * 64 + nl) * jc.K + jc.tk * 128 + k0) = w;
    }
    buf ^= 1;
    tile = next;
  }
  __syncthreads();
}

__device__ void cvt_rest(const Params& p, int l, bf16_t* WB, bf16_t* lds, unsigned* counter, int part, int ntile) {
  const int tid = opaque_tid();
  const int kk = tid >> 4, n4 = (tid & 15) * 4, nl = tid >> 3, kc = (tid & 7) * 8;
  float* T = (float*)lds;
  int* slot = (int*)(T + 128 * 65);
  for (;;) {
    if (tid == 0) *slot = (int)atomicAdd(counter, 1u);
    __syncthreads();
    const int i = *slot;
    if (i >= ntile) break;
    const CvtJob jc = cvt_decode(p, l, WB, cvt_tile_of(part, i));
    f32x4 v[4];
    cvt_load(jc, tid, v);
#pragma unroll
    for (int q = 0; q < 4; ++q) {
      float* tp = T + (kk + 32 * q) * 65 + n4;
      tp[0] = v[q][0]; tp[1] = v[q][1]; tp[2] = v[q][2]; tp[3] = v[q][3];
    }
    __syncthreads();
#pragma unroll
    for (int hlf = 0; hlf < 2; ++hlf) {
      const int k0 = hlf * 64 + kc;
      u32x4 w;
      w.x = cvt_pk_bf16(T[(k0 + 0) * 65 + nl], T[(k0 + 1) * 65 + nl]);
      w.y = cvt_pk_bf16(T[(k0 + 2) * 65 + nl], T[(k0 + 3) * 65 + nl]);
      w.z = cvt_pk_bf16(T[(k0 + 4) * 65 + nl], T[(k0 + 5) * 65 + nl]);
      w.w = cvt_pk_bf16(T[(k0 + 6) * 65 + nl], T[(k0 + 7) * 65 + nl]);
      *(u32x4*)(jc.dst + (size_t)(jc.tn * 64 + nl) * jc.K + jc.tk * 128 + k0) = w;
    }
    __syncthreads();
  }
  __syncthreads();
}

__device__ void mod_phase(const Params& p, float* MOD, float* S) {
  const int tid = opaque_tid();
  float* R = S + 5120;
  for (int i = tid; i < 5120; i += 512) {
    const int j = i >> 10, k = i & 1023;
    const float c = (j == 0) ? p.c_ctx[k] : p.c[(j - 1) * 1024 + k];
    S[i] = c / (1.0f + __expf(-c));
  }
  __syncthreads();
  for (int item = opaque_bid(); item < 768; item += opaque_gdim()) {
    const int l = item / 384, cgp = item - l * 384, c16 = tid & 15, ks = tid >> 4;
    const float* w = p.w_mod + (size_t)l * 1024 * 6144 + cgp * 16 + c16;
    float a0 = 0.f, a1 = 0.f, a2 = 0.f, a3 = 0.f, a4 = 0.f;
#pragma unroll 8
    for (int kk2 = 0; kk2 < 32; ++kk2) {
      const int k = ks * 32 + kk2;
      const float wv = w[(size_t)k * 6144];
      a0 += S[k] * wv; a1 += S[1024 + k] * wv; a2 += S[2048 + k] * wv; a3 += S[3072 + k] * wv; a4 += S[4096 + k] * wv;
    }
    R[(ks * 5 + 0) * 16 + c16] = a0; R[(ks * 5 + 1) * 16 + c16] = a1; R[(ks * 5 + 2) * 16 + c16] = a2;
    R[(ks * 5 + 3) * 16 + c16] = a3; R[(ks * 5 + 4) * 16 + c16] = a4;
    __syncthreads();
    if (tid < 80) {
      const int j = tid >> 4, c = tid & 15;
      float s = 0.f;
      for (int q = 0; q < 32; ++q) s += R[(q * 5 + j) * 16 + c];
      MOD[(size_t)(l * 5 + j) * 6144 + cgp * 16 + c] = s + p.b_mod[l * 6144 + cgp * 16 + c];
    }
    __syncthreads();
  }
}

__device__ void normmod_rows(const Params& p, bool from_input, const float* g, const float* MODl, int sh_off, int sc_off, bf16_t* H) {
  const int tid_ = opaque_tid(), lane = tid_ & 63, wid = tid_ >> 6;
  const int stride = opaque_gdim() * 8;
  for (int row0 = opaque_bid() * 8 + wid; row0 < NTOK; row0 += stride * 4) {
    f32x4 v[4][4];
    float ss[4];
#pragma unroll
    for (int k = 0; k < 4; ++k) {
      const int row = row0 + k * stride;
      ss[k] = 0.f;
      if (row < NTOK) {
        const float* x = from_input ? (row < NCTX ? p.x_prompt + (size_t)row * 1024 : p.x_sample + (size_t)(row - NCTX) * 1024)
                                    : p.out + (size_t)row * 1024;
#pragma unroll
        for (int i = 0; i < 4; ++i) {
          v[k][i] = *(const f32x4*)(x + i * 256 + lane * 4);
          ss[k] += v[k][i][0] * v[k][i][0] + v[k][i][1] * v[k][i][1] + v[k][i][2] * v[k][i][2] + v[k][i][3] * v[k][i][3];
        }
      }
    }
#pragma unroll
    for (int d = 1; d < 64; d <<= 1) {
#pragma unroll
      for (int k = 0; k < 4; ++k) ss[k] += __shfl_xor(ss[k], d);
    }
#pragma unroll
    for (int k = 0; k < 4; ++k) {
      const int row = row0 + k * stride;
      if (row < NTOK) {
        const float* md = MODl + mod_index(row) * 6144;
        const float rstd = rsqrtf(ss[k] * (1.0f / 1024.0f) + EPS);
#pragma unroll
        for (int i = 0; i < 4; ++i) {
          const int c = i * 256 + lane * 4;
          const f32x4 g4 = *(const f32x4*)(g + c), sc = *(const f32x4*)(md + sc_off + c), sh = *(const f32x4*)(md + sh_off + c);
          float y[4];
#pragma unroll
          for (int e = 0; e < 4; ++e) y[e] = v[k][i][e] * rstd * g4[e] * (1.0f + sc[e]) + sh[e];
          u32x2 w;
          w.x = cvt_pk_bf16(y[0], y[1]);
          w.y = cvt_pk_bf16(y[2], y[3]);
          *(u32x2*)(H + (size_t)row * 1024 + c) = w;
        }
      }
    }
  }
}

__device__ __forceinline__ void rope_cs(int t, int pidx, int nfreq, float& c, float& s) {
  const int fi = pidx < nfreq ? pidx : pidx - nfreq;
  const float pos = pidx < nfreq ? (float)(t >> 6) : (float)(t & 63);
  const float freq = exp2f(-(float)fi / (float)nfreq * 13.287712379549449f);
  const float ang = pos * freq;
  sincosf(ang, &s, &c);
}

__device__ void rope_tables(f32x2* TG, f32x2* TA) {
  for (int i = opaque_bid() * 512 + opaque_tid(); i < 2048 * 48; i += opaque_gdim() * 512) {
    const int t = i / 48, j = i - t * 48;
    float c, s;
    if (j < 32) { rope_cs(t, j, 16, c, s); TG[t * 32 + j] = (f32x2){c, s}; }
    else { rope_cs(t, j - 32, 8, c, s); TA[t * 16 + (j - 32)] = (f32x2){c, s}; }
  }
}
__device__ __forceinline__ float sum8(float v) { v += __shfl_xor(v, 1); v += __shfl_xor(v, 2); v += __shfl_xor(v, 4); return v; }

__device__ void post_small(const Params& p, int l, const bf16_t* PS, bf16_t* QL, bf16_t* CKV, bf16_t* KR, bf16_t* GQ, bf16_t* GK, bf16_t* GV, const f32x2* TG) {
  const int tid_ = opaque_tid(), lane = tid_ & 63, wid = tid_ >> 6;
  const int head = lane >> 3, j8 = lane & 7;
  const float gq_scale = 0.125f * 1.4426950408889634f;
  const f32x4 gqa = *(const f32x4*)(p.g_qnorm_g + l * 64 + 4 * j8), gqb = *(const f32x4*)(p.g_qnorm_g + l * 64 + 32 + 4 * j8);
  const f32x4 gka = *(const f32x4*)(p.g_knorm_g + l * 64 + 4 * j8), gkb = *(const f32x4*)(p.g_knorm_g + l * 64 + 32 + 4 * j8);
  const f32x4 gql = *(const f32x4*)(p.a_qlora_g + l * 256 + lane * 4);
  const f32x2 gkv = *(const f32x2*)(p.a_kvlora_g + l * 128 + lane * 2);
  for (int row = opaque_bid() * 8 + wid; row < NKV; row += opaque_gdim() * 8) {
    if (row < NTOK) {
      const bf16_t* ps = PS + (size_t)row * 1216;
      const bool ctx = row < NCTX;
      const int b = ctx ? (row >> 8) : ((row - NCTX) >> 11);
      const int t = ctx ? (row & 255) : ((row - NCTX) & 2047);
      const size_t obase = (size_t)((b * 2 + l) * 256 + t);
      const u32x2 wq = *(const u32x2*)(ps + 16 + lane * 4);
      const unsigned wkv = *(const unsigned*)(ps + 272 + lane * 2);
      const u32x2 g1 = *(const u32x2*)(ps + 432 + head * 64 + 4 * j8), g2 = *(const u32x2*)(ps + 432 + head * 64 + 32 + 4 * j8);
      const int khead = (lane >> 3) & 1;
      const u32x2 k1 = *(const u32x2*)(ps + 944 + khead * 64 + 4 * j8), k2 = *(const u32x2*)(ps + 944 + khead * 64 + 32 + 4 * j8);
      f32x4 c4 = {1.f, 1.f, 1.f, 1.f}, s4 = {0.f, 0.f, 0.f, 0.f}, c4b = c4, s4b = s4;
      if (!ctx) {
        const f32x4 r0 = *(const f32x4*)(TG + t * 32 + 4 * j8), r1 = *(const f32x4*)(TG + t * 32 + 4 * j8 + 2);
        c4 = (f32x4){r0[0], r0[2], r1[0], r1[2]}; s4 = (f32x4){r0[1], r0[3], r1[1], r1[3]};
      }
      (void)c4b; (void)s4b;
      float q0 = bflo(wq.x), q1 = bfhi(wq.x), q2 = bflo(wq.y), q3 = bfhi(wq.y);
      float v0 = bflo(wkv), v1 = bfhi(wkv);
      float ssq = q0 * q0 + q1 * q1 + q2 * q2 + q3 * q3, sskv = v0 * v0 + v1 * v1;
#pragma unroll
      for (int d = 1; d < 64; d <<= 1) { ssq += __shfl_xor(ssq, d); sskv += __shfl_xor(sskv, d); }
      {
        const float rstd = rsqrtf(ssq * (1.0f / 256.0f) + EPS);
        u32x2 o;
        o.x = cvt_pk_bf16(q0 * rstd * gql[0], q1 * rstd * gql[1]);
        o.y = cvt_pk_bf16(q2 * rstd * gql[2], q3 * rstd * gql[3]);
        *(u32x2*)(QL + (size_t)row * 256 + lane * 4) = o;
      }
      {
        const float rstd = rsqrtf(sskv * (1.0f / 128.0f) + EPS);
        v0 = v0 * rstd * gkv[0]; v1 = v1 * rstd * gkv[1];
        *(unsigned*)(CKV + (size_t)row * 128 + lane * 2) = cvt_pk_bf16(v0, v1);
        if (ctx) { f32x2 o = {v0, v1}; *(f32x2*)(p.out + O_CKV + obase * 128 + lane * 2) = o; }
      }
      {
        float x1[4] = {bflo(g1.x), bfhi(g1.x), bflo(g1.y), bfhi(g1.y)}, x2[4] = {bflo(g2.x), bfhi(g2.x), bflo(g2.y), bfhi(g2.y)};
        float ss = 0.f;
#pragma unroll
        for (int e = 0; e < 4; ++e) ss += x1[e] * x1[e] + x2[e] * x2[e];
        ss = sum8(ss);
        const float rstd = rsqrtf(ss * (1.0f / 64.0f) + EPS) ;
        float y1[4], y2[4];
#pragma unroll
        for (int e = 0; e < 4; ++e) {
          const float a1 = x1[e] * rstd * gqa[e], a2 = x2[e] * rstd * gqb[e];
          y1[e] = (a1 * c4[e] - a2 * s4[e]) * gq_scale;
          y2[e] = (a1 * s4[e] + a2 * c4[e]) * gq_scale;
        }
        u32x2 o1, o2;
        o1.x = cvt_pk_bf16(y1[0], y1[1]); o1.y = cvt_pk_bf16(y1[2], y1[3]);
        o2.x = cvt_pk_bf16(y2[0], y2[1]); o2.y = cvt_pk_bf16(y2[2], y2[3]);
        *(u32x2*)(GQ + (size_t)row * 512 + head * 64 + 4 * j8) = o1;
        *(u32x2*)(GQ + (size_t)row * 512 + head * 64 + 32 + 4 * j8) = o2;
      }
      {
        float x1[4] = {bflo(k1.x), bfhi(k1.x), bflo(k1.y), bfhi(k1.y)}, x2[4] = {bflo(k2.x), bfhi(k2.x), bflo(k2.y), bfhi(k2.y)};
        float ss = 0.f;
#pragma unroll
        for (int e = 0; e < 4; ++e) ss += x1[e] * x1[e] + x2[e] * x2[e];
        ss = sum8(ss);
        const float rstd = rsqrtf(ss * (1.0f / 64.0f) + EPS);
        float y1[4], y2[4];
#pragma unroll
        for (int e = 0; e < 4; ++e) {
          const float a1 = x1[e] * rstd * gka[e], a2 = x2[e] * rstd * gkb[e];
          y1[e] = a1 * c4[e] - a2 * s4[e];
          y2[e] = a1 * s4[e] + a2 * c4[e];
        }
        if (lane < 16) {
          if (ctx) {
            *(f32x4*)(p.out + O_GK + obase * 128 + khead * 64 + 4 * j8) = (f32x4){y1[0], y1[1], y1[2], y1[3]};
            *(f32x4*)(p.out + O_GK + obase * 128 + khead * 64 + 32 + 4 * j8) = (f32x4){y2[0], y2[1], y2[2], y2[3]};
          }
          u32x2 o1, o2;
          o1.x = cvt_pk_bf16(y1[0], y1[1]); o1.y = cvt_pk_bf16(y1[2], y1[3]);
          o2.x = cvt_pk_bf16(y2[0], y2[1]); o2.y = cvt_pk_bf16(y2[2], y2[3]);
          *(u32x2*)(GK + (size_t)row * 128 + khead * 64 + 4 * j8) = o1;
          *(u32x2*)(GK + (size_t)row * 128 + khead * 64 + 32 + 4 * j8) = o2;
        }
      }
      if (lane >= 32) {
        const int e0 = (lane - 32) * 4;
        const u32x2 w = *(const u32x2*)(ps + 1072 + e0);
        *(u32x2*)(GV + (size_t)row * 128 + e0) = w;
        if (ctx) *(f32x4*)(p.out + O_GV + obase * 128 + e0) = (f32x4){bflo(w.x), bfhi(w.x), bflo(w.y), bfhi(w.y)};
      } else if (lane >= 16 && lane < 24) {
        const int e0 = (lane - 16) * 4;
        const u32x2 w = *(const u32x2*)(ps + 400 + e0);
        *(u32x2*)(KR + (size_t)row * 32 + e0) = w;
        if (ctx) *(f32x4*)(p.out + O_KR + obase * 32 + e0) = (f32x4){bflo(w.x), bfhi(w.x), bflo(w.y), bfhi(w.y)};
      }
    } else {
      const int r = row - NTOK, b = r >> 8, s = r & 255;
      const size_t cb = (size_t)((b * 2 + l) * 256 + s);
      {
        const f32x2 v = *(const f32x2*)(p.c_ckv + cb * 128 + lane * 2);
        *(unsigned*)(CKV + (size_t)row * 128 + lane * 2) = cvt_pk_bf16(v[0], v[1]);
      }
      if (lane < 32) KR[(size_t)row * 32 + lane] = f2bf(p.c_kr[cb * 32 + lane]);
      {
        const f32x2 v = *(const f32x2*)(p.c_gk + cb * 128 + lane * 2);
        *(unsigned*)(GK + (size_t)row * 128 + lane * 2) = cvt_pk_bf16(v[0], v[1]);
      }
      {
        const f32x2 v = *(const f32x2*)(p.c_gv + cb * 128 + lane * 2);
        *(unsigned*)(GV + (size_t)row * 128 + lane * 2) = cvt_pk_bf16(v[0], v[1]);
      }
    }
  }
}

__device__ __forceinline__ void mla_head_vec(bf16_t* np, bf16_t* rp_out, const u32x2 rw, const f32x4 ga, const f32x4 gb, const f32x4 gr,
                                             bool lat, int j8, const f32x4 c4, const f32x4 s4, float oscale) {
  const u32x4 nw = *(const u32x4*)np;
  float x[8] = {bflo(nw.x), bfhi(nw.x), bflo(nw.y), bfhi(nw.y), bflo(nw.z), bfhi(nw.z), bflo(nw.w), bfhi(nw.w)};
  float rr[4] = {bflo(rw.x), bfhi(rw.x), bflo(rw.y), bfhi(rw.y)};
  float ss = 0.f;
#pragma unroll
  for (int e = 0; e < 8; ++e) ss += x[e] * x[e];
#pragma unroll
  for (int e = 0; e < 4; ++e) ss += rr[e] * rr[e];
  ss = sum8(ss);
  const float rstd = rsqrtf(ss * (1.0f / 96.0f) + EPS);
#pragma unroll
  for (int e = 0; e < 4; ++e) { x[e] *= rstd * ga[e] * oscale; x[4 + e] *= rstd * gb[e] * oscale; rr[e] *= rstd * gr[e]; }
  float ro[4];
#pragma unroll
  for (int e = 0; e < 4; ++e) {
    const float other = __shfl_xor(rr[e], 4);
    ro[e] = rr[e];
    if (lat) ro[e] = (j8 < 4) ? (rr[e] * c4[e] - other * s4[e]) : (other * s4[e] + rr[e] * c4[e]);
    ro[e] *= oscale;
  }
  u32x4 ow;
  ow.x = cvt_pk_bf16(x[0], x[1]); ow.y = cvt_pk_bf16(x[2], x[3]); ow.z = cvt_pk_bf16(x[4], x[5]); ow.w = cvt_pk_bf16(x[6], x[7]);
  *(u32x4*)np = ow;
  u32x2 orw;
  orw.x = cvt_pk_bf16(ro[0], ro[1]); orw.y = cvt_pk_bf16(ro[2], ro[3]);
  *(u32x2*)rp_out = orw;
}
__device__ void post_mla(const Params& p, int l, bf16_t* QA, bf16_t* KAV, const bf16_t* KR, const f32x2* TA) {
  const int tid_ = opaque_tid(), lane = tid_ & 63, wid = tid_ >> 6;
  const int head = lane >> 3, j8 = lane & 7;
  const float q_scale = 0.10206207261596577f * 1.4426950408889634f;
  const f32x4 gka = *(const f32x4*)(p.a_knorm_g + l * 96 + 8 * j8), gkb = *(const f32x4*)(p.a_knorm_g + l * 96 + 8 * j8 + 4), gkr = *(const f32x4*)(p.a_knorm_g + l * 96 + 64 + 4 * j8);
  const f32x4 gqa = *(const f32x4*)(p.a_qnorm_g + l * 96 + 8 * j8), gqb = *(const f32x4*)(p.a_qnorm_g + l * 96 + 8 * j8 + 4), gqr = *(const f32x4*)(p.a_qnorm_g + l * 96 + 64 + 4 * j8);
  for (int row = opaque_bid() * 8 + wid; row < NKV; row += opaque_gdim() * 8) {
    const bool lat = (row >= NCTX) && (row < NTOK);
    const int t = (row - NCTX) & 2047;
    f32x4 c4 = {1.f, 1.f, 1.f, 1.f}, s4 = {0.f, 0.f, 0.f, 0.f};
    if (lat) {
      const f32x4 r0 = *(const f32x4*)(TA + t * 16 + 4 * (j8 & 3)), r1 = *(const f32x4*)(TA + t * 16 + 4 * (j8 & 3) + 2);
      c4 = (f32x4){r0[0], r0[2], r1[0], r1[2]}; s4 = (f32x4){r0[1], r0[3], r1[1], r1[3]};
    }
    {
      bf16_t* kp = KAV + (size_t)row * 1280 + head * 160;
      const u32x2 rw = *(const u32x2*)(KR + (size_t)row * 32 + 4 * j8);
      mla_head_vec(kp + 8 * j8, kp + 64 + 4 * j8, rw, gka, gkb, gkr, lat, j8, c4, s4, 1.0f);
    }
    if (row < NTOK) {
      bf16_t* qp = QA + (size_t)row * 768 + head * 96;
      const u32x2 rw = *(const u32x2*)(qp + 64 + 4 * j8);
      mla_head_vec(qp + 8 * j8, qp + 64 + 4 * j8, rw, gqa, gqb, gqr, lat, j8, c4, s4, q_scale);
    }
  }
}

__device__ void post_mlstm(const Params& p, int l, bf16_t* HF, const bf16_t* HB, const bf16_t* PM) {
  const int tid_ = opaque_tid(), lane = tid_ & 63, wid = tid_ >> 6;
  const int head = lane >> 4, j16 = lane & 15;
  const f32x4 ga = *(const f32x4*)(p.m_norm_g + l * 128 + 8 * j16), gb = *(const f32x4*)(p.m_norm_g + l * 128 + 8 * j16 + 4);
  for (int row = opaque_bid() * 8 + wid; row < NTOK; row += opaque_gdim() * 8) {
    const u32x4 wf = *(const u32x4*)(HF + (size_t)row * 512 + head * 128 + 8 * j16);
    const u32x4 wb = *(const u32x4*)(HB + (size_t)row * 512 + head * 128 + 8 * j16);
    const u32x4 wo = *(const u32x4*)(PM + (size_t)row * 2048 + 1536 + head * 128 + 8 * j16);
    float v[8] = {bflo(wf.x) + bflo(wb.x), bfhi(wf.x) + bfhi(wb.x), bflo(wf.y) + bflo(wb.y), bfhi(wf.y) + bfhi(wb.y),
                  bflo(wf.z) + bflo(wb.z), bfhi(wf.z) + bfhi(wb.z), bflo(wf.w) + bflo(wb.w), bfhi(wf.w) + bfhi(wb.w)};
    const float mo[8] = {bflo(wo.x), bfhi(wo.x), bflo(wo.y), bfhi(wo.y), bflo(wo.z), bfhi(wo.z), bflo(wo.w), bfhi(wo.w)};
    float ss = 0.f;
#pragma unroll
    for (int e = 0; e < 8; ++e) ss += v[e] * v[e];
    ss = sum8(ss);
    ss += __shfl_xor(ss, 8);
    const float rstd = rsqrtf(ss * (1.0f / 128.0f) + EPS);
#pragma unroll
    for (int e = 0; e < 4; ++e) { v[e] = v[e] * rstd * ga[e] * sigmoidf_(mo[e]); v[4 + e] = v[4 + e] * rstd * gb[e] * sigmoidf_(mo[4 + e]); }
    u32x4 o;
    o.x = cvt_pk_bf16(v[0], v[1]); o.y = cvt_pk_bf16(v[2], v[3]); o.z = cvt_pk_bf16(v[4], v[5]); o.w = cvt_pk_bf16(v[6], v[7]);
    *(u32x4*)(HF + (size_t)row * 512 + head * 128 + 8 * j16) = o;
  }
}

template <int DQK>
__device__ __forceinline__ void attn_item(const bf16_t* qptr, bf16_t* optr, const bf16_t* Kb, int kstride, const bf16_t* Vb, int vstride,
                                          int seg0_row, int seg0_tiles, int seg1_row, int ntiles, bf16_t* lds, bool nostore = false) {
  constexpr int KSTR = DQK + 8, KT_EL = 64 * KSTR, VT_EL = 64 * 72, NKK = DQK / 16, KCH = DQK / 8;
  const int tid = opaque_tid(), lane = tid & 63, h2 = lane >> 5, r = lane & 31;
  bf16_t* const sKb = lds;
  bf16_t* const sVb = lds + 2 * KT_EL;
  bf16x8 qf[NKK];
#pragma unroll
  for (int kk = 0; kk < NKK; ++kk) qf[kk] = *(const bf16x8*)(qptr + kk * 16 + h2 * 8);
  f32x16 o0, o1;
#pragma unroll
  for (int i = 0; i < 16; ++i) { o0[i] = 0.f; o1[i] = 0.f; }
  float m_run = -1e30f, l_run = 0.f;
  const int key0 = tid / KCH, c0 = tid - key0 * KCH;
  const int id1 = tid + 512, key1 = id1 / KCH, c1 = id1 - key1 * KCH;
  const bool has1 = (DQK == 96) && (tid < 256);
  const int vkey = tid & 63, vc = tid >> 6;
  const int vpos = (vkey & ~12) | ((vkey & 4) << 1) | ((vkey & 8) >> 1);
  u32x4 kr0, kr1 = {0u, 0u, 0u, 0u}, vr;
#define ATTN_ROW0(j) (((j) < seg0_tiles) ? seg0_row + (j) * 64 : seg1_row + ((j) - seg0_tiles) * 64)
#define ATTN_LOADK(j)                                                                        \
  {                                                                                          \
    const int row0_ = ATTN_ROW0(j);                                                          \
    kr0 = *(const u32x4*)(Kb + (size_t)(row0_ + key0) * kstride + c0 * 8);                   \
    if (has1) kr1 = *(const u32x4*)(Kb + (size_t)(row0_ + key1) * kstride + c1 * 8);        \
  }
#define ATTN_LOADV(j) { const int row0_ = ATTN_ROW0(j); vr = *(const u32x4*)(Vb + (size_t)(row0_ + vkey) * vstride + vc * 8); }
#define ATTN_STOREK(buf)                                                                     \
  {                                                                                          \
    bf16_t* sK_ = sKb + (buf) * KT_EL;                                                       \
    *(u32x4*)(sK_ + key0 * KSTR + c0 * 8) = kr0;                                             \
    if (has1) *(u32x4*)(sK_ + key1 * KSTR + c1 * 8) = kr1;                                   \
  }
#define ATTN_STOREV(buf)                                                                     \
  {                                                                                          \
    bf16_t* sV_ = sVb + (buf) * VT_EL;                                                       \
    sV_[(vc * 8 + 0) * 72 + vpos] = (bf16_t)(vr.x & 0xffffu);                                \
    sV_[(vc * 8 + 1) * 72 + vpos] = (bf16_t)(vr.x >> 16);                                    \
    sV_[(vc * 8 + 2) * 72 + vpos] = (bf16_t)(vr.y & 0xffffu);                                \
    sV_[(vc * 8 + 3) * 72 + vpos] = (bf16_t)(vr.y >> 16);                                    \
    sV_[(vc * 8 + 4) * 72 + vpos] = (bf16_t)(vr.z & 0xffffu);                                \
    sV_[(vc * 8 + 5) * 72 + vpos] = (bf16_t)(vr.z >> 16);                                    \
    sV_[(vc * 8 + 6) * 72 + vpos] = (bf16_t)(vr.w & 0xffffu);                                \
    sV_[(vc * 8 + 7) * 72 + vpos] = (bf16_t)(vr.w >> 16);                                    \
  }
#define ATTN_QK(dst0, dst1, buf)                                                             \
  {                                                                                          \
    const bf16_t* sK_ = sKb + (buf) * KT_EL;                                                 \
    _Pragma("unroll") for (int i = 0; i < 16; ++i) { dst0[i] = 0.f; dst1[i] = 0.f; }         \
    __builtin_amdgcn_s_setprio(1);                                                           \
    bf16x8 ka0_[NKK], ka1_[NKK];     \
    _Pragma("unroll") for (int kk = 0; kk < NKK; ++kk) {                                     \
      ka0_[kk] = *(const bf16x8*)(sK_ + r * KSTR + kk * 16 + h2 * 8);                        \
      ka1_[kk] = *(const bf16x8*)(sK_ + (32 + r) * KSTR + kk * 16 + h2 * 8);                 \
    }                                                                                        \
    __builtin_amdgcn_sched_barrier(0);         \
    _Pragma("unroll") for (int kk = 0; kk < NKK; ++kk) {                                     \
      dst0 = __builtin_amdgcn_mfma_f32_32x32x16_bf16(ka0_[kk], qf[kk], dst0, 0, 0, 0);       \
      dst1 = __builtin_amdgcn_mfma_f32_32x32x16_bf16(ka1_[kk], qf[kk], dst1, 0, 0, 0);       \
    }                                                                                        \
    __builtin_amdgcn_s_setprio(0);                                                           \
  }
  ATTN_LOADK(0); ATTN_LOADV(0);
  ATTN_STOREK(0); ATTN_STOREV(0);
  ATTN_LOADK(1);
  ATTN_STOREK(1);
  lds_barrier();
  f32x16 s0, s1;
  ATTN_QK(s0, s1, 0);
  lds_barrier();
  for (int j = 0; j < ntiles; ++j) {
    const int cur = j & 1;
    if (j + 1 < ntiles) ATTN_LOADV(j + 1);
    if (j + 2 < ntiles) ATTN_LOADK(j + 2);
    f32x16 n0, n1;
    if (j + 1 < ntiles) { ATTN_QK(n0, n1, cur ^ 1); }
    else {
#pragma unroll
      for (int i = 0; i < 16; ++i) { n0[i] = 0.f; n1[i] = 0.f; }
    }
    const bf16_t* sV = sVb + cur * VT_EL;
    {
      float mx = fmaxf(s0[0], s1[0]);
#pragma unroll
      for (int i = 1; i < 16; ++i) mx = fmaxf(mx, fmaxf(s0[i], s1[i]));
      mx = cross_half_max(mx);
      if (__any(mx > m_run + 11.5f)) {
        const float m_new = fmaxf(m_run, mx);
        const float alpha = __builtin_amdgcn_exp2f(m_run - m_new);
        l_run *= alpha;
#pragma unroll
        for (int i = 0; i < 16; ++i) { o0[i] *= alpha; o1[i] *= alpha; }
        m_run = m_new;
      }
      float ls = 0.f;
#pragma unroll
      for (int i = 0; i < 16; ++i) {
        s0[i] = __builtin_amdgcn_exp2f(s0[i] - m_run);
        s1[i] = __builtin_amdgcn_exp2f(s1[i] - m_run);
        ls += s0[i] + s1[i];
      }
      l_run += ls;
      u32x4 pa, pb, pc, pd;
      pa.x = cvt_pk_bf16(s0[0], s0[1]); pa.y = cvt_pk_bf16(s0[2], s0[3]); pa.z = cvt_pk_bf16(s0[4], s0[5]); pa.w = cvt_pk_bf16(s0[6], s0[7]);
      pb.x = cvt_pk_bf16(s0[8], s0[9]); pb.y = cvt_pk_bf16(s0[10], s0[11]); pb.z = cvt_pk_bf16(s0[12], s0[13]); pb.w = cvt_pk_bf16(s0[14], s0[15]);
      pc.x = cvt_pk_bf16(s1[0], s1[1]); pc.y = cvt_pk_bf16(s1[2], s1[3]); pc.z = cvt_pk_bf16(s1[4], s1[5]); pc.w = cvt_pk_bf16(s1[6], s1[7]);
      pd.x = cvt_pk_bf16(s1[8], s1[9]); pd.y = cvt_pk_bf16(s1[10], s1[11]); pd.z = cvt_pk_bf16(s1[12], s1[13]); pd.w = cvt_pk_bf16(s1[14], s1[15]);
      const bf16x8 pf[4] = {__builtin_bit_cast(bf16x8, pa), __builtin_bit_cast(bf16x8, pb), __builtin_bit_cast(bf16x8, pc), __builtin_bit_cast(bf16x8, pd)};
      bf16x8 vf0[4], vf1[4];
#pragma unroll
      for (int q = 0; q < 4; ++q) {
        vf0[q] = *(const bf16x8*)(sV + r * 72 + q * 16 + h2 * 8);
        vf1[q] = *(const bf16x8*)(sV + (32 + r) * 72 + q * 16 + h2 * 8);
      }
      __builtin_amdgcn_sched_barrier(0);
#pragma unroll
      for (int q = 0; q < 4; ++q) {
        o0 = __builtin_amdgcn_mfma_f32_32x32x16_bf16(vf0[q], pf[q], o0, 0, 0, 0);
        o1 = __builtin_amdgcn_mfma_f32_32x32x16_bf16(vf1[q], pf[q], o1, 0, 0, 0);
      }
    }
    if (j + 1 < ntiles) ATTN_STOREV(cur ^ 1);
    if (j + 2 < ntiles) ATTN_STOREK(cur);
    lds_barrier();
    s0 = n0; s1 = n1;
  }
#undef ATTN_ROW0
#undef ATTN_LOADK
#undef ATTN_LOADV
#undef ATTN_STOREK
#undef ATTN_STOREV
#undef ATTN_QK
  const float l_tot = l_run + __shfl_xor(l_run, 32);
  const float inv = 1.0f / l_tot;
  if (nostore && inv != 12345.f) return;
#pragma unroll
  for (int g = 0; g < 4; ++g) {
    u32x2 w0, w1;
    w0.x = cvt_pk_bf16(o0[4 * g] * inv, o0[4 * g + 1] * inv);
    w0.y = cvt_pk_bf16(o0[4 * g + 2] * inv, o0[4 * g + 3] * inv);
    w1.x = cvt_pk_bf16(o1[4 * g] * inv, o1[4 * g + 1] * inv);
    w1.y = cvt_pk_bf16(o1[4 * g + 2] * inv, o1[4 * g + 3] * inv);
    *(u32x2*)(optr + 8 * g + 4 * h2) = w0;
    *(u32x2*)(optr + 32 + 8 * g + 4 * h2) = w1;
  }
}

__device__ void mlstm_chain(const Params& p, int l, bool lat, int b, int h, int dir, const bf16_t* PM, const float* G, bf16_t* Hout, bf16_t* lds) {
  const int tid = opaque_tid(), lane = tid & 63, wid = tid >> 6, h2 = lane >> 5, r = lane & 31;
  const int T = lat ? 2048 : 256, base_row = lat ? NCTX + b * 2048 : b * 256, nc = T >> 6;
  const float kscale = 0.08838834764831845f;
  bf16_t* Qs = lds;
  bf16_t* Ks = Qs + 64 * 136;
  bf16_t* KwT = Ks + 64 * 136;
  bf16_t* VT = KwT + 128 * 72;
  bf16_t* CT = VT + 128 * 72;
  bf16_t* Ss = CT + 128 * 136;
  float* F = (float*)(Ss + 64 * 72);
  float* qnv = F + 768; float* hdv = F + 832; float* nvec = F + 896;
  const int dkt = wid >> 1, dvt0 = (wid & 1) * 2;
  const int lt = wid >> 2, dvt = wid & 3;
  f32x16 accC[2];
  float m_state = 0.f;
  const size_t sidx = (size_t)(((b * 2 + l) * 2 + dir) * 4 + h);
  if (lat) {
#pragma unroll
    for (int i = 0; i < 2; ++i)
#pragma unroll
      for (int rg = 0; rg < 16; ++rg)
        accC[i][rg] = p.st_C[sidx * 16384 + (size_t)(dkt * 32 + rowof(rg, h2)) * 128 + (dvt0 + i) * 32 + r];
    asm volatile("" ::: "memory");
    if (tid < 128) nvec[tid] = p.st_n[sidx * 128 + tid];
    m_state = p.st_m[sidx];
  } else {
#pragma unroll
    for (int i = 0; i < 2; ++i)
#pragma unroll
      for (int rg = 0; rg < 16; ++rg) accC[i][rg] = 0.f;
    if (tid < 128) nvec[tid] = 0.f;
  }
#pragma unroll
  for (int i = 0; i < 2; ++i)
#pragma unroll
    for (int g = 0; g < 4; ++g) {
      u32x2 w;
      w.x = cvt_pk_bf16(accC[i][4 * g], accC[i][4 * g + 1]);
      w.y = cvt_pk_bf16(accC[i][4 * g + 2], accC[i][4 * g + 3]);
      *(u32x2*)(CT + ((dvt0 + i) * 32 + r) * 136 + dkt * 32 + 8 * g + 4 * h2) = w;
    }
  const int j0 = tid >> 4, cc = tid & 15;
  const int vj = tid & 63, vc8 = tid >> 6;
  u32x4 rq[2], rk[2], rv[2];
  float gi = 0.f, gf = 0.f;
#define MLSTM_ROW(c, j) (base_row + (dir ? (T - 1 - ((c) * 64 + (j))) : ((c) * 64 + (j))))
  const int rstep = dir ? -64 : 64;
  const bf16_t* pq0 = PM + (size_t)MLSTM_ROW(0, j0) * 2048 + h * 128 + cc * 8;
  const bf16_t* pq1 = PM + (size_t)MLSTM_ROW(0, j0 + 32) * 2048 + h * 128 + cc * 8;
  const bf16_t* pv0 = PM + (size_t)MLSTM_ROW(0, vj) * 2048 + 1024 + h * 128 + vc8 * 8;
  const float* pgt = G + (size_t)MLSTM_ROW(0, lane) * 16 + (2 * dir) * 4 + h;
  const long cstride = (long)rstep * 2048;
  const int sgn = dir ? -1 : 1;
  bf16_t* const ph0 = Hout + (size_t)MLSTM_ROW(0, lt * 32 + 4 * h2) * 512 + h * 128 + dvt * 32 + r;
#define MLSTM_LOAD(c)                                                                     \
  {                                                                                       \
    const long co_ = (long)(c) * cstride;                                                 \
    rq[0] = *(const u32x4*)(pq0 + co_); rk[0] = *(const u32x4*)(pq0 + co_ + 512);         \
    rq[1] = *(const u32x4*)(pq1 + co_); rk[1] = *(const u32x4*)(pq1 + co_ + 512);         \
    rv[0] = *(const u32x4*)(pv0 + co_); rv[1] = *(const u32x4*)(pv0 + co_ + 64);          \
  }
#define MLSTM_GATES(c)                                                                    \
  if (wid == 7) {                                                                         \
    const float* gp_ = pgt + (long)(c) * (rstep * 16);                                    \
    gi = gp_[0];                                                                          \
    gf = gp_[4];                                                                          \
  }
#define MLSTM_SCAL(par)                                                                   \
  if (wid == 7) {                                                                         \
    float* Fp = F + (par) * 384;                                                          \
    const float iv = gi;                                                                  \
    float bc = fminf(gf, 0.f) - log1pf(__expf(-fabsf(gf)));                               \
    _Pragma("unroll") for (int d = 1; d < 64; d <<= 1) { const float tt = __shfl_up(bc, d); if (lane >= d) bc += tt; } \
    const float a = iv - bc;                                                              \
    float pm = a;                                                                         \
    _Pragma("unroll") for (int d = 1; d < 64; d <<= 1) { const float tt = __shfl_up(pm, d); if (lane >= d) pm = fmaxf(pm, tt); } \
    const float mt = bc + fmaxf(m_state, pm);                                             \
    const float tot = __shfl(bc, 63);                                                     \
    const float gg = tot + a;                                                             \
    const float gmax = wave_max(gg);                                                      \
    const float total = tot + m_state;                                                    \
    const float m_new = fmaxf(total, gmax);                                               \
    Fp[lane] = bc - mt;                                                           \
    Fp[64 + lane] = a;                                                             \
    Fp[128 + lane] = mt;                                                          \
    Fp[192 + lane] = __expf(bc + m_state - mt);                                  \
    Fp[256 + lane] = __expf(gg - m_new) * kscale;                                \
    if (lane == 0) Fp[320] = __expf(total - m_new);                             \
    m_state = m_new;                                                                      \
  }
  MLSTM_LOAD(0);
  MLSTM_GATES(0);
  MLSTM_SCAL(0);
  if (nc > 1) MLSTM_GATES(1);
  for (int c = 0; c < nc; ++c) {
#pragma unroll
    for (int i = 0; i < 2; ++i) {
      const int j = j0 + 32 * i;
      *(u32x4*)(Qs + j * 136 + cc * 8) = rq[i];
      *(u32x4*)(Ks + j * 136 + cc * 8) = rk[i];
      const int vr0 = (vc8 + 8 * i) * 8;
      VT[(vr0 + 0) * 72 + vj] = (bf16_t)(rv[i].x & 0xffffu);
      VT[(vr0 + 1) * 72 + vj] = (bf16_t)(rv[i].x >> 16);
      VT[(vr0 + 2) * 72 + vj] = (bf16_t)(rv[i].y & 0xffffu);
      VT[(vr0 + 3) * 72 + vj] = (bf16_t)(rv[i].y >> 16);
      VT[(vr0 + 4) * 72 + vj] = (bf16_t)(rv[i].z & 0xffffu);
      VT[(vr0 + 5) * 72 + vj] = (bf16_t)(rv[i].z >> 16);
      VT[(vr0 + 6) * 72 + vj] = (bf16_t)(rv[i].w & 0xffffu);
      VT[(vr0 + 7) * 72 + vj] = (bf16_t)(rv[i].w >> 16);
    }
    lds_barrier();
    const float* e1v = F + (c & 1) * 384; const float* av = e1v + 64; const float* mtv = e1v + 128;
    const float* winv = e1v + 192; const float* wgkv = e1v + 256; const float* scal = e1v + 320;
    if (c + 1 < nc) MLSTM_LOAD(c + 1);
    if (c + 1 < nc) { MLSTM_SCAL((c + 1) & 1); if (c + 2 < nc) MLSTM_GATES(c + 2); }
    {
      const int j = tid & 63;
      const float wk = wgkv[j];
#pragma unroll
      for (int i = 0; i < 2; ++i) {
        const int dkb = (tid >> 6) * 8 + 64 * i;
        const u32x4 w = *(const u32x4*)(Ks + j * 136 + dkb);
        KwT[(dkb + 0) * 72 + j] = f2bf(bflo(w.x) * wk);
        KwT[(dkb + 1) * 72 + j] = f2bf(bfhi(w.x) * wk);
        KwT[(dkb + 2) * 72 + j] = f2bf(bflo(w.y) * wk);
        KwT[(dkb + 3) * 72 + j] = f2bf(bfhi(w.y) * wk);
        KwT[(dkb + 4) * 72 + j] = f2bf(bflo(w.z) * wk);
        KwT[(dkb + 5) * 72 + j] = f2bf(bfhi(w.z) * wk);
        KwT[(dkb + 6) * 72 + j] = f2bf(bflo(w.w) * wk);
        KwT[(dkb + 7) * 72 + j] = f2bf(bfhi(w.w) * wk);
      }
    }
    f32x16 acc;
#pragma unroll
    for (int i = 0; i < 16; ++i) acc[i] = 0.f;
    const bf16_t* qcA = Qs + (lt * 32 + r) * 136 + h2 * 8;
    const bf16_t* qcB = CT + (dvt * 32 + r) * 136 + h2 * 8;
    if (wid < 4) {
      const int lt2 = wid >> 1, st = wid & 1;
      const bf16_t* sA = Qs + (lt2 * 32 + r) * 136 + h2 * 8;
      const bf16_t* sB = Ks + (st * 32 + r) * 136 + h2 * 8;
      f32x16 sacc;
#pragma unroll
      for (int i = 0; i < 16; ++i) sacc[i] = 0.f;
#pragma unroll
      for (int kb = 0; kb < 4; ++kb) {
        bf16x8 fa[2], fb[2], ga[2], gb[2];
#pragma unroll
        for (int u = 0; u < 2; ++u) {
          fa[u] = *(const bf16x8*)(sA + (2 * kb + u) * 16); fb[u] = *(const bf16x8*)(sB + (2 * kb + u) * 16);
          ga[u] = *(const bf16x8*)(qcA + (2 * kb + u) * 16); gb[u] = *(const bf16x8*)(qcB + (2 * kb + u) * 16);
        }
        __builtin_amdgcn_sched_barrier(0);
#pragma unroll
        for (int u = 0; u < 2; ++u) {
          sacc = __builtin_amdgcn_mfma_f32_32x32x16_bf16(fa[u], fb[u], sacc, 0, 0, 0);
          acc = __builtin_amdgcn_mfma_f32_32x32x16_bf16(ga[u], gb[u], acc, 0, 0, 0);
        }
      }
      const int scol = st * 32 + r;
      const float as = av[scol];
      float ev[16];
#pragma unroll
      for (int rg = 0; rg < 16; ++rg) ev[rg] = e1v[lt2 * 32 + rowof(rg, h2)];
#pragma unroll
      for (int rg = 0; rg < 16; ++rg) {
        const int lrow = lt2 * 32 + rowof(rg, h2);
        const float ex = (scol <= lrow) ? (ev[rg] + as) * 1.4426950408889634f : -__builtin_inff();
        const float val = sacc[rg] * kscale * __builtin_amdgcn_exp2f(ex);
        Ss[lrow * 72 + scol] = f2bf(val);
      }
    } else {
#pragma unroll
      for (int kb = 0; kb < 2; ++kb) {
        bf16x8 ga[4], gb[4];
#pragma unroll
        for (int u = 0; u < 4; ++u) { ga[u] = *(const bf16x8*)(qcA + (4 * kb + u) * 16); gb[u] = *(const bf16x8*)(qcB + (4 * kb + u) * 16); }
        __builtin_amdgcn_sched_barrier(0);
#pragma unroll
        for (int u = 0; u < 4; ++u) acc = __builtin_amdgcn_mfma_f32_32x32x16_bf16(ga[u], gb[u], acc, 0, 0, 0);
      }
    }
#pragma unroll
    for (int rg = 0; rg < 16; ++rg) acc[rg] *= winv[lt * 32 + rowof(rg, h2)];
    {
      const int lq = tid >> 3, part = tid & 7;
      float sq = 0.f;
#pragma unroll
      for (int e4 = 0; e4 < 2; ++e4) {
        const u32x4 qw = *(const u32x4*)(Qs + lq * 136 + part * 16 + e4 * 8);
        const f32x4 n0 = *(const f32x4*)(nvec + part * 16 + e4 * 8), n1 = *(const f32x4*)(nvec + part * 16 + e4 * 8 + 4);
        sq += bflo(qw.x) * n0[0] + bfhi(qw.x) * n0[1] + bflo(qw.y) * n0[2] + bfhi(qw.y) * n0[3];
        sq += bflo(qw.z) * n1[0] + bfhi(qw.z) * n1[1] + bflo(qw.w) * n1[2] + bfhi(qw.w) * n1[3];
      }
      sq += __shfl_xor(sq, 1); sq += __shfl_xor(sq, 2); sq += __shfl_xor(sq, 4);
      if (part == 0) qnv[lq] = sq;
    }
    lds_barrier();
    {
      bf16x8 sa[4], sb[4];
#pragma unroll
      for (int ks = 0; ks < 4; ++ks) {
        sa[ks] = *(const bf16x8*)(Ss + (lt * 32 + r) * 72 + ks * 16 + h2 * 8);
        sb[ks] = *(const bf16x8*)(VT + (dvt * 32 + r) * 72 + ks * 16 + h2 * 8);
      }
      __builtin_amdgcn_sched_barrier(0);
#pragma unroll
      for (int ks = 0; ks < 4; ++ks) acc = __builtin_amdgcn_mfma_f32_32x32x16_bf16(sa[ks], sb[ks], acc, 0, 0, 0);
    }
    {
      const int lq = tid >> 3, part = tid & 7;
      const u32x4 sw = *(const u32x4*)(Ss + lq * 72 + part * 8);
      float rs = (bflo(sw.x) + bfhi(sw.x)) + (bflo(sw.y) + bfhi(sw.y)) + (bflo(sw.z) + bfhi(sw.z)) + (bflo(sw.w) + bfhi(sw.w));
      rs += __shfl_xor(rs, 1); rs += __shfl_xor(rs, 2); rs += __shfl_xor(rs, 4);
      if (part == 0) {
        const float den = qnv[lq] * winv[lq] + rs;
        hdv[lq] = 1.0f / fmaxf(fabsf(den), __expf(-mtv[lq]));
      }
    }
    {
      const float decay = scal[0];
      bf16x8 ka[4], kv0[4], kv1[4];
#pragma unroll
      for (int ks = 0; ks < 4; ++ks) {
        ka[ks] = *(const bf16x8*)(KwT + (dkt * 32 + r) * 72 + ks * 16 + h2 * 8);
        kv0[ks] = *(const bf16x8*)(VT + (dvt0 * 32 + r) * 72 + ks * 16 + h2 * 8);
        kv1[ks] = *(const bf16x8*)(VT + ((dvt0 + 1) * 32 + r) * 72 + ks * 16 + h2 * 8);
      }
      __builtin_amdgcn_sched_barrier(0);
#pragma unroll
      for (int rg = 0; rg < 16; ++rg) { accC[0][rg] *= decay; accC[1][rg] *= decay; }
#pragma unroll
      for (int ks = 0; ks < 4; ++ks) {
        accC[0] = __builtin_amdgcn_mfma_f32_32x32x16_bf16(ka[ks], kv0[ks], accC[0], 0, 0, 0);
        accC[1] = __builtin_amdgcn_mfma_f32_32x32x16_bf16(ka[ks], kv1[ks], accC[1], 0, 0, 0);
      }
#pragma unroll
      for (int i = 0; i < 2; ++i) {
#pragma unroll
        for (int g = 0; g < 4; ++g) {
          u32x2 w;
          w.x = cvt_pk_bf16(accC[i][4 * g], accC[i][4 * g + 1]);
          w.y = cvt_pk_bf16(accC[i][4 * g + 2], accC[i][4 * g + 3]);
          *(u32x2*)(CT + ((dvt0 + i) * 32 + r) * 136 + dkt * 32 + 8 * g + 4 * h2) = w;
        }
      }
      {
        const int ndk = tid >> 2, npart = tid & 3;
        const u32x4 k0 = *(const u32x4*)(KwT + ndk * 72 + npart * 16), k1 = *(const u32x4*)(KwT + ndk * 72 + npart * 16 + 8);
        float sn = (bflo(k0.x) + bfhi(k0.x)) + (bflo(k0.y) + bfhi(k0.y)) + (bflo(k0.z) + bfhi(k0.z)) + (bflo(k0.w) + bfhi(k0.w));
        sn += (bflo(k1.x) + bfhi(k1.x)) + (bflo(k1.y) + bfhi(k1.y)) + (bflo(k1.z) + bfhi(k1.z)) + (bflo(k1.w) + bfhi(k1.w));
        sn += __shfl_xor(sn, 1); sn += __shfl_xor(sn, 2);
        if (npart == 0) nvec[ndk] = nvec[ndk] * decay + sn;
      }
    }
    lds_barrier();
    {
      bf16_t* const phc = ph0 + (long)c * (rstep * 512);
#pragma unroll
      for (int rg = 0; rg < 16; ++rg) {
        const int lrow = lt * 32 + rowof(rg, h2);
        phc[sgn * (((rg & 3) + 8 * (rg >> 2)) * 512)] = f2bf(acc[rg] * hdv[lrow]);
      }
    }
  }
#undef MLSTM_LOAD
#undef MLSTM_GATES
#undef MLSTM_SCAL
#undef MLSTM_ROW
  if (!lat) {
#pragma unroll
    for (int i = 0; i < 2; ++i)
#pragma unroll
      for (int rg = 0; rg < 16; ++rg)
        p.out[O_C + sidx * 16384 + (size_t)(dkt * 32 + rowof(rg, h2)) * 128 + (dvt0 + i) * 32 + r] = accC[i][rg];
    if (tid < 128) p.out[O_N + sidx * 128 + tid] = nvec[tid];
    if (tid == 448) p.out[O_M + sidx] = m_state;
  }
  __syncthreads();
}

__device__ void mixers_phase(const Params& p, int l, unsigned* counter, const bf16_t* PM, const float* G, bf16_t* HF, bf16_t* HB,
                             bf16_t* QA, bf16_t* YA, const bf16_t* KAV, bf16_t* GQ, const bf16_t* GK, const bf16_t* GV, bf16_t* lds, int item_limit, int item_first = 0, bool nostore = false) {
  const int tid = opaque_tid(), lane = tid & 63, wid = tid >> 6, r = lane & 31;
  int* slot = (int*)((unsigned char*)lds + 130048);
#ifndef STATIC_SCHED
#define STATIC_SCHED 0
#endif
  for (int it_ = 0;; ++it_) {
#if STATIC_SCHED
    const int item = opaque_bid() + it_ * opaque_gdim();
    (void)slot; (void)counter;
#else
    if (tid == 0) *slot = (int)atomicAdd(counter, 1u);
    __syncthreads();
    int item = *slot;
    __syncthreads();
#endif
    item += item_first;
    if (item >= item_limit) break;
    if (item < 64) {
#if MIXSEL & 1
      const bool lat = item < 32;
      const int nch = lat ? 1 : 8, ch0 = lat ? item : (item - 32) * 8;
      for (int q = 0; q < nch; ++q) {
        const int ch = ch0 + q;
        const int dir = ch & 1, h = (ch >> 1) & 3, b = ch >> 3;
        mlstm_chain(p, l, lat, b, h, dir, PM, G, dir ? HB : HF, lds);
      }
#endif
    } else if (item < 320 || (item >= 576 && item < 832)) {
#if MIXSEL & 2
      const bool lat = item < 320;
      const int i = lat ? item - 64 : item - 576;
      const int b = lat ? (i >> 6) : (i >> 3), h = lat ? ((i >> 3) & 7) : (i & 7), qt = lat ? (i & 7) : 0;
      const int own0 = lat ? NCTX + b * 2048 : b * 256;
      const int qrow = own0 + qt * 256 + wid * 32 + r;
      bf16_t* qp = QA + (size_t)qrow * 768 + h * 96;
      attn_item<96>(qp, YA + (size_t)qrow * 512 + h * 64, KAV + h * 160, 1280, KAV + h * 160 + 96, 1280, NTOK + b * 256, lat ? 4 : 0, own0, lat ? 36 : 4, lds, nostore);
#endif
    } else {
#if MIXSEL & 4
      const bool lat = item < 576;
      const int i = lat ? item - 320 : item - 832;
      const int b = lat ? (i >> 6) : (i >> 3), kvh = lat ? ((i >> 5) & 1) : ((i >> 2) & 1), tile = lat ? (i & 31) : (i & 3);
      const int own0 = lat ? NCTX + b * 2048 : b * 256;
      const int head = kvh * 4 + (wid >> 1);
      const int qrow = own0 + tile * 64 + (wid & 1) * 32 + r;
      bf16_t* qp = GQ + (size_t)qrow * 512 + head * 64;
      attn_item<64>(qp, qp, GK + kvh * 64, 128, GV + kvh * 64, 128, NTOK + b * 256, lat ? 4 : 0, own0, lat ? 36 : 4, lds, nostore);
#endif
    }
  }
}

#define XB_TMO      128
#define XB_XCNT(j)  (256  + 64 * (j))
#define XB_XSUB(j)  (1280 + 64 * (j))
#define XB_XGEN(j)  (2304 + 64 * (j))
#define XB_TOP      3328
#define XB_TOPGEN   3392
#define XCD_BAR_WORDS 3456
#define XB_SPIN_CAP (1u << 18)
#define XLAS __attribute__((address_space(3)))

__device__ __forceinline__ unsigned xb_ld(unsigned* p)              { return __hip_atomic_load(p, __ATOMIC_RELAXED, __HIP_MEMORY_SCOPE_AGENT); }
__device__ __forceinline__ unsigned xb_add(unsigned* p, unsigned v) { return __hip_atomic_fetch_add(p, v, __ATOMIC_RELAXED, __HIP_MEMORY_SCOPE_AGENT); }
__device__ __forceinline__ unsigned xb_xcc_id() { return (unsigned)__builtin_amdgcn_s_getreg((3 << 11) | 20) & 0xFu; }
#define XB_SPIN(cond, bar) do { unsigned _sp = 0; while (cond) { __builtin_amdgcn_s_sleep(1); \
    if ((++_sp & 255u) == 0u) { if (xb_ld(&(bar)[XB_TMO])) break; if (_sp > XB_SPIN_CAP) { atomicAdd(&(bar)[XB_TMO], 1u); break; } } } } while (0)

struct XcdBarrier {
    unsigned* bar; unsigned x;
    volatile XLAS unsigned* st;
};

__device__ __forceinline__ XcdBarrier xcd_barrier_post(unsigned* bar, volatile XLAS unsigned* st) {
    XcdBarrier b; b.bar = bar; b.x = xb_xcc_id(); b.st = st;
    if (threadIdx.x == 0) (void)xb_add(&bar[XB_XCNT(b.x)], 1u);
    return b;
}
__device__ __forceinline__ void xcd_barrier_complete(unsigned* bar, unsigned x, unsigned& nloc, unsigned& nx) {
    const unsigned G = gridDim.x * gridDim.y * gridDim.z;
    unsigned sum, cnt, mine, sp = 0u;
    for (;;) {
        sum = 0u; cnt = 0u; mine = 0u;
#pragma unroll
        for (unsigned j = 0; j < 16; ++j) { const unsigned c = xb_ld(&bar[XB_XCNT(j)]); sum += c; cnt += (c > 0u) ? 1u : 0u; mine = (j == x) ? c : mine; }
        if (sum == G) break;
        __builtin_amdgcn_s_sleep(1);
        if ((++sp & 255u) == 0u) { if (xb_ld(&bar[XB_TMO])) break; if (sp > XB_SPIN_CAP) { atomicAdd(&bar[XB_TMO], 1u); break; } }
    }
    nloc = mine > 0u ? mine : 1u; nx = cnt > 0u ? cnt : 1u;
}

__device__ __forceinline__ void xcd_barrier(const XcdBarrier& b) {
    asm volatile("s_waitcnt vmcnt(0)" ::: "memory");
    __syncthreads();
    if (threadIdx.x == 0) {
        unsigned* bar = b.bar;
        __builtin_amdgcn_s_waitcnt(0);
        unsigned nloc = b.st[0], nx = b.st[1];
        if (nloc == 0u) { xcd_barrier_complete(bar, b.x, nloc, nx); b.st[0] = nloc; b.st[1] = nx; }
        const unsigned old = xb_add(&bar[XB_XSUB(b.x)], 1u);
        const unsigned gen = old / nloc;
        if (old + 1u == (gen + 1u) * nloc) {
            __builtin_amdgcn_fence(__ATOMIC_RELEASE, "agent");
            asm volatile("s_waitcnt vmcnt(0)" ::: "memory");
            const unsigned og = xb_add(&bar[XB_TOP], 1u);
            const unsigned tg = og / nx;
            if (og + 1u == (tg + 1u) * nx) xb_add(&bar[XB_TOPGEN], 1u);
            else XB_SPIN(xb_ld(&bar[XB_TOPGEN]) == tg, bar);
            __builtin_amdgcn_fence(__ATOMIC_ACQUIRE, "agent");
            xb_add(&bar[XB_XGEN(b.x)], 1u);
            asm volatile("s_waitcnt vmcnt(0)" ::: "memory");
        } else {
            XB_SPIN(xb_ld(&bar[XB_XGEN(b.x)]) == gen, bar);
            __builtin_amdgcn_fence(__ATOMIC_ACQUIRE, "agent");
            asm volatile("s_waitcnt vmcnt(0)" ::: "memory");
        }
    }
    __syncthreads();
}

__global__ void __launch_bounds__(512) fwd_megakernel(const Params p0) {
  extern __shared__ __attribute__((aligned(16))) unsigned char smem[];
  bf16_t* lds = (bf16_t*)smem;
  cg::grid_group grid = cg::this_grid();
  volatile XLAS unsigned* xb_st = (volatile XLAS unsigned*)((XLAS unsigned char*)smem + 131072);
  if (threadIdx.x == 0) { xb_st[0] = 0u; xb_st[1] = 0u; }
  __syncthreads();
  const XcdBarrier xbar = xcd_barrier_post((unsigned*)(p0.ws + OFF_BAR), xb_st);
  if (p0.ph_lo == 0) {
    const Params& p = p0;
    const int tid = opaque_tid(), lane = tid & 63, wid = tid >> 6, wm = wid >> 1, wn = wid & 1, h2 = lane >> 5, r = lane & 31;
    unsigned char* ws = p0.ws;
    asm volatile("" : "+s"(ws));
    bf16_t* WB = (bf16_t*)(ws + OFF_R0);
    bf16_t* PM = (bf16_t*)(ws + OFF_R1);
    bf16_t* MIX = (bf16_t*)(ws + OFF_MIX);
    unsigned char* SG8 = ws + OFF_SG8;
    bf16_t* YA = (bf16_t*)(ws + OFF_YA);
    bf16_t* ACT = (bf16_t*)(ws + OFF_R1);
    bf16_t* PS = (bf16_t*)(ws + OFF_R2);
    bf16_t* QA = (bf16_t*)(ws + OFF_R2);
    bf16_t* KAV = (bf16_t*)(ws + OFF_R3);
    bf16_t* H = (bf16_t*)(ws + OFF_R3);
    bf16_t* HF = (bf16_t*)(ws + OFF_HF);
    bf16_t* HB = (bf16_t*)(ws + OFF_HB);
    bf16_t* GQ = (bf16_t*)(ws + OFF_GQ);
    bf16_t* GK = (bf16_t*)(ws + OFF_GK);
    bf16_t* GV = (bf16_t*)(ws + OFF_GV);
    bf16_t* QL = (bf16_t*)(ws + OFF_QL);
    bf16_t* CKV = (bf16_t*)(ws + OFF_CKV);
    bf16_t* KR = (bf16_t*)(ws + OFF_KR);
    float* G = (float*)(ws + OFF_G);
    float* MOD = (float*)(ws + OFF_MOD);
    unsigned* CNT = (unsigned*)(ws + OFF_CNT);


    if (opaque_bid() == 0 && tid < (int)(sizeof(Params) / 8)) ((unsigned long long*)(ws + OFF_PCOPY))[tid] = ((const unsigned long long*)&p0)[tid];
      if (opaque_bid() == 0 && tid < 64) CNT[tid] = 0u;
      cvt_layer(p, 0, WB, lds);
      mod_phase(p, MOD, (float*)smem);
      rope_tables((f32x2*)(ws + OFF_TG), (f32x2*)(ws + OFF_TA));
    if (p0.ph_hi > 1) xcd_barrier(xbar);
  }
  if (p0.ph_hi < 0) grid.sync();
  for (int ph = (p0.ph_lo > 1 ? p0.ph_lo : 1); ph < p0.ph_hi; ++ph) {
    if ((ph - 1) % 13 == 10 || ph == 14) continue;
    const int tid = opaque_tid(), lane = tid & 63, wid = tid >> 6, wm = wid >> 1, wn = wid & 1, h2 = lane >> 5, r = lane & 31;
    unsigned char* ws = p0.ws;
    asm volatile("" : "+s"(ws));
    const Params& p = *(const Params*)(ws + OFF_PCOPY);
    bf16_t* WB = (bf16_t*)(ws + OFF_R0);
    bf16_t* PM = (bf16_t*)(ws + OFF_R1);
    bf16_t* MIX = (bf16_t*)(ws + OFF_MIX);
    unsigned char* SG8 = ws + OFF_SG8;
    bf16_t* YA = (bf16_t*)(ws + OFF_YA);
    bf16_t* ACT = (bf16_t*)(ws + OFF_R1);
    bf16_t* PS = (bf16_t*)(ws + OFF_R2);
    bf16_t* QA = (bf16_t*)(ws + OFF_R2);
    bf16_t* KAV = (bf16_t*)(ws + OFF_R3);
    bf16_t* H = (bf16_t*)(ws + OFF_R3);
    bf16_t* HF = (bf16_t*)(ws + OFF_HF);
    bf16_t* HB = (bf16_t*)(ws + OFF_HB);
    bf16_t* GQ = (bf16_t*)(ws + OFF_GQ);
    bf16_t* GK = (bf16_t*)(ws + OFF_GK);
    bf16_t* GV = (bf16_t*)(ws + OFF_GV);
    bf16_t* QL = (bf16_t*)(ws + OFF_QL);
    bf16_t* CKV = (bf16_t*)(ws + OFF_CKV);
    bf16_t* KR = (bf16_t*)(ws + OFF_KR);
    float* G = (float*)(ws + OFF_G);
    float* MOD = (float*)(ws + OFF_MOD);
    unsigned* CNT = (unsigned*)(ws + OFF_CNT);


    {
      const int l = (ph - 1) / 13, sp = (ph - 1) % 13;
      const float* MODl = MOD + (size_t)l * 5 * 6144;
      if (sp == 0) {
        if (l == 1) cvt_layer(p, 1, WB, lds);
        else normmod_rows(p, true, p.norm1_g, MODl, 0, 1024, H);
      } else if (sp == 1 || sp == 7 || sp == 11) {
        const int mode = (sp == 1) ? 0 : (sp == 7) ? 1 : 2;
        const int Nn = (mode == 0) ? 3328 : (mode == 1) ? 3072 : 5632;
        const size_t boff = (mode == 0) ? WB_WIN + (size_t)3072 * 1024 : (mode == 1) ? WB_WIN : WB_WFI;
        pg8::Gemm g{H, WB + boff, NTOK, Nn, 1024};
        pg8::StaticOrder S; S.init(NTOK, Nn, opaque_gdim(), opaque_bid());
        EpiU E{mode, EpiP2{PM, PS, G, p.b_mgate + l * 16}, EpiGate8{SG8}, EpiSwiGLU{ACT}};
        pg8::gemm_phase<EpiU, pg8::StaticOrder, false>((PG8_LAS unsigned char*)smem, g, S, E, nullptr);
        if (mode == 0) cvt_rest(p, l, WB, lds, CNT + 32 + l, 1, 1760);
        if (mode == 2 && l == 0) cvt_rest(p, 1, WB, lds, CNT + 34, 0, 456);
      } else if (sp == 2) {
        post_small(p, l, PS, QL, CKV, KR, GQ, GK, GV, (const f32x2*)(ws + OFF_TG));
      } else if (sp == 3) {
        size_t wz4_ = 0;
        asm volatile("" : "+s"(wz4_));
        unsigned char* wsg4 = p0.ws + wz4_;
        const bf16_t* gQL = (const bf16_t*)(wsg4 + OFF_QL); const bf16_t* gCKV = (const bf16_t*)(wsg4 + OFF_CKV); const bf16_t* gWB = (const bf16_t*)(wsg4 + OFF_R0);
        bf16_t* gQA = (bf16_t*)(wsg4 + OFF_R2); bf16_t* gKAV = (bf16_t*)(wsg4 + OFF_R3);
        for (int tile = opaque_bid(); tile < 384 + 544; tile += opaque_gdim()) {
          f32x16 acc[2][2];
          zero_acc<2>(acc);
          if (tile < 384) {
            const int tm = tile & 63, tn = tile >> 6;
            gemm_acc<2>(acc, gQL + (size_t)tm * 256 * 256, 256, 64, gWB + WB_WUQ + (size_t)tn * 128 * 256, 256, 4, lds);
#pragma unroll
            for (int mi = 0; mi < 2; ++mi)
#pragma unroll
              for (int ni = 0; ni < 2; ++ni) {
                const int col = tn * 128 + wn * 64 + ni * 32 + r;
#pragma unroll
                for (int rg = 0; rg < 16; ++rg) {
                  const int row = tm * 256 + wm * 64 + mi * 32 + rowof(rg, h2);
                  gQA[(size_t)row * 768 + col] = f2bf(acc[mi][ni][rg]);
                }
              }
          } else {
            const int t2 = tile - 384, tm = t2 % 68, tn = t2 / 68;
            gemm_acc<2>(acc, gCKV + (size_t)tm * 256 * 128, 128, 64, gWB + WB_WUKV + (size_t)tn * 128 * 128, 128, 2, lds);
#pragma unroll
            for (int mi = 0; mi < 2; ++mi)
#pragma unroll
              for (int ni = 0; ni < 2; ++ni) {
                const int col = tn * 128 + wn * 64 + ni * 32 + r;
                const int hd = col >> 7, jj = col & 127;
                const int dcol = hd * 160 + (jj < 64 ? jj : jj + 32);
#pragma unroll
                for (int rg = 0; rg < 16; ++rg) {
                  const int row = tm * 256 + wm * 64 + mi * 32 + rowof(rg, h2);
                  gKAV[(size_t)row * 1280 + dcol] = f2bf(acc[mi][ni][rg]);
                }
              }
          }
        }
      } else if (sp == 4) {
        post_mla(p, l, QA, KAV, KR, (const f32x2*)(ws + OFF_TA));
      } else if (sp == 5) {
        size_t wz_ = 0;
        asm volatile("" : "+s"(wz_));
        unsigned char* wsg = p0.ws + wz_;
        const ParamsG* pg_ = (const ParamsG*)(wsg + OFF_PCOPY);
        Params pm_;
        pm_.st_C = (const float*)pg_->f[2]; pm_.st_n = (const float*)pg_->f[3]; pm_.st_m = (const float*)pg_->f[4];
        pm_.out = (float*)pg_->out;
        mixers_phase(pm_, l, (unsigned*)(wsg + OFF_CNT) + l, (const bf16_t*)(wsg + OFF_R1), (const float*)(wsg + OFF_G), (bf16_t*)(wsg + OFF_HF), (bf16_t*)(wsg + OFF_HB),
                     (bf16_t*)(wsg + OFF_R2), (bf16_t*)(wsg + OFF_YA), (const bf16_t*)(wsg + OFF_R3), (bf16_t*)(wsg + OFF_GQ), (const bf16_t*)(wsg + OFF_GK),
                     (const bf16_t*)(wsg + OFF_GV), lds, 1088);
      } else if (sp == 6) {
        post_mlstm(p, l, HF, HB, PM);
        normmod_rows(p, l == 0, p.norm1_g + l * 1024, MODl, 0, 1024, H);
      } else if (sp == 8) {
        pg8::Gemm g{HF, WB + WB_WBR, 3 * NTOK, 1024, 512};
        BranchOrder S{opaque_gdim(), opaque_bid()};
        EpiMixAcc E{SG8, MIX};
        pg8::gemm_phase<EpiMixAcc, BranchOrder, false>((PG8_LAS unsigned char*)smem, g, S, E, nullptr);
      } else if (sp == 9 || sp == 12) {
        const bool is9 = (sp == 9);
        pg8::Gemm g{is9 ? MIX : ACT, WB + (is9 ? WB_WOUT : WB_WFO), NTOK, 1024, is9 ? 1024 : DFF};
        pg8::StaticOrder S; S.init(NTOK, 1024, opaque_gdim(), opaque_bid());
        const bool donorm = is9 || l == 0;
        const int ln = is9 ? l : 1;
        EpiRes E{p.x_prompt, p.x_sample, p.out, MODl, is9 ? 2048 : 5120, (is9 && l == 0) ? 1 : 0,
                 donorm ? 1 : 0, (is9 ? p.norm2_g : p.norm1_g) + ln * 1024, MOD + (size_t)ln * 5 * 6144, is9 ? 3072 : 0, is9 ? 4096 : 1024, H,
                 (unsigned*)(ws + OFF_SS), CNT + 128 + (l * 2 + (is9 ? 0 : 1)) * 64};
        pg8::gemm_phase<EpiRes, pg8::StaticOrder, false>((PG8_LAS unsigned char*)smem, g, S, E, nullptr);
      }
    }
    if (ph + 1 < p0.ph_hi) xcd_barrier(xbar);
  }
}

extern "C" void kernel_launch(void* const* d_in, const int* in_sizes, int n_in, void* d_out, int out_size, void* d_ws, size_t ws_size,
                              hipStream_t stream) {
  static int grid_blocks = 0;
  if (!grid_blocks) {
    int dev = 0, cus = 0, per_cu = 0;
    (void)hipGetDevice(&dev);
    (void)hipDeviceGetAttribute(&cus, hipDeviceAttributeMultiprocessorCount, dev);
    (void)hipFuncSetAttribute((const void*)fwd_megakernel, hipFuncAttributeMaxDynamicSharedMemorySize, (int)DYN_LDS);
    (void)hipOccupancyMaxActiveBlocksPerMultiprocessor(&per_cu, fwd_megakernel, 512, DYN_LDS);
    if (per_cu > 1) per_cu = 1;
    if (per_cu < 1) per_cu = 1;
    grid_blocks = cus * per_cu;
  }
  if (ws_size < WS_END) fprintf(stderr, "workspace too small: %zu < %zu\n", ws_size, (size_t)WS_END);
  Params p{};
  const float* const* in = (const float* const*)d_in;
  p.x_prompt = in[0]; p.x_sample = in[1]; p.st_C = in[2]; p.st_n = in[3]; p.st_m = in[4]; p.c_ckv = in[5]; p.c_kr = in[6];
  p.c_gk = in[7]; p.c_gv = in[8]; p.c = in[9]; p.c_ctx = in[10]; p.w_mod = in[11]; p.b_mod = in[12]; p.norm1_g = in[13];
  p.w_in = in[14]; p.b_mgate = in[15]; p.m_norm_g = in[16]; p.a_qlora_g = in[17]; p.a_kvlora_g = in[18]; p.w_uq = in[19];
  p.w_ukv = in[20]; p.a_qnorm_g = in[21]; p.a_knorm_g = in[22]; p.g_qnorm_g = in[23]; p.g_knorm_g = in[24]; p.w_branch = in[25];
  p.w_out = in[26]; p.norm2_g = in[27]; p.w_ffn_in = in[28]; p.w_ffn_out = in[29];
  p.out = (float*)d_out;
  p.ws = (unsigned char*)d_ws;
  (void)hipMemsetAsync((unsigned char*)d_ws + OFF_CNT, 0, 4096 + 16384, stream);
#if MULTI_LAUNCH
#ifndef RUN_PHASES
#define RUN_PHASES NPHASE
#endif
  for (int ph = 0; ph < RUN_PHASES; ++ph) {
    p.ph_lo = ph; p.ph_hi = ph + 1;
    hipLaunchKernelGGL(fwd_megakernel, dim3(grid_blocks), dim3(512), DYN_LDS, stream, p);
  }
#ifdef DUMP_OFF
  p.ph_lo = 99; p.ph_hi = 100;
  hipLaunchKernelGGL(fwd_megakernel, dim3(grid_blocks), dim3(512), DYN_LDS, stream, p);
#endif
#else
  p.ph_lo = 0; p.ph_hi = NPHASE;
  void* args[] = {&p};
  hipError_t e = hipLaunchCooperativeKernel((void*)fwd_megakernel, dim3(grid_blocks), dim3(512), args, DYN_LDS, stream);
  if (e != hipSuccess) fprintf(stderr, "cooperative launch failed: %s (grid %d)\n", hipGetErrorString(e), grid_blocks);
#endif
}
```
